# Optimizing an MI355X kernel written in HIP

```python
import jax, jax.numpy as jnp
from jax import lax
import numpy as np

D_MODEL = 1024
BATCH = 8
SEQ = 4096
DEPTH = 2

GRID_W = 64
CTX_LEN = 256
N_MIXERS = 2
N_LAYERS_A = (DEPTH + 1) // 2
N_LAYERS_B = DEPTH // 2
N_MOD = 6

NA_HEADS = 16
NA_HEAD_DIM = D_MODEL // NA_HEADS
WIN_H = 8
WIN_W = 16

LRU_WIDTH = D_MODEL
LRU_BLOCKS = 4
LRU_BLOCK_W = LRU_WIDTH // LRU_BLOCKS
CONV_W = 4
LRU_C = 8.0

N_GROUPS = 4
EXPERTS_PER_GROUP = 8
N_EXPERTS = N_GROUPS * EXPERTS_PER_GROUP
TOP_K = 2
EXPERT_FF = 512
MOE_BLOCK = 128
EPS = 1e-6

kernel_name = "hybrid_na_rglru_hmoe_dit"


def rmsnorm(x, g):
    x32 = x.astype(jnp.float32)
    y = x32 * lax.rsqrt(jnp.mean(x32 * x32, axis=-1, keepdims=True) + EPS)
    return (y * g.astype(jnp.float32)).astype(x.dtype)


def modulate(x, shift, scale):
    return x * (1 + scale) + shift


def neighbourhood_attention(hl, hc, w_qkv, b_qkv, rpb, w_o, b_o, with_ctx_out):
    B_, L, D = hl.shape
    C = hc.shape[1]
    rows = L // GRID_W
    kh = min(WIN_H, rows)
    kw = WIN_W
    qkv = (hl @ w_qkv + b_qkv).reshape(B_, rows, GRID_W, 3, NA_HEADS, NA_HEAD_DIM)
    q, k, v = qkv[:, :, :, 0], qkv[:, :, :, 1], qkv[:, :, :, 2]
    kv_c = (hc @ w_qkv[:, D:] + b_qkv[D:]).reshape(B_, C, 2, NA_HEADS, NA_HEAD_DIM)
    kc, vc = kv_c[:, :, 0], kv_c[:, :, 1]
    scale = NA_HEAD_DIM ** -0.5

    cols = jnp.arange(GRID_W)
    col_start = jnp.clip(cols - kw // 2, 0, GRID_W - kw)
    col_idx = col_start[:, None] + jnp.arange(kw)[None, :]
    dci = col_idx - cols[:, None] + (WIN_W - 1)

    def row_block(r):
        rs = jnp.clip(r - kh // 2, 0, rows - kh)
        q_r = lax.dynamic_index_in_dim(q, r, axis=1, keepdims=False)
        k_win = lax.dynamic_slice_in_dim(k, rs, kh, axis=1)[:, :, col_idx]
        v_win = lax.dynamic_slice_in_dim(v, rs, kh, axis=1)[:, :, col_idx]
        dri = rs + jnp.arange(kh) - r + (WIN_H - 1)
        bias = rpb[:, dri[:, None, None], dci[None, :, :]]
        s_win = jnp.einsum('bqhd,biqjhd->bhqij', q_r, k_win) * scale
        s_win = s_win.astype(jnp.float32) + jnp.transpose(bias, (0, 2, 1, 3))[None].astype(jnp.float32)
        s_ctx = (jnp.einsum('bqhd,bchd->bhqc', q_r, kc) * scale).astype(jnp.float32)
        s = jnp.concatenate([s_win.reshape(B_, NA_HEADS, GRID_W, kh * kw), s_ctx], axis=-1)
        p = jax.nn.softmax(s, axis=-1).astype(v.dtype)
        p_win = p[..., :kh * kw].reshape(B_, NA_HEADS, GRID_W, kh, kw)
        p_ctx = p[..., kh * kw:]
        return (jnp.einsum('bhqij,biqjhd->bqhd', p_win, v_win)
                + jnp.einsum('bhqc,bchd->bqhd', p_ctx, vc))

    o = lax.map(row_block, jnp.arange(rows))
    o = jnp.moveaxis(o, 0, 1).reshape(B_, L, D)
    out_l = o @ w_o + b_o
    out_c = None
    if with_ctx_out:
        qc = (hc @ w_qkv[:, :D] + b_qkv[:D]).reshape(B_, C, NA_HEADS, NA_HEAD_DIM)
        sc = (jnp.einsum('bqhd,bkhd->bhqk', qc, kc) * scale).astype(jnp.float32)
        pc = jax.nn.softmax(sc, axis=-1).astype(vc.dtype)
        oc = jnp.einsum('bhqk,bkhd->bqhd', pc, vc).reshape(B_, C, D)
        out_c = oc @ w_o + b_o
    return out_l, out_c


def centred_dwconv(u, w, b):
    T = u.shape[1]
    left = CONV_W // 2
    right = CONV_W - 1 - left
    up = jnp.pad(u, ((0, 0), (left, right), (0, 0)))
    out = up[:, 0:T] * w[0]
    for kk in range(1, CONV_W):
        out = out + up[:, kk:kk + T] * w[kk]
    return out + b


def rglru_coeffs(u, w_gate, b_gate, lam):
    B_, T, _ = u.shape
    ub = u.reshape(B_, T, LRU_BLOCKS, LRU_BLOCK_W)
    g = jnp.einsum('btnk,gnkj->gbtnj', ub, w_gate).reshape(2, B_, T, LRU_WIDTH) + b_gate[:, None, None, :]
    g = g.astype(jnp.float32)
    r = jax.nn.sigmoid(g[0])
    ig = jax.nn.sigmoid(g[1])
    log_a = LRU_C * r * jax.nn.log_sigmoid(lam.astype(jnp.float32))
    a = jnp.exp(log_a)
    b = jnp.sqrt(-jnp.expm1(2.0 * log_a)) * (ig * u.astype(jnp.float32))
    return a, b


def linear_scan(a, b, h0, reverse):
    if h0 is not None:
        if reverse:
            b = b.at[:, -1].add(a[:, -1] * h0)
        else:
            b = b.at[:, 0].add(a[:, 0] * h0)

    def combine(lhs, rhs):
        a1, b1 = lhs
        a2, b2 = rhs
        return a1 * a2, a2 * b1 + b2

    _, h = lax.associative_scan(combine, (a, b), reverse=reverse, axis=1)
    return h


def rglru_mixer(hl, hc, w_in, b_in, conv_w, conv_b, w_gate, b_gate, lam, w_o, b_o, with_ctx_out):
    yl, ul = jnp.split(hl @ w_in + b_in, 2, axis=-1)
    uc = hc @ w_in[:, LRU_WIDTH:] + b_in[LRU_WIDTH:]
    ul = centred_dwconv(ul, conv_w, conv_b)
    uc = centred_dwconv(uc, conv_w, conv_b)
    h_l_sum = None
    h_c_sum = None
    for d in range(2):
        rev = d == 1
        ac, bc = rglru_coeffs(uc, w_gate[d], b_gate[d], lam[d])
        h_c = linear_scan(ac, bc, None, rev)
        h_end = h_c[:, 0] if rev else h_c[:, -1]
        al, bl = rglru_coeffs(ul, w_gate[d], b_gate[d], lam[d])
        h_l = linear_scan(al, bl, h_end, rev)
        h_l_sum = h_l if h_l_sum is None else h_l_sum + h_l
        if with_ctx_out:
            h_c_sum = h_c if h_c_sum is None else h_c_sum + h_c
    out_l = (jax.nn.gelu(yl) * h_l_sum.astype(yl.dtype)) @ w_o + b_o
    out_c = None
    if with_ctx_out:
        yc = hc @ w_in[:, :LRU_WIDTH] + b_in[:LRU_WIDTH]
        out_c = (jax.nn.gelu(yc) * h_c_sum.astype(yc.dtype)) @ w_o + b_o
    return out_l, out_c


def hier_moe(xt, w_group, b_group, w_expert, b_expert, w1, w3, w2):
    N, D = xt.shape
    glog = (xt @ w_group + b_group).astype(jnp.float32)
    gprob = jax.nn.softmax(glog, axis=-1)
    _, g_sel = lax.top_k(glog, 1)
    g_w = jnp.take_along_axis(gprob, g_sel, axis=1)
    elog = (jnp.einsum('nd,gde->nge', xt, w_expert) + b_expert[None]).astype(jnp.float32)
    elog_g = jnp.take_along_axis(elog, g_sel[:, :, None], axis=1)[:, 0]
    e_val, e_idx = lax.top_k(elog_g, TOP_K)
    weights = g_w * jax.nn.softmax(e_val, axis=-1)
    eids = g_sel * EXPERTS_PER_GROUP + e_idx

    A = N * TOP_K
    flat_e = eids.reshape(A)
    flat_w = weights.reshape(A)
    order = jnp.argsort(flat_e)
    sorted_e = flat_e[order]
    tok = order // TOP_K
    counts = jax.ops.segment_sum(jnp.ones((A,), jnp.int32), flat_e, num_segments=N_EXPERTS)
    start = jnp.cumsum(counts) - counts
    padded = (counts + MOE_BLOCK - 1) // MOE_BLOCK * MOE_BLOCK
    pend = jnp.cumsum(padded)
    pstart = pend - padded
    dest = pstart[sorted_e] + (jnp.arange(A) - start[sorted_e])
    nb = (A + N_EXPERTS * (MOE_BLOCK - 1) + MOE_BLOCK - 1) // MOE_BLOCK
    buf = jnp.zeros((nb * MOE_BLOCK, D), xt.dtype).at[dest].set(xt[tok])
    block_e = jnp.clip(jnp.searchsorted(pend, jnp.arange(nb) * MOE_BLOCK, side='right'), 0, N_EXPERTS - 1)

    def expert_block(args):
        xb, e = args
        hdn = jax.nn.silu(xb @ w1[e]) * (xb @ w3[e])
        return hdn @ w2[e]

    ys = lax.map(expert_block, (buf.reshape(nb, MOE_BLOCK, D), block_e)).reshape(nb * MOE_BLOCK, D)
    y = ys[dest] * flat_w[order][:, None].astype(xt.dtype)
    return jax.ops.segment_sum(y, tok, num_segments=N)


def setup_inputs(seed: int = 0) -> dict:
    key = jax.random.key(seed)
    ks = jax.random.split(key, 32)
    D = D_MODEL
    f32 = jnp.float32

    def nrm(k, shape, s):
        return jax.random.normal(k, shape, f32) * s

    u = jax.random.uniform(ks[17], (N_LAYERS_B, 2, LRU_WIDTH), f32, minval=0.9, maxval=0.999)
    return {
        "x": nrm(ks[0], (BATCH, SEQ, D), 1.0),
        "c": nrm(ks[1], (BATCH, D), 1.0),
        "ctx": nrm(ks[2], (BATCH, CTX_LEN, D), 1.0),
        "c_ctx": nrm(ks[3], (D,), 1.0),
        "ada_w": nrm(ks[4], (DEPTH, D, N_MOD * D), D ** -0.5),
        "ada_b": nrm(ks[5], (DEPTH, N_MOD * D), 0.02),
        "norm_g": 1.0 + nrm(ks[6], (DEPTH, 2, D), 0.02),
        "na_w_qkv": nrm(ks[7], (N_LAYERS_A, D, 3 * D), D ** -0.5),
        "na_b_qkv": nrm(ks[8], (N_LAYERS_A, 3 * D), 0.02),
        "na_rpb": nrm(ks[9], (N_LAYERS_A, NA_HEADS, 2 * WIN_H - 1, 2 * WIN_W - 1), 0.5),
        "na_w_o": nrm(ks[10], (N_LAYERS_A, D, D), D ** -0.5),
        "na_b_o": nrm(ks[11], (N_LAYERS_A, D), 0.02),
        "lru_w_in": nrm(ks[12], (N_LAYERS_B, D, 2 * LRU_WIDTH), D ** -0.5),
        "lru_b_in": nrm(ks[13], (N_LAYERS_B, 2 * LRU_WIDTH), 0.02),
        "lru_conv_w": nrm(ks[14], (N_LAYERS_B, CONV_W, LRU_WIDTH), CONV_W ** -0.5),
        "lru_conv_b": nrm(ks[15], (N_LAYERS_B, LRU_WIDTH), 0.02),
        "lru_w_gate": nrm(ks[16], (N_LAYERS_B, 2, 2, LRU_BLOCKS, LRU_BLOCK_W, LRU_BLOCK_W), LRU_BLOCK_W ** -0.5),
        "lru_b_gate": nrm(ks[18], (N_LAYERS_B, 2, 2, LRU_WIDTH), 0.02),
        "lru_lambda": jnp.log(u) - jnp.log1p(-u),
        "lru_w_o": nrm(ks[19], (N_LAYERS_B, LRU_WIDTH, D), LRU_WIDTH ** -0.5),
        "lru_b_o": nrm(ks[20], (N_LAYERS_B, D), 0.02),
        "moe_w_group": nrm(ks[21], (DEPTH, D, N_GROUPS), D ** -0.5),
        "moe_b_group": nrm(ks[22], (DEPTH, N_GROUPS), 0.01),
        "moe_w_expert": nrm(ks[23], (DEPTH, N_GROUPS, D, EXPERTS_PER_GROUP), D ** -0.5),
        "moe_b_expert": nrm(ks[24], (DEPTH, N_GROUPS, EXPERTS_PER_GROUP), 0.01),
        "moe_w1": nrm(ks[25], (DEPTH, N_EXPERTS, D, EXPERT_FF), D ** -0.5),
        "moe_w3": nrm(ks[26], (DEPTH, N_EXPERTS, D, EXPERT_FF), D ** -0.5),
        "moe_w2": nrm(ks[27], (DEPTH, N_EXPERTS, EXPERT_FF, D), EXPERT_FF ** -0.5),
        "final_g": 1.0 + nrm(ks[28], (D,), 0.02),
    }


def reference(x, c, ctx, c_ctx, ada_w, ada_b, norm_g,
              na_w_qkv, na_b_qkv, na_rpb, na_w_o, na_b_o,
              lru_w_in, lru_b_in, lru_conv_w, lru_conv_b, lru_w_gate, lru_b_gate, lru_lambda, lru_w_o, lru_b_o,
              moe_w_group, moe_b_group, moe_w_expert, moe_b_expert, moe_w1, moe_w3, moe_w2,
              final_g):
    B_, L, D = x.shape
    C = ctx.shape[1]
    xl, xc = x, ctx
    for i in range(DEPTH):
        last = i == DEPTH - 1
        mod_l = jnp.split(jax.nn.silu(c) @ ada_w[i] + ada_b[i], N_MOD, axis=-1)
        mod_c = jnp.split(jax.nn.silu(c_ctx) @ ada_w[i] + ada_b[i], N_MOD, axis=-1)
        sh1, sc1, gt1, sh2, sc2, gt2 = [m[:, None, :] for m in mod_l]
        csh1, csc1, cgt1, csh2, csc2, cgt2 = mod_c

        hl = modulate(rmsnorm(xl, norm_g[i, 0]), sh1, sc1)
        hc = modulate(rmsnorm(xc, norm_g[i, 0]), csh1, csc1)
        j = i // N_MIXERS
        if i % N_MIXERS == 0:
            ol, oc = neighbourhood_attention(hl, hc, na_w_qkv[j], na_b_qkv[j], na_rpb[j],
                                             na_w_o[j], na_b_o[j], not last)
        else:
            ol, oc = rglru_mixer(hl, hc, lru_w_in[j], lru_b_in[j], lru_conv_w[j], lru_conv_b[j],
                                 lru_w_gate[j], lru_b_gate[j], lru_lambda[j], lru_w_o[j], lru_b_o[j], not last)
        xl = xl + gt1 * ol
        if not last:
            xc = xc + cgt1 * oc

        hl = modulate(rmsnorm(xl, norm_g[i, 1]), sh2, sc2).reshape(B_ * L, D)
        moe_args = (moe_w_group[i], moe_b_group[i], moe_w_expert[i], moe_b_expert[i],
                    moe_w1[i], moe_w3[i], moe_w2[i])
        if not last:
            hc = modulate(rmsnorm(xc, norm_g[i, 1]), csh2, csc2).reshape(B_ * C, D)
            out = hier_moe(jnp.concatenate([hl, hc], axis=0), *moe_args)
            xl = xl + gt2 * out[:B_ * L].reshape(B_, L, D)
            xc = xc + cgt2 * out[B_ * L:].reshape(B_, C, D)
        else:
            xl = xl + gt2 * hier_moe(hl, *moe_args).reshape(B_, L, D)
    return rmsnorm(xl, final_g)
```

```cpp
#include <hip/hip_runtime.h>
#include <cstdio>
#include <cstdint>
#include <cstddef>

#define GAS __attribute__((address_space(1)))
#define LAS __attribute__((address_space(3)))
typedef unsigned short bf16;
typedef unsigned v4u __attribute__((ext_vector_type(4)));
typedef unsigned v2u __attribute__((ext_vector_type(2)));
typedef float f32x4 __attribute__((ext_vector_type(4)));
typedef float f32x2 __attribute__((ext_vector_type(2)));
typedef short bf16x8 __attribute__((ext_vector_type(8)));

constexpr int D = 1024, BATCH = 8, SEQ = 4096, CTXL = 256, GRIDW = 64;
constexpr int NL = BATCH * SEQ;
constexpr int NC = BATCH * CTXL;
constexpr int MT = NL + NC;
constexpr int NMOD = 6, NHEAD = 16, HD = 64;
constexpr int NEXP = 32, EFF = 512;
constexpr float EPS = 1e-6f;
constexpr int NWAVES = 8, NTHREADS = 512;

enum { I_X = 0, I_C, I_CTX, I_CCTX, I_ADAW, I_ADAB, I_NORMG, I_WQKV, I_BQKV, I_RPB, I_NAWO, I_NABO, I_LWIN, I_LBIN, I_CONVW, I_CONVB, I_WGATE, I_BGATE,
       I_LAMBDA, I_LWO, I_LBO, I_MWG, I_MBG, I_MWE, I_MBE, I_MW1, I_MW3, I_MW2, I_FINALG, N_IN };

constexpr size_t MiB = 1u << 20;
constexpr size_t WS_CTL = 0, CTL_ZERO_BYTES = 1 * MiB;
constexpr size_t WS_MOD = 1 * MiB;
constexpr size_t WS_WQK = 2 * MiB;
constexpr size_t WS_WV = 6 * MiB;
constexpr size_t WS_WO = 8 * MiB;
constexpr size_t WS_WIN = 10 * MiB;
constexpr size_t WS_WG = 14 * MiB;
constexpr size_t WS_WLO = 16 * MiB;
constexpr size_t WS_SRCROW = 18 * MiB;
constexpr size_t WS_W13 = 32 * MiB;
constexpr size_t WS_W2 = 112 * MiB;
constexpr size_t WS_XL = 428 * MiB;
constexpr size_t WS_ROUTE = 136 * MiB;
constexpr size_t WS_A = 140 * MiB;
constexpr size_t WS_B = 208 * MiB;
constexpr size_t WS_C = 344 * MiB;
constexpr size_t WS_HL2 = 208 * MiB;
constexpr size_t WS_XS = 276 * MiB;
constexpr size_t WS_HDN = 64 * MiB;
constexpr size_t WS_END = 504 * MiB;
constexpr int CW_BAR = 4096;
constexpr int CW_ECNT = 16384;

constexpr int RING_BYTES = 131072;
constexpr int RTAB_BYTES = 36 * 1024 * 4;
constexpr int LDSCTL_OFF = RTAB_BYTES;
constexpr int LDS_BYTES = 163840;

#define RLX_AGENT __ATOMIC_RELAXED, __HIP_MEMORY_SCOPE_AGENT
#define LDS_WAIT() asm volatile("s_waitcnt lgkmcnt(0)" ::: "memory")
#define VM_WAIT() asm volatile("s_waitcnt vmcnt(0)" ::: "memory")
__device__ __forceinline__ unsigned f2bf(float f) { unsigned u = __builtin_bit_cast(unsigned, f); return (u + 0x7fffu + ((u >> 16) & 1u)) >> 16; }
__device__ __forceinline__ unsigned pk2(float lo, float hi) { return f2bf(lo) | (f2bf(hi) << 16); }
__device__ __forceinline__ float bf2f(unsigned short h) { return __builtin_bit_cast(float, (unsigned)h << 16); }
__device__ __forceinline__ float bflo(unsigned w) { return __builtin_bit_cast(float, w << 16); }
__device__ __forceinline__ float bfhi(unsigned w) { return __builtin_bit_cast(float, w & 0xffff0000u); }
__device__ __forceinline__ float wave_sum(float v) {
#define WS_DPP(x, ctrl, rmask) __builtin_bit_cast(float, __builtin_amdgcn_update_dpp(0, __builtin_bit_cast(int, x), ctrl, rmask, 0xF, false))
    v += WS_DPP(v, 0xB1, 0xF); v += WS_DPP(v, 0x4E, 0xF); v += WS_DPP(v, 0x124, 0xF); v += WS_DPP(v, 0x128, 0xF);
    v += WS_DPP(v, 0x142, 0xA); v += WS_DPP(v, 0x143, 0xC);
#undef WS_DPP
    return __builtin_bit_cast(float, __builtin_amdgcn_readlane(__builtin_bit_cast(int, v), 63));
}

#define XB_TMO      128
#define XB_XCNT(j)  (256  + 64 * (j))
#define XB_XSUB(j)  (1280 + 64 * (j))
#define XB_XGEN(j)  (2304 + 64 * (j))
#define XB_TOP      3328
#define XB_TOPGEN   3392
#define XCD_BAR_WORDS 3456
#define XB_SPIN_CAP (1u << 20)
__device__ __forceinline__ unsigned xb_ld(unsigned* p)              { return __hip_atomic_load(p, __ATOMIC_RELAXED, __HIP_MEMORY_SCOPE_AGENT); }
__device__ __forceinline__ unsigned xb_add(unsigned* p, unsigned v) { return __hip_atomic_fetch_add(p, v, __ATOMIC_RELAXED, __HIP_MEMORY_SCOPE_AGENT); }
__device__ __forceinline__ unsigned xb_xcc_id() { return (unsigned)__builtin_amdgcn_s_getreg((3 << 11) | 20) & 0xFu; }
#define XB_SPIN(cond, bar) do { unsigned _sp = 0; while (cond) { __builtin_amdgcn_s_sleep(1); \
    if ((++_sp & 255u) == 0u) { if (xb_ld(&(bar)[XB_TMO])) break; if (_sp > XB_SPIN_CAP) { atomicAdd(&(bar)[XB_TMO], 1u); break; } } } } while (0)
struct XcdBarrier { unsigned* bar; unsigned x; volatile LAS unsigned* st; };
__device__ __forceinline__ XcdBarrier xcd_barrier_post(unsigned* bar, volatile LAS unsigned* st) {
    XcdBarrier b; b.bar = bar; b.x = xb_xcc_id(); b.st = st;
    if (threadIdx.x == 0) (void)xb_add(&bar[XB_XCNT(b.x)], 1u);
    return b;
}
__device__ __forceinline__ void xcd_barrier_complete(unsigned* bar, unsigned x, unsigned& nloc, unsigned& nx) {
    const unsigned G = gridDim.x * gridDim.y * gridDim.z;
    unsigned sum, cnt, mine, sp = 0u;
    for (;;) {
        sum = 0u; cnt = 0u; mine = 0u;
#pragma unroll
        for (unsigned j = 0; j < 16; ++j) { const unsigned c = xb_ld(&bar[XB_XCNT(j)]); sum += c; cnt += (c > 0u) ? 1u : 0u; mine = (j == x) ? c : mine; }
        if (sum == G) break;
        __builtin_amdgcn_s_sleep(1);
        if ((++sp & 255u) == 0u) { if (xb_ld(&bar[XB_TMO])) break; if (sp > XB_SPIN_CAP) { atomicAdd(&bar[XB_TMO], 1u); break; } }
    }
    nloc = mine > 0u ? mine : 1u; nx = cnt > 0u ? cnt : 1u;
}
__device__ __forceinline__ void xcd_barrier(const XcdBarrier& b) {
    asm volatile("s_waitcnt vmcnt(0)" ::: "memory");
    __syncthreads();
    if (threadIdx.x == 0) {
        unsigned* bar = b.bar;
        __builtin_amdgcn_s_waitcnt(0);
        unsigned nloc = b.st[0], nx = b.st[1];
        if (nloc == 0u) { xcd_barrier_complete(bar, b.x, nloc, nx); b.st[0] = nloc; b.st[1] = nx; }
        const unsigned old = xb_add(&bar[XB_XSUB(b.x)], 1u);
        const unsigned gen = old / nloc;
        if (old + 1u == (gen + 1u) * nloc) {
            __builtin_amdgcn_fence(__ATOMIC_RELEASE, "agent");
            asm volatile("s_waitcnt vmcnt(0)" ::: "memory");
            const unsigned og = xb_add(&bar[XB_TOP], 1u);
            const unsigned tg = og / nx;
            if (og + 1u == (tg + 1u) * nx) xb_add(&bar[XB_TOPGEN], 1u);
            else XB_SPIN(xb_ld(&bar[XB_TOPGEN]) == tg, bar);
            __builtin_amdgcn_fence(__ATOMIC_ACQUIRE, "agent");
            xb_add(&bar[XB_XGEN(b.x)], 1u);
            asm volatile("s_waitcnt vmcnt(0)" ::: "memory");
        } else {
            XB_SPIN(xb_ld(&bar[XB_XGEN(b.x)]) == gen, bar);
            __builtin_amdgcn_fence(__ATOMIC_ACQUIRE, "agent");
            asm volatile("s_waitcnt vmcnt(0)" ::: "memory");
        }
    }
    __syncthreads();
}

struct Args { const float* in[N_IN]; float* out; unsigned char* ws; int ph_lo, ph_hi; };
struct Frame {
    LAS unsigned char* lds;
    int tid, lane, wave, vcu, G;
    const float* const __attribute__((address_space(4)))* in;
    float* out; unsigned char* ws;
};
__device__ __forceinline__ const float* row_x_in(const Frame& F, int r) {
    return r < NL ? F.in[I_X] + (size_t)r * D : F.in[I_CTX] + (size_t)(r - NL) * D;
}
__device__ __forceinline__ int row_mod(int r) { return r < NL ? (r >> 12) : 8; }
__device__ __forceinline__ const float* modp(const Frame& F, int layer, int mrow, int which) {
    return (const float*)(F.ws + WS_MOD) + ((size_t)(layer * 9 + mrow) * NMOD + which) * D;
}

__device__ __forceinline__ float silu_f(float v) { return v * __builtin_amdgcn_rcpf(1.f + __expf(-v)); }
__device__ __forceinline__ void p0_mod(Frame& F) {
    LAS float* S = (LAS float*)F.lds;
    LAS float* P = (LAS float*)(F.lds + 9 * 1024 * 4);
    for (int it = blockIdx.x; it < 192; it += F.G) {
        const int layer = it / 96, n0 = (it % 96) * 64;
        { float sv[18];
#pragma unroll
          for (int q = 0; q < 18; ++q) { const int e = F.tid + NTHREADS * q; const int m = e >> 10, k = e & 1023; sv[q] = m < 8 ? F.in[I_C][m * D + k] : F.in[I_CCTX][k]; }
#pragma unroll
          for (int q = 0; q < 18; ++q) S[F.tid + NTHREADS * q] = silu_f(sv[q]); }
        __syncthreads();
        const float* W = F.in[I_ADAW] + (size_t)layer * D * (NMOD * D) + n0 + F.lane;
        float acc[9];
#pragma unroll
        for (int m = 0; m < 9; ++m) acc[m] = 0.f;
        const int kb = F.wave * 128;
#pragma unroll 8
        for (int k = 0; k < 128; ++k) { const float w = W[(size_t)(kb + k) * (NMOD * D)];
#pragma unroll
            for (int m = 0; m < 9; ++m) acc[m] += S[m * 1024 + kb + k] * w; }
#pragma unroll
        for (int m = 0; m < 9; ++m) P[(F.wave * 9 + m) * 64 + F.lane] = acc[m];
        __syncthreads();
        for (int e = F.tid; e < 9 * 64; e += NTHREADS) { const int m = e >> 6, n = e & 63; float s = F.in[I_ADAB][layer * (NMOD * D) + n0 + n];
#pragma unroll
            for (int w = 0; w < 8; ++w) s += P[(w * 9 + m) * 64 + n];
            ((float*)(F.ws + WS_MOD))[(size_t)(layer * 9 + m) * (NMOD * D) + n0 + n] = s; }
        __syncthreads();
    }
}
__device__ __forceinline__ void transpose_item(const float* W, int ldw, int k0, int n0, bf16* dst, int dld, int drow0, LAS float* scr, int lane) {
    const int lq = lane >> 4, ln = 4 * (lane & 15);
    f32x4 v[16];
#pragma unroll
    for (int i = 0; i < 16; ++i) v[i] = *(const f32x4*)(W + (size_t)(k0 + lq + 4 * i) * ldw + n0 + ln);
#pragma unroll
    for (int i = 0; i < 16; ++i) { LAS float* q = scr + (lq + 4 * i) * 65 + ln; q[0] = v[i].x; q[1] = v[i].y; q[2] = v[i].z; q[3] = v[i].w; }
    LDS_WAIT(); asm volatile("" ::: "memory");
    const int c = lane & 7;
#pragma unroll
    for (int j = 0; j < 8; ++j) { const int n = (lane >> 3) + 8 * j; const LAS float* q = scr + (8 * c) * 65 + n;
        v4u o; o.x = pk2(q[0 * 65], q[1 * 65]); o.y = pk2(q[2 * 65], q[3 * 65]); o.z = pk2(q[4 * 65], q[5 * 65]); o.w = pk2(q[6 * 65], q[7 * 65]);
        *(v4u*)(dst + (size_t)(drow0 + n) * dld + k0 + 8 * c) = o; }
    LDS_WAIT(); asm volatile("" ::: "memory");
}
constexpr int TR_SCR = 64 * 65 * 4;
__device__ __forceinline__ unsigned pk4_fp8(float a, float b, float c, float d) { int w = __builtin_amdgcn_cvt_pk_fp8_f32(a, b, 0, false); w = __builtin_amdgcn_cvt_pk_fp8_f32(c, d, w, true); return (unsigned)w; }
__device__ __forceinline__ void transpose_item_f8(const float* W, int ldw, int k0, int n0, unsigned char* dst, int dld, int drow0, LAS float* scr, int lane, float wsc = 64.f) {
    const int lq = lane >> 4, ln = 4 * (lane & 15);
    f32x4 v[16];
#pragma unroll
    for (int i = 0; i < 16; ++i) v[i] = *(const f32x4*)(W + (size_t)(k0 + lq + 4 * i) * ldw + n0 + ln);
#pragma unroll
    for (int i = 0; i < 16; ++i) { LAS float* q = scr + (lq + 4 * i) * 65 + ln; q[0] = v[i].x; q[1] = v[i].y; q[2] = v[i].z; q[3] = v[i].w; }
    LDS_WAIT(); asm volatile("" ::: "memory");
    const int c = lane & 3;
#pragma unroll
    for (int j = 0; j < 4; ++j) { const int n = (lane >> 2) + 16 * j; const LAS float* q = scr + (16 * c) * 65 + n;
        v4u o;
        o.x = pk4_fp8(wsc * q[0 * 65], wsc * q[1 * 65], wsc * q[2 * 65], wsc * q[3 * 65]); o.y = pk4_fp8(wsc * q[4 * 65], wsc * q[5 * 65], wsc * q[6 * 65], wsc * q[7 * 65]);
        o.z = pk4_fp8(wsc * q[8 * 65], wsc * q[9 * 65], wsc * q[10 * 65], wsc * q[11 * 65]); o.w = pk4_fp8(wsc * q[12 * 65], wsc * q[13 * 65], wsc * q[14 * 65], wsc * q[15 * 65]);
        *(v4u*)(dst + (size_t)(drow0 + n) * dld + k0 + 16 * c) = o; }
    LDS_WAIT(); asm volatile("" ::: "memory");
}
__device__ __forceinline__ void p0_small_weights(Frame& F) {
    LAS float* scr = (LAS float*)(F.lds + F.wave * TR_SCR);
    const int gw = F.vcu * NWAVES + F.wave, NGW = F.G * NWAVES;
    constexpr int I_QK = 16 * 32, I_V = 16 * 16, I_O = 16 * 16, I_IN = 16 * 32, I_G = 16 * 16, I_LO = 16 * 16;
    constexpr int NIT = I_QK + I_V + I_O + I_IN + I_G + I_LO;
    for (int it = gw; it < NIT; it += NGW) {
        int r = it;
        if (r < I_QK) { transpose_item(F.in[I_WQKV], 3 * D, (r / 32) * 64, (r % 32) * 64, (bf16*)(F.ws + WS_WQK), D, (r % 32) * 64, scr, F.lane); continue; } r -= I_QK;
        if (r < I_V) { transpose_item(F.in[I_WQKV], 3 * D, (r / 16) * 64, 2 * D + (r % 16) * 64, (bf16*)(F.ws + WS_WV), D, (r % 16) * 64, scr, F.lane); continue; } r -= I_V;
        if (r < I_O) { transpose_item_f8(F.in[I_NAWO], D, (r / 16) * 64, (r % 16) * 64, F.ws + WS_WO, D, (r % 16) * 64, scr, F.lane); continue; } r -= I_O;
        if (r < I_IN) { transpose_item(F.in[I_LWIN], 2 * D, (r / 32) * 64, (r % 32) * 64, (bf16*)(F.ws + WS_WIN), D, (r % 32) * 64, scr, F.lane); continue; } r -= I_IN;
        if (r < I_G) { const int mat = r / 16, q = r % 16; transpose_item_f8(F.in[I_WGATE] + (size_t)mat * 65536, 256, (q / 4) * 64, (q % 4) * 64, F.ws + WS_WG + (size_t)mat * 65536, 256, (q % 4) * 64, scr, F.lane, 16.f); continue; } r -= I_G;
        transpose_item(F.in[I_LWO], D, (r / 16) * 64, (r % 16) * 64, (bf16*)(F.ws + WS_WLO), D, (r % 16) * 64, scr, F.lane);
    }
}
constexpr int MOE_CONV_ITEMS = 3 * NEXP * 128;
constexpr int MOE_CONV_SIDE0 = 4096, MOE_CONV_SIDE1 = 3072, GEMM_G = 240;
struct ConvItem { const float* W; int ldw, k0, n0; unsigned char* dst; int dld, drow0; };
__device__ __forceinline__ ConvItem moe_conv_item(Frame& F, int layer, int it) {
    constexpr int I_1 = NEXP * 16 * 8;
    ConvItem c; int r = it;
    if (r < 2 * I_1) { const int which = r / I_1; r %= I_1; const int e = r / 128, q = r % 128, kb = q / 8, nb = q % 8, n0 = nb * 64;
        c.W = F.in[which ? I_MW3 : I_MW1] + ((size_t)layer * NEXP + e) * (size_t)(D * EFF); c.ldw = EFF; c.k0 = kb * 64; c.n0 = n0;
        c.dst = F.ws + WS_W13 + (size_t)e * (1024 * 1024); c.dld = D; c.drow0 = (n0 / 128) * 256 + which * 128 + (n0 % 128); }
    else { r -= 2 * I_1; const int e = r / 128, q = r % 128, kb = q / 16, nb = q % 16;
        c.W = F.in[I_MW2] + ((size_t)layer * NEXP + e) * (size_t)(EFF * D); c.ldw = D; c.k0 = kb * 64; c.n0 = nb * 64;
        c.dst = F.ws + WS_W2 + (size_t)e * (1024 * 512); c.dld = EFF; c.drow0 = nb * 64; }
    return c;
}
__device__ __forceinline__ void conv_load(const ConvItem& c, int lane, f32x4 (&v)[16]) {
    const int lq = lane >> 4, ln = 4 * (lane & 15);
#pragma unroll
    for (int i = 0; i < 16; ++i) v[i] = *(const f32x4*)(c.W + (size_t)(c.k0 + lq + 4 * i) * c.ldw + c.n0 + ln);
}
__device__ __forceinline__ void conv_moe_weights(Frame& F, int layer, int first, int stride, int end) {
    LAS float* scr = (LAS float*)(F.lds + F.wave * TR_SCR);
    const int lane = F.lane, lq = lane >> 4, ln = 4 * (lane & 15), c4 = lane & 3;
    if (first >= end) return;
    ConvItem cur = moe_conv_item(F, layer, first); f32x4 v[16]; conv_load(cur, lane, v);
    for (int it = first; it < end; it += stride) {
#pragma unroll
        for (int i = 0; i < 16; ++i) { LAS float* q = scr + (lq + 4 * i) * 65 + ln; q[0] = v[i].x; q[1] = v[i].y; q[2] = v[i].z; q[3] = v[i].w; }
        const ConvItem me = cur;
        if (it + stride < end) { cur = moe_conv_item(F, layer, it + stride); conv_load(cur, lane, v); }
        LDS_WAIT(); asm volatile("" ::: "memory");
#pragma unroll
        for (int j = 0; j < 4; ++j) { const int n = (lane >> 2) + 16 * j; const LAS float* q = scr + (16 * c4) * 65 + n;
            v4u o;
            o.x = pk4_fp8(64.f * q[0 * 65], 64.f * q[1 * 65], 64.f * q[2 * 65], 64.f * q[3 * 65]); o.y = pk4_fp8(64.f * q[4 * 65], 64.f * q[5 * 65], 64.f * q[6 * 65], 64.f * q[7 * 65]);
            o.z = pk4_fp8(64.f * q[8 * 65], 64.f * q[9 * 65], 64.f * q[10 * 65], 64.f * q[11 * 65]); o.w = pk4_fp8(64.f * q[12 * 65], 64.f * q[13 * 65], 64.f * q[14 * 65], 64.f * q[15 * 65]);
            *(v4u*)(me.dst + (size_t)(me.drow0 + n) * me.dld + me.k0 + 16 * c4) = o; }
        LDS_WAIT(); asm volatile("" ::: "memory");
    }
}

__device__ __forceinline__ void load_row(const float* p, int lane, f32x4 (&v)[4]) {
#pragma unroll
    for (int j = 0; j < 4; ++j) v[j] = ((const f32x4*)p)[64 * j + lane];
}
__device__ __forceinline__ void load_row_bf16(const bf16* p, int lane, f32x4 (&v)[4]) {
#pragma unroll
    for (int j = 0; j < 4; ++j) { const v2u w = ((const v2u*)p)[64 * j + lane]; v[j] = (f32x4){bflo(w.x), bfhi(w.x), bflo(w.y), bfhi(w.y)}; }
}
__device__ __forceinline__ float row_rstd(const f32x4 (&v)[4]) {
    float s = 0.f;
#pragma unroll
    for (int j = 0; j < 4; ++j) s += (v[j].x * v[j].x + v[j].y * v[j].y) + (v[j].z * v[j].z + v[j].w * v[j].w);
    return __builtin_amdgcn_rsqf(wave_sum(s) * (1.f / D) + EPS);
}
__device__ __forceinline__ void norm_mod(f32x4 (&v)[4], int lane, const float* g, const float* sh, const float* sc) {
    const float rstd = row_rstd(v);
#pragma unroll
    for (int j = 0; j < 4; ++j) { const f32x4 gg = ((const f32x4*)g)[64 * j + lane], s1 = ((const f32x4*)sc)[64 * j + lane], s0 = ((const f32x4*)sh)[64 * j + lane];
        v[j] = (v[j] * rstd) * gg * (s1 + 1.0f) + s0; }
}
__device__ __forceinline__ void store_row_bf16(bf16* o, int lane, const f32x4 (&v)[4]) {
#pragma unroll
    for (int j = 0; j < 4; ++j) { v2u w; w.x = pk2(v[j].x, v[j].y); w.y = pk2(v[j].z, v[j].w); ((v2u*)o)[64 * j + lane] = w; }
}
__device__ __forceinline__ void store_row_f32(float* o, int lane, const f32x4 (&v)[4]) {
#pragma unroll
    for (int j = 0; j < 4; ++j) ((f32x4*)o)[64 * j + lane] = v[j];
}

__device__ __forceinline__ void p1_norm0(Frame& F) {
    const int gw = F.vcu * NWAVES + F.wave, NGW = F.G * NWAVES;
    bf16* HL = (bf16*)(F.ws + WS_A);
    for (int r0 = gw * 4; r0 < MT; r0 += NGW * 4) {
        f32x4 v[4][4];
#pragma unroll
        for (int q = 0; q < 4; ++q) load_row(row_x_in(F, r0 + q), F.lane, v[q]);
#pragma unroll
        for (int q = 0; q < 4; ++q) { const int mr = row_mod(r0 + q);
            norm_mod(v[q], F.lane, F.in[I_NORMG] + 0 * D, modp(F, 0, mr, 0), modp(F, 0, mr, 1));
            store_row_bf16(HL + (size_t)(r0 + q) * D, F.lane, v[q]); asm volatile("" ::: "memory"); }
    }
}

namespace pg8 {
constexpr int FP8_SCALE = 0x7C7C7C7C;
constexpr int BM = 256, BK = 64, HALF = 128, HTB = HALF * BK * 2, STAGE_BYTES = 8 * HTB, NXCD = 8, WGM = 8;
__host__ __device__ __forceinline__ int lds_byte(int r, int c) { const int st = (r >> 4) * 2 + (c >> 5), rr = r & 15, cc = c & 31, ob = rr * 64 + cc * 2; return st * 1024 + (ob ^ (((ob >> 9) & 1) << 5)); }
__host__ __device__ __forceinline__ void stage_rc(int b, int& R, int& C) { const int st = b / 1024, sb = b % 1024, swz = sb ^ (((sb >> 9) & 1) << 5); R = (st >> 1) * 16 + swz / 64; C = (st & 1) * 32 + (swz % 64) / 2; }
__host__ __device__ __forceinline__ int perm32(int rho) { const int n = rho >> 4, i = rho & 15; return 8 * (i >> 2) + 4 * n + (i & 3); }
constexpr int GROW_OFF = 131072;
struct Unit { int pm, pn; const char* a; const char* b; int aux; };
struct Gemm { int nt, lda, ldb; };
__host__ __device__ __forceinline__ bool order_next(int nM, int nN, int G, int c, int i, int& pm, int& pn) {
    const int nwg = nM * nN; const long L = (long)i * G + c; if (L >= nwg) return false;
    int wgid = (int)L; { const int q = nwg / NXCD, r = nwg % NXCD, xcd = wgid % NXCD, off = wgid / NXCD; wgid = (xcd < r ? xcd * (q + 1) : r * (q + 1) + (xcd - r) * q) + off; }
    const int nig = WGM * nN, gid = wgid / nig, fm = gid * WGM, gsz = (nM - fm) < WGM ? (nM - fm) : WGM;
    pm = fm + ((wgid % nig) % gsz); pn = (wgid % nig) / gsz; return true;
}
typedef int v8i __attribute__((ext_vector_type(8)));
typedef int v4i __attribute__((ext_vector_type(4)));
__host__ __device__ __forceinline__ int f8swz(int r) { return ((r >> 1) & 1) | (((r >> 3) & 1) << 2); }
__device__ __forceinline__ unsigned cvt_pk_bf16(float lo, float hi) { unsigned r; asm volatile("v_cvt_pk_bf16_f32 %0, %1, %2" : "=v"(r) : "v"(lo), "v"(hi)); return r; }

template <bool F8> struct Frag;
template <> struct Frag<false> { bf16x8 k[2]; };
template <> struct Frag<true> { v8i v; };
template <class Epi, class Sched, bool FP8 = false, bool ALIGN_EPI = true, bool SP2 = true>
__device__ __forceinline__ void gemm_phase(LAS unsigned char* lds, const Gemm g, const Sched& S, const Epi& E, int wave_id) {
    const int wid = wave_id, lane = (int)__builtin_amdgcn_mbcnt_hi(~0u, __builtin_amdgcn_mbcnt_lo(~0u, 0u)), tid = wid * 64 + lane, wr = wid >> 2, wc = wid & 3, fr = lane & 15, fq = lane >> 4;
    const int nt = g.nt;
    unsigned voffB[2]; int RA[2], CA_[2];
#pragma unroll
    for (int i = 0; i < 2; ++i) { int R, C; const int b_ = tid * 16 + i * 8192;
        if (FP8) { R = b_ >> 7; C = (((b_ >> 4) & 7) ^ f8swz(R)) * 16; } else { stage_rc(b_, R, C); C *= 2; }
        const int Rb = Epi::PERM ? ((R & ~31) + perm32(R & 31)) : R;
        RA[i] = R; CA_[i] = C; voffB[i] = (unsigned)(Rb * g.ldb + C); }
    const size_t kstep = (size_t)(BK * 2);
    const size_t hstepB = (size_t)HALF * g.ldb;
    unsigned vA[2][2], nvA[2][2];
    const unsigned ldsw = (unsigned)wid * 1024u;
    const int aoff = FP8 ? (wr * 64 + fr) * 128 + (((2 * fq) ^ f8swz(fr)) << 4) : lds_byte(wr * 64 + fr, fq * 8);
    const int boff = FP8 ? (wc * 32 + fr) * 128 + (((2 * fq) ^ f8swz(fr)) << 4) : lds_byte(wc * 32 + fr, fq * 8);
#define PG8_SA(b, h) (((b) * 2 + (h)) * HTB)
#define PG8_SB(b, h) ((4 + (b) * 2 + (h)) * HTB)
#define PG8_STAGE(bufoff, gbase, voff) do { _Pragma("unroll") for (int _i = 0; _i < 2; ++_i) \
        __builtin_amdgcn_global_load_lds((const unsigned*)((const char*)(gbase) + (voff)[_i]), (LAS unsigned*)(lds + (bufoff) + ldsw + _i * 8192), 16, 0, 0); } while (0)
#define PG8_LD1(dstf, base_, off_, i_) do { if constexpr (FP8) { dstf.v.lo = *(const LAS v4i*)(lds + (base_) + (off_) + (i_) * 2048); dstf.v.hi = *(const LAS v4i*)(lds + (base_) + ((off_) ^ 16) + (i_) * 2048); } \
        else { dstf.k[0] = *(const LAS bf16x8*)(lds + (base_) + (off_) + (i_) * 2048); dstf.k[1] = *(const LAS bf16x8*)(lds + (base_) + (off_) + (i_) * 2048 + 1024); } } while (0)
#define PG8_LDA(dst, b, h) do { _Pragma("unroll") for (int m = 0; m < 4; ++m) PG8_LD1(dst[m], PG8_SA(b, h), aoff, m); } while (0)
#define PG8_LDB(dst, b, h) do { _Pragma("unroll") for (int n = 0; n < 2; ++n) PG8_LD1(dst[n], PG8_SB(b, h), boff, n); } while (0)
#define PG8_MMA(ai, bj, At, Bt) do { if constexpr (FP8) __builtin_amdgcn_sched_barrier(0); __builtin_amdgcn_s_setprio(1); _Pragma("unroll") for (int m = 0; m < 4; ++m) _Pragma("unroll") for (int n = 0; n < 2; ++n) { \
        if constexpr (FP8) asm volatile("v_mfma_scale_f32_16x16x128_f8f6f4 %0, %1, %2, %0, %3, %4 op_sel_hi:[0,0,0]" : "+v"(acc[ai][bj][m][n]) : "v"(Bt[n].v), "v"(At[m].v), "v"(f8s), "v"(f8s)); \
        else { _Pragma("unroll") for (int k = 0; k < 2; ++k) acc[ai][bj][m][n] = __builtin_amdgcn_mfma_f32_16x16x32_bf16(Bt[n].k[k], At[m].k[k], acc[ai][bj][m][n], 0, 0, 0); } } \
        __builtin_amdgcn_s_setprio(0); if constexpr (FP8) __builtin_amdgcn_sched_barrier(0); } while (0)
#define PG8_NVA(h) ((Sched::GATHER && last) ? nvA[h] : vA[h])
#define PG8_WAIT_V(n) asm volatile("s_waitcnt vmcnt(" #n ")" ::: "memory")
#define PG8_WAIT_L(n) asm volatile("s_waitcnt lgkmcnt(" #n ")" ::: "memory")
#define PG8_BAR __builtin_amdgcn_s_barrier()
#define PG8_SCHED __builtin_amdgcn_sched_barrier(0)
    Unit cur, nxt; int ui = 0;
    if (!S.next(0, cur)) return;
    f32x4 acc[2][2][4][2];
#pragma unroll
    for (int a = 0; a < 2; ++a)
#pragma unroll
        for (int b = 0; b < 2; ++b)
#pragma unroll
            for (int m = 0; m < 4; ++m)
#pragma unroll
                for (int n = 0; n < 2; ++n) acc[a][b][m][n] = (f32x4){0.f, 0.f, 0.f, 0.f};
    Frag<FP8> At[4], B0[2], B1[2];
    int f8s = FP8_SCALE;
    asm volatile("" : "+v"(f8s));
    const char* cA = cur.a; const char* cB = cur.b;
    S.a_offsets(cur, g, RA, CA_, vA);
    if constexpr (SP2) {
        PG8_STAGE(PG8_SB(0, 0), cB, voffB); PG8_STAGE(PG8_SB(0, 1), cB + hstepB, voffB); PG8_STAGE(PG8_SA(0, 0), cA, vA[0]); PG8_STAGE(PG8_SA(0, 1), cA, vA[1]);
        if (wr == 1) PG8_BAR;
        PG8_WAIT_V(2); PG8_BAR;
        PG8_STAGE(PG8_SB(1, 0), cB + kstep, voffB); PG8_STAGE(PG8_SA(1, 0), cA + kstep, vA[0]); PG8_STAGE(PG8_SB(1, 1), cB + hstepB + kstep, voffB);
        PG8_WAIT_V(6); PG8_BAR;
    } else {
        PG8_STAGE(PG8_SB(0, 0), cB, voffB); PG8_STAGE(PG8_SA(0, 0), cA, vA[0]); PG8_STAGE(PG8_SB(0, 1), cB + hstepB, voffB); PG8_STAGE(PG8_SA(0, 1), cA, vA[1]);
        if (wr == 1) PG8_BAR;
        PG8_WAIT_V(4); PG8_BAR;
        PG8_STAGE(PG8_SB(1, 0), cB + kstep, voffB); PG8_STAGE(PG8_SA(1, 0), cA + kstep, vA[0]); PG8_STAGE(PG8_SB(1, 1), cB + hstepB + kstep, voffB);
        PG8_WAIT_V(6); PG8_BAR;
    }
    for (;;) {
        const bool has_next = S.next(ui + 1, nxt);
        const char* nA = has_next ? nxt.a : cA; const char* nB = has_next ? nxt.b : cB;
        if constexpr (Sched::GATHER) {
#pragma unroll
            for (int h = 0; h < 2; ++h)
#pragma unroll
                for (int i = 0; i < 2; ++i) nvA[h][i] = vA[h][i];
        }
        for (int t = 0; t < nt; t += 2) {
            const bool last = (t == nt - 2);
            if constexpr (Sched::GATHER) {
                if (last && has_next) {
#pragma unroll
                    for (int h = 0; h < 2; ++h)
#pragma unroll
                        for (int i = 0; i < 2; ++i) nvA[h][i] = (unsigned)(*(const LAS int*)(lds + GROW_OFF + (h * 128 + RA[i]) * 4) * g.lda + CA_[i]);
                }
                if (t == 0 && has_next && wr == 0) __builtin_amdgcn_global_load_lds((const unsigned*)S.row_ptr(nxt, tid), (LAS unsigned*)(lds + GROW_OFF + wid * 256), 4, 0, 0);
            }
            const char* a1 = cA + (size_t)(t + 1) * kstep;
            const char* a2 = last ? nA : cA + (size_t)(t + 2) * kstep; const char* b2 = last ? nB : cB + (size_t)(t + 2) * kstep;
            const char* a3 = a2 + kstep; const char* b3 = b2 + kstep;
            if constexpr (SP2) {
            PG8_LDB(B0, 0, 0); PG8_LDB(B1, 0, 1); PG8_SCHED; PG8_LDA(At, 0, 0); PG8_STAGE(PG8_SA(1, 1), a1, vA[1]);
            PG8_WAIT_V(8); PG8_WAIT_L(0); PG8_BAR; PG8_MMA(0, 0, At, B0); PG8_MMA(0, 1, At, B1); PG8_BAR; PG8_SCHED;
            PG8_LDA(At, 0, 1); PG8_STAGE(PG8_SB(0, 0), b2, voffB); PG8_STAGE(PG8_SB(0, 1), b2 + hstepB, voffB); PG8_STAGE(PG8_SA(0, 0), a2, PG8_NVA(0));
            PG8_WAIT_V(8); PG8_WAIT_L(0); PG8_BAR; PG8_MMA(1, 0, At, B0); PG8_MMA(1, 1, At, B1); PG8_BAR; PG8_SCHED;
            PG8_LDB(B0, 1, 0); PG8_LDB(B1, 1, 1); PG8_SCHED; PG8_LDA(At, 1, 0); PG8_STAGE(PG8_SA(0, 1), a2, PG8_NVA(1));
            PG8_WAIT_V(8); PG8_WAIT_L(0); PG8_BAR; PG8_MMA(0, 0, At, B0); PG8_MMA(0, 1, At, B1); PG8_BAR; PG8_SCHED;
            PG8_LDA(At, 1, 1); PG8_STAGE(PG8_SB(1, 0), b3, voffB); PG8_STAGE(PG8_SB(1, 1), b3 + hstepB, voffB); PG8_STAGE(PG8_SA(1, 0), a3, PG8_NVA(0));
            PG8_WAIT_V(8); PG8_WAIT_L(0); PG8_BAR; PG8_MMA(1, 0, At, B0); PG8_MMA(1, 1, At, B1); PG8_BAR; PG8_SCHED;
            } else {
            PG8_LDB(B0, 0, 0); PG8_SCHED; PG8_LDA(At, 0, 0); PG8_STAGE(PG8_SA(1, 1), a1, vA[1]);
            PG8_WAIT_L(8); PG8_BAR; PG8_WAIT_L(0); PG8_MMA(0, 0, At, B0); PG8_BAR; PG8_SCHED;
            PG8_LDB(B1, 0, 1); PG8_STAGE(PG8_SB(0, 0), b2, voffB);
            PG8_BAR; PG8_WAIT_L(0); PG8_MMA(0, 1, At, B1); PG8_BAR;
            PG8_LDA(At, 0, 1); PG8_STAGE(PG8_SA(0, 0), a2, PG8_NVA(0));
            PG8_BAR; PG8_WAIT_L(0); PG8_MMA(1, 0, At, B0); PG8_BAR; PG8_SCHED;
            PG8_STAGE(PG8_SB(0, 1), b2 + hstepB, voffB);
            PG8_WAIT_V(6); PG8_BAR; PG8_MMA(1, 1, At, B1); PG8_BAR;
            PG8_LDB(B0, 1, 0); PG8_SCHED; PG8_LDA(At, 1, 0); PG8_STAGE(PG8_SA(0, 1), a2, PG8_NVA(1));
            PG8_WAIT_L(8); PG8_BAR; PG8_WAIT_L(0); PG8_MMA(0, 0, At, B0); PG8_BAR; PG8_SCHED;
            PG8_LDB(B1, 1, 1); PG8_STAGE(PG8_SB(1, 0), b3, voffB);
            PG8_BAR; PG8_WAIT_L(0); PG8_MMA(0, 1, At, B1); PG8_BAR;
            PG8_LDA(At, 1, 1); PG8_STAGE(PG8_SA(1, 0), a3, PG8_NVA(0));
            PG8_BAR; PG8_WAIT_L(0); PG8_MMA(1, 0, At, B0); PG8_BAR; PG8_SCHED;
            PG8_STAGE(PG8_SB(1, 1), b3 + hstepB, voffB);
            PG8_WAIT_V(6); PG8_BAR; PG8_MMA(1, 1, At, B1); PG8_BAR;
            }
        }
        if constexpr (ALIGN_EPI) { if (wr == 0) PG8_BAR; }
        if constexpr (FP8) asm volatile("s_nop 15\n\ts_nop 15" ::: "memory");
        E(acc, cur, wr, wc, fr, fq);
        if (!has_next) break;
#pragma unroll
        for (int a = 0; a < 2; ++a)
#pragma unroll
            for (int b = 0; b < 2; ++b)
#pragma unroll
                for (int m = 0; m < 4; ++m)
#pragma unroll
                    for (int n = 0; n < 2; ++n) acc[a][b][m][n] = (f32x4){0.f, 0.f, 0.f, 0.f};
        cur = nxt; cA = nA; cB = nB; ++ui;
        if constexpr (Sched::GATHER) {
#pragma unroll
            for (int h = 0; h < 2; ++h)
#pragma unroll
                for (int i = 0; i < 2; ++i) vA[h][i] = nvA[h][i];
        }
        if constexpr (ALIGN_EPI) { if (wr == 1) PG8_BAR; }
    }
    PG8_WAIT_V(0);
    if constexpr (!ALIGN_EPI) { if (wr == 0) PG8_BAR; }
    PG8_BAR;
#undef PG8_SA
#undef PG8_SB
#undef PG8_STAGE
#undef PG8_LDA
#undef PG8_LDB
#undef PG8_MMA
#undef PG8_NVA
#undef PG8_LD1
#undef PG8_WAIT_V
#undef PG8_WAIT_L
#undef PG8_BAR
#undef PG8_SCHED
}
}

struct DenseSched {
    static constexpr bool GATHER = false;
    int nM, nN, G, c; const char* A; const char* B; size_t strideA, strideB;
    __device__ __forceinline__ bool next(int i, pg8::Unit& u) const {
        if (!pg8::order_next(nM, nN, G, c, i, u.pm, u.pn)) return false;
        u.a = A + (size_t)u.pm * strideA; u.b = B + (size_t)u.pn * strideB; u.aux = 0; return true;
    }
    __device__ __forceinline__ void a_offsets(const pg8::Unit&, const pg8::Gemm& g, const int (&R)[2], const int (&C)[2], unsigned (&v)[2][2]) const {
#pragma unroll
        for (int h = 0; h < 2; ++h)
#pragma unroll
            for (int i = 0; i < 2; ++i) v[h][i] = (unsigned)((h * 128 + R[i]) * g.lda + C[i]);
    }
};


__device__ __forceinline__ float gelu_tanh(float v) { const float z = 1.5957691216057308f * (v + 0.044715f * v * v * v); return v * __builtin_amdgcn_rcpf(1.f + __expf(-z)); }
__device__ __forceinline__ float sigmoid_f(float v) { return __builtin_amdgcn_rcpf(1.f + __expf(-v)); }
template <int ACT> struct EpiBf16 {
    static constexpr bool PERM = true;
    bf16* O; int ldc; const float* bias; int nscale; float scale;
    __device__ __forceinline__ void operator()(const f32x4 (&acc)[2][2][4][2], const pg8::Unit& u, int wr, int wc, int fr, int fq) const {
        const int row0 = u.pm * 256 + wr * 64 + fr, col0 = u.pn * 256 + wc * 32 + 8 * fq;
        const float sc = u.pn < nscale ? scale : 1.f;
#pragma unroll
        for (int bj = 0; bj < 2; ++bj) {
            const f32x4 zz = (f32x4){0.f, 0.f, 0.f, 0.f};
            const f32x4 b0 = bias ? *(const f32x4*)(bias + col0 + bj * 128) : zz, b1 = bias ? *(const f32x4*)(bias + col0 + bj * 128 + 4) : zz;
#pragma unroll
            for (int ai = 0; ai < 2; ++ai)
#pragma unroll
                for (int m = 0; m < 4; ++m) {
                    f32x4 v0 = (acc[ai][bj][m][0] + b0) * sc, v1 = (acc[ai][bj][m][1] + b1) * sc;
                    if (ACT == 1) { v0 = (f32x4){gelu_tanh(v0.x), gelu_tanh(v0.y), gelu_tanh(v0.z), gelu_tanh(v0.w)}; v1 = (f32x4){gelu_tanh(v1.x), gelu_tanh(v1.y), gelu_tanh(v1.z), gelu_tanh(v1.w)}; }
                    v4u w; w.x = pg8::cvt_pk_bf16(v0.x, v0.y); w.y = pg8::cvt_pk_bf16(v0.z, v0.w); w.z = pg8::cvt_pk_bf16(v1.x, v1.y); w.w = pg8::cvt_pk_bf16(v1.z, v1.w);
                    *(v4u*)(O + (size_t)(row0 + ai * 128 + m * 16) * ldc + col0 + bj * 128) = w;
                    if (m == 3) asm volatile("s_waitcnt vmcnt(0)" ::: "memory");
                }
        }
    }
};
struct EpiF8 {
    static constexpr bool PERM = true;
    unsigned char* O; int ldc;
    __device__ __forceinline__ void operator()(const f32x4 (&acc)[2][2][4][2], const pg8::Unit& u, int wr, int wc, int fr, int fq) const {
        const int row0 = u.pm * 256 + wr * 64 + fr, col0 = u.pn * 256 + wc * 32 + 8 * fq;
#pragma unroll
        for (int bj = 0; bj < 2; ++bj)
#pragma unroll
            for (int ai = 0; ai < 2; ++ai)
#pragma unroll
                for (int m = 0; m < 4; ++m) { const f32x4 v0 = acc[ai][bj][m][0], v1 = acc[ai][bj][m][1];
                    v2u w; w.x = pk4_fp8(v0.x, v0.y, v0.z, v0.w); w.y = pk4_fp8(v1.x, v1.y, v1.z, v1.w);
                    *(v2u*)(O + (size_t)(row0 + ai * 128 + m * 16) * ldc + col0 + bj * 128) = w; }
    }
};
struct EpiBf16RowBias {
    static constexpr bool PERM = true;
    bf16* O; int ldc; const float* bias;
    __device__ __forceinline__ void operator()(const f32x4 (&acc)[2][2][4][2], const pg8::Unit& u, int wr, int wc, int fr, int fq) const {
        const int row0 = u.pm * 256 + wr * 64 + fr, col0 = u.pn * 256 + wc * 32 + 8 * fq;
#pragma unroll
        for (int ai = 0; ai < 2; ++ai)
#pragma unroll
            for (int m = 0; m < 4; ++m) { const int row = row0 + ai * 128 + m * 16; const float b = bias[row];
#pragma unroll
                for (int bj = 0; bj < 2; ++bj) { const f32x4 v0 = acc[ai][bj][m][0] + b, v1 = acc[ai][bj][m][1] + b;
                    v4u w; w.x = pg8::cvt_pk_bf16(v0.x, v0.y); w.y = pg8::cvt_pk_bf16(v0.z, v0.w); w.z = pg8::cvt_pk_bf16(v1.x, v1.y); w.w = pg8::cvt_pk_bf16(v1.z, v1.w);
                    *(v4u*)(O + (size_t)row * ldc + col0 + bj * 128) = w; } }
    }
};
template <bool INPLACE>
struct EpiResid {
    static constexpr bool PERM = true;
    const float* baseL; const float* baseC; bf16* XL; const float* bias; const float* gate;
    __device__ __forceinline__ void operator()(const f32x4 (&acc)[2][2][4][2], const pg8::Unit& u, int wr, int wc, int fr, int fq) const {
        const int rowt = u.pm * 256, col0 = u.pn * 256 + wc * 32 + 8 * fq;
        const bool isc = rowt >= NL; const int mrow = isc ? 8 : (rowt >> 12);
        const float* base = isc ? baseC - (size_t)NL * D : baseL;
        const float* gp = gate + (size_t)mrow * (NMOD * D);
#pragma unroll
        for (int bj = 0; bj < 2; ++bj) { const int col = col0 + bj * 128;
            const f32x4 bv0 = *(const f32x4*)(bias + col), bv1 = *(const f32x4*)(bias + col + 4), gv0 = *(const f32x4*)(gp + col), gv1 = *(const f32x4*)(gp + col + 4);
#pragma unroll
            for (int ai = 0; ai < 2; ++ai) {
                f32x4 x0[4], x1[4];
#pragma unroll
                for (int m = 0; m < 4; ++m) { const size_t off = (size_t)(rowt + ai * 128 + wr * 64 + m * 16 + fr) * D + col;
                    if (INPLACE) { const v4u w = *(const v4u*)(XL + off); x0[m] = (f32x4){bflo(w.x), bfhi(w.x), bflo(w.y), bfhi(w.y)}; x1[m] = (f32x4){bflo(w.z), bfhi(w.z), bflo(w.w), bfhi(w.w)}; }
                    else { x0[m] = *(const f32x4*)(base + off); x1[m] = *(const f32x4*)(base + off + 4); } }
#pragma unroll
                for (int m = 0; m < 4; ++m) { const size_t off = (size_t)(rowt + ai * 128 + wr * 64 + m * 16 + fr) * D + col;
                    const f32x4 y0 = x0[m] + gv0 * (acc[ai][bj][m][0] + bv0), y1 = x1[m] + gv1 * (acc[ai][bj][m][1] + bv1);
                    v4u o; o.x = pg8::cvt_pk_bf16(y0.x, y0.y); o.y = pg8::cvt_pk_bf16(y0.z, y0.w); o.z = pg8::cvt_pk_bf16(y1.x, y1.y); o.w = pg8::cvt_pk_bf16(y1.z, y1.w);
                    *(v4u*)(XL + off) = o; } } }
    }
};

constexpr size_t WS_G = 208 * MiB, WS_UPRE = 272 * MiB, WS_GH = 340 * MiB;
constexpr int SCT = 64, NCHUNK = 68, AT_STRIDE = 528;
typedef float f32x4v __attribute__((ext_vector_type(4)));
constexpr size_t WS_UC8 = WS_HDN;
constexpr size_t WS_UC = WS_A;
__device__ __forceinline__ void conv_phase(Frame& F) {
    const bf16* UPRE = (const bf16*)(F.ws + WS_UPRE); bf16* UC = (bf16*)(F.ws + WS_UC); unsigned char* UC8 = F.ws + WS_UC8;
    const int ch8 = F.tid & 127, c0 = 8 * ch8;
    float cw[4][8], cb[8];
#pragma unroll
    for (int k = 0; k < 4; ++k) { const f32x4 a = *(const f32x4*)(F.in[I_CONVW] + k * D + c0), bq = *(const f32x4*)(F.in[I_CONVW] + k * D + c0 + 4);
        cw[k][0] = a.x; cw[k][1] = a.y; cw[k][2] = a.z; cw[k][3] = a.w; cw[k][4] = bq.x; cw[k][5] = bq.y; cw[k][6] = bq.z; cw[k][7] = bq.w; }
    { const f32x4 a = *(const f32x4*)(F.in[I_CONVB] + c0), bq = *(const f32x4*)(F.in[I_CONVB] + c0 + 4); cb[0] = a.x; cb[1] = a.y; cb[2] = a.z; cb[3] = a.w; cb[4] = bq.x; cb[5] = bq.y; cb[6] = bq.z; cb[7] = bq.w; }
    const int ng = MT / 4;
    for (int gi = F.vcu * 4 + (F.tid >> 7); gi < ng; gi += F.G * 4) {
        const int r0 = gi * 4;
        int s0, len; if (r0 < NL) { s0 = r0 & ~(SEQ - 1); len = SEQ; } else { s0 = NL + ((r0 - NL) & ~(CTXL - 1)); len = CTXL; }
        float x[7][8];
#pragma unroll
        for (int i = 0; i < 7; ++i) { const int r = r0 - 2 + i;
            v4u raw = (v4u){0u, 0u, 0u, 0u};
            if (r >= s0 && r < s0 + len) raw = *(const v4u*)(UPRE + (size_t)r * D + c0);
            x[i][0] = bflo(raw.x); x[i][1] = bfhi(raw.x); x[i][2] = bflo(raw.y); x[i][3] = bfhi(raw.y); x[i][4] = bflo(raw.z); x[i][5] = bfhi(raw.z); x[i][6] = bflo(raw.w); x[i][7] = bfhi(raw.w); }
#pragma unroll
        for (int tt = 0; tt < 4; ++tt) { float o[8];
#pragma unroll
            for (int c = 0; c < 8; ++c) o[c] = cb[c] + x[tt][c] * cw[0][c] + x[tt + 1][c] * cw[1][c] + x[tt + 2][c] * cw[2][c] + x[tt + 3][c] * cw[3][c];
            v4u wv; wv.x = pk2(o[0], o[1]); wv.y = pk2(o[2], o[3]); wv.z = pk2(o[4], o[5]); wv.w = pk2(o[6], o[7]);
            *(v4u*)(UC + (size_t)(r0 + tt) * D + c0) = wv;
            v2u w8; w8.x = pk4_fp8(o[0], o[1], o[2], o[3]); w8.y = pk4_fp8(o[4], o[5], o[6], o[7]); *(v2u*)(UC8 + (size_t)(r0 + tt) * D + c0) = w8; }
    }
}
constexpr int SW_AGG = 16384, SW_A = 20480, SW_ATILE = 32 * 256, SW_U = SW_A + 8 * SW_ATILE, SW_G = SW_U + 8 * 2560;
constexpr int SW_MTN = 2, SW_T = 16 * SW_MTN;
constexpr int SW_NCTX = CTXL / SW_T, SW_NCH = (CTXL + SEQ) / SW_T, SW_STEPS = (SW_NCH + 7) / 8;
constexpr int SW_F8SCALE = 0x7D7D7D7D;
static_assert(SW_MTN == 2 && SW_G + 8 * 2560 <= RTAB_BYTES, "sweep LDS map");
__device__ __forceinline__ void rows4(float x, float (&r)[4]) {
    typedef unsigned u32x2 __attribute__((ext_vector_type(2)));
    const unsigned xi = __builtin_bit_cast(unsigned, x);
    const u32x2 p16 = __builtin_amdgcn_permlane16_swap(xi, xi, false, false);
    const u32x2 pa = __builtin_amdgcn_permlane32_swap(p16.x, p16.x, false, false);
    const u32x2 pb = __builtin_amdgcn_permlane32_swap(p16.y, p16.y, false, false);
    r[0] = __uint_as_float(pa[0]); r[1] = __uint_as_float(pb[0]); r[2] = __uint_as_float(pa[1]); r[3] = __uint_as_float(pb[1]);
}
template <int DIR>
__device__ __forceinline__ void scan_sweep(Frame& F) {
    constexpr int MTN = SW_MTN;
    const int lane = F.lane, w = F.wave, g = lane >> 4, lc = lane & 15;
    const int c = F.vcu, b = c >> 5, nb = (c >> 3) & 3, cg = c & 7;
    const bf16* UC = (const bf16*)(F.ws + WS_UC); const unsigned char* UC8 = F.ws + WS_UC8; const unsigned char* WG8 = F.ws + WS_WG;
    const bf16* Gp = (const bf16*)(F.ws + WS_G); bf16* GH = (bf16*)(F.ws + WS_GH);
#pragma unroll
    for (int i = 0; i < 2; ++i) { const int pid = F.tid + 512 * i, n = pid >> 4, pp = pid & 15; const int nt = n >> 4, j = n & 15, ct = nt >> 1, gate = nt & 1;
        const v4u v = *(const v4u*)(WG8 + ((size_t)(((DIR * 2 + gate) * 4 + nb) * 256 + 32 * cg + 16 * ct + j)) * 256 + pp * 16);
        *(LAS v4u*)(F.lds + n * 256 + ((pp ^ (n & 15)) << 4)) = v; }
    float br[2], bi[2], lam8[2], hprev[2];
#pragma unroll
    for (int ct = 0; ct < 2; ++ct) { const int ch = nb * 256 + 32 * cg + 16 * ct + lc;
        br[ct] = F.in[I_BGATE][(DIR * 2 + 0) * D + ch]; bi[ct] = F.in[I_BGATE][(DIR * 2 + 1) * D + ch];
        lam8[ct] = -8.f * log1pf(__expf(-F.in[I_LAMBDA][DIR * D + ch])); hprev[ct] = 0.f; }
    LAS f32x2* AGG = (LAS f32x2*)(F.lds + SW_AGG);
    LAS unsigned char* AT = F.lds + SW_A + w * SW_ATILE;
    LAS unsigned char* UT = F.lds + SW_U + w * 2560;
    LAS unsigned char* GS = F.lds + SW_G + w * 2560;
    int f8s = SW_F8SCALE; asm volatile("" : "+v"(f8s));
#define SW_CI(idx_) (DIR == 0 ? (idx_) : ((idx_) < SW_NCTX ? SW_NCTX - 1 - (idx_) : SW_NCH + SW_NCTX - 1 - (idx_)))
#define SW_ROW0(ci_) ((ci_) < SW_NCTX ? NL + b * CTXL + (ci_) * SW_T : b * SEQ + ((ci_) - SW_NCTX) * SW_T)
#define SW_LOADA(row0_) do { const unsigned char* ap_ = UC8 + (size_t)((row0_) + (lane >> 4)) * D + nb * 256 + 16 * (lane & 15); \
        _Pragma("unroll") for (int i = 0; i < 8; ++i) areg[i] = *(const v4u*)(ap_ + (size_t)(4 * i) * D); \
        _Pragma("unroll") for (int i = 0; i < 2; ++i) { const int pp_ = lane + 64 * i; ureg[i] = *(const v4u*)(UC + (size_t)((row0_) + (pp_ >> 2)) * D + nb * 256 + 32 * cg + 8 * (pp_ & 3)); } } while (0)
    v4u areg[8], ureg[2];
    { const int ci0 = SW_CI(w); SW_LOADA(SW_ROW0(ci0)); }
    __syncthreads();
    for (int s = 0; s < SW_STEPS; ++s) {
        const int idx = 8 * s + w; const bool active = idx < SW_NCH;
        const int ci = SW_CI(idx); const bool isctx = ci < SW_NCTX; const int row0 = SW_ROW0(ci);
        float Pc[2][MTN][4], Hc[2][MTN][4], CA[2], CB[2]; v4u hfr[MTN], gr[MTN];
        CA[0] = 1.f; CB[0] = 0.f; CA[1] = 1.f; CB[1] = 0.f;
        if (active) {
            f32x4 acc[MTN][4]; float uu[2][MTN][4];
#pragma unroll
            for (int mt = 0; mt < MTN; ++mt)
#pragma unroll
                for (int nt = 0; nt < 4; ++nt) acc[mt][nt] = (f32x4){0.f, 0.f, 0.f, 0.f};
#pragma unroll
            for (int i = 0; i < 8; ++i) { const int r = 4 * i + (lane >> 4); *(LAS v4u*)(AT + r * 256 + (((lane & 15) ^ (r & 15)) << 4)) = areg[i]; }
#pragma unroll
            for (int i = 0; i < 2; ++i) { const int pp = lane + 64 * i; *(LAS v4u*)(UT + (pp >> 2) * 80 + 16 * (pp & 3)) = ureg[i]; }
            asm volatile("s_waitcnt lgkmcnt(0)" ::: "memory");
#pragma unroll
            for (int ct = 0; ct < 2; ++ct)
#pragma unroll
                for (int mt = 0; mt < MTN; ++mt)
#pragma unroll
                    for (int r = 0; r < 4; ++r) uu[ct][mt][r] = bf2f(*(const LAS unsigned short*)(UT + (16 * mt + 4 * g + r) * 80 + (16 * ct + lc) * 2));
#pragma unroll
            for (int kb = 0; kb < 2; ++kb) {
                pg8::v8i bfr[4], afr[MTN];
#pragma unroll
                for (int nt = 0; nt < 4; ++nt) { const LAS unsigned char* rp = F.lds + (16 * nt + lc) * 256;
                    bfr[nt].lo = *(const LAS pg8::v4i*)(rp + (((2 * g + 8 * kb) ^ lc) << 4)); bfr[nt].hi = *(const LAS pg8::v4i*)(rp + (((2 * g + 1 + 8 * kb) ^ lc) << 4)); }
#pragma unroll
                for (int mt = 0; mt < MTN; ++mt) { const LAS unsigned char* rp = AT + (16 * mt + lc) * 256;
                    afr[mt].lo = *(const LAS pg8::v4i*)(rp + (((2 * g + 8 * kb) ^ lc) << 4)); afr[mt].hi = *(const LAS pg8::v4i*)(rp + (((2 * g + 1 + 8 * kb) ^ lc) << 4)); }
#pragma unroll
                for (int mt = 0; mt < MTN; ++mt)
#pragma unroll
                    for (int nt = 0; nt < 4; ++nt)
                        asm volatile("v_mfma_scale_f32_16x16x128_f8f6f4 %0, %1, %2, %0, %3, %3 op_sel_hi:[0,0,0]" : "+v"(acc[mt][nt]) : "v"(afr[mt]), "v"(bfr[nt]), "v"(f8s));
            }
            asm volatile("s_nop 15\n\ts_nop 15\n\ts_waitcnt lgkmcnt(0)" ::: "memory");
            if (idx + 8 < SW_NCH) { const int nci = SW_CI(idx + 8); SW_LOADA(SW_ROW0(nci)); }
            if (DIR == 1 && !isctx) {
#pragma unroll
                for (int i = 0; i < MTN; ++i) { const int pp = lane + 64 * i; const size_t off = (size_t)(row0 + (pp >> 2)) * D + nb * 256 + 32 * cg + 8 * (pp & 3);
                    hfr[i] = *(const v4u*)(GH + off); gr[i] = *(const v4u*)(Gp + off); }
            }
#pragma unroll
            for (int ct = 0; ct < 2; ++ct) {
                float a[MTN][4], bc[MTN][4];
#pragma unroll
                for (int mt = 0; mt < MTN; ++mt)
#pragma unroll
                    for (int r = 0; r < 4; ++r) {
                        const float rg = __builtin_amdgcn_rcpf(1.f + __expf(-(acc[mt][ct * 2 + 0][r] + br[ct]))), ig = __builtin_amdgcn_rcpf(1.f + __expf(-(acc[mt][ct * 2 + 1][r] + bi[ct])));
                        const float av = __expf(lam8[ct] * rg); a[mt][r] = av; bc[mt][r] = __builtin_amdgcn_sqrtf(fmaxf(1.f - av * av, 0.f)) * (ig * uu[ct][mt][r]); }
                float ca = 1.f, cbv = 0.f;
#pragma unroll
                for (int q4 = 0; q4 < MTN; ++q4) { const int mt = DIR == 0 ? q4 : MTN - 1 - q4;
                    float A = 1.f, B = 0.f;
#pragma unroll
                    for (int rr = 0; rr < 4; ++rr) { const int r = DIR == 0 ? rr : 3 - rr; A = A * a[mt][r]; B = a[mt][r] * B + bc[mt][r]; }
                    float ta = 1.f, tb = 0.f, ea = 1.f, eb = 0.f, Ar[4], Br[4];
                    rows4(A, Ar); rows4(B, Br);
#pragma unroll
                    for (int q = 0; q < 4; ++q) { const int gg = DIR == 0 ? q : 3 - q;
                        const float Ag = Ar[gg], Bg = Br[gg];
                        if (gg == g) { ea = ta; eb = tb; }
                        tb = Ag * tb + Bg; ta = ta * Ag; }
                    float pa = ea * ca, pb = ea * cbv + eb;
#pragma unroll
                    for (int rr = 0; rr < 4; ++rr) { const int r = DIR == 0 ? rr : 3 - rr; pb = a[mt][r] * pb + bc[mt][r]; pa = pa * a[mt][r]; Pc[ct][mt][r] = pa; Hc[ct][mt][r] = pb; }
                    cbv = ta * cbv + tb; ca = ca * ta; }
                CA[ct] = ca; CB[ct] = cbv;
            }
        }
        if (g == 0) { AGG[(((s & 1) * 8 + w) * 2 + 0) * 16 + lc] = (f32x2){CA[0], CB[0]}; AGG[(((s & 1) * 8 + w) * 2 + 1) * 16 + lc] = (f32x2){CA[1], CB[1]}; }
        __syncthreads();
        float hin[2];
#pragma unroll
        for (int ct = 0; ct < 2; ++ct) { float h = hprev[ct]; hin[ct] = h;
#pragma unroll
            for (int ww = 0; ww < 8; ++ww) { const f32x2 ab = AGG[(((s & 1) * 8 + ww) * 2 + ct) * 16 + lc]; if (ww == w) hin[ct] = h; h = ab.x * h + ab.y; }
            hprev[ct] = h; }
        if (active && !isctx) {
            LAS unsigned char* US = AT;
            if (DIR == 1) {
#pragma unroll
                for (int i = 0; i < MTN; ++i) { const int pp = lane + 64 * i; *(LAS v4u*)(US + (pp >> 2) * 80 + 16 * (pp & 3)) = hfr[i]; *(LAS v4u*)(GS + (pp >> 2) * 80 + 16 * (pp & 3)) = gr[i]; }
                asm volatile("s_waitcnt lgkmcnt(0)" ::: "memory");
            }
#pragma unroll
            for (int ct = 0; ct < 2; ++ct)
#pragma unroll
                for (int mt = 0; mt < MTN; ++mt)
#pragma unroll
                    for (int r = 0; r < 4; ++r) { const float h = Pc[ct][mt][r] * hin[ct] + Hc[ct][mt][r];
                        const int so = (16 * mt + 4 * g + r) * 80 + (16 * ct + lc) * 2;
                        float o = h;
                        if (DIR == 1) o = (bf2f(*(const LAS unsigned short*)(US + so)) + h) * bf2f(*(const LAS unsigned short*)(GS + so));
                        *(LAS unsigned short*)(US + so) = (unsigned short)f2bf(o); }
            asm volatile("s_waitcnt lgkmcnt(0)" ::: "memory");
#pragma unroll
            for (int i = 0; i < MTN; ++i) { const int pp = lane + 64 * i; const size_t off = (size_t)(row0 + (pp >> 2)) * D + nb * 256 + 32 * cg + 8 * (pp & 3);
                *(v4u*)(GH + off) = *(const LAS v4u*)(US + (pp >> 2) * 80 + 16 * (pp & 3)); }
            asm volatile("s_waitcnt lgkmcnt(0)" ::: "memory");
        }
    }
#undef SW_CI
#undef SW_ROW0
#undef SW_LOADA
    __syncthreads();
}

constexpr float LOG2E = 1.4426950408889634f;
__device__ __forceinline__ bf16x8 pack8(const f32x4 a, const f32x4 b) {
    v4u w; w.x = pg8::cvt_pk_bf16(a.x, a.y); w.y = pg8::cvt_pk_bf16(a.z, a.w); w.z = pg8::cvt_pk_bf16(b.x, b.y); w.w = pg8::cvt_pk_bf16(b.z, b.w);
    return __builtin_bit_cast(bf16x8, w);
}
constexpr int AK_C = 0, AV_C = 32768, AK_W = 67584, AV_W = 67584, A_RPB = 143360;
__device__ __forceinline__ int kswz(int k) { return ((k >> 1) & 1) | (((k >> 3) & 3) << 1); }
__device__ __forceinline__ void attn_stage_ctx(Frame& F, const bf16* QK, const bf16* VT, int b, int h) {
    v4u kr[4], vr[4]; int tid_ = F.tid; asm volatile("" : "+v"(tid_));
#pragma unroll
    for (int i = 0; i < 4; ++i) { const int pid = tid_ + 512 * i; { const int key = pid >> 3, c = pid & 7; kr[i] = *(const v4u*)(QK + (size_t)(NL + b * CTXL + key) * 2048 + 1024 + h * 64 + c * 8); }
        { const int dim = pid >> 5, c = pid & 31; vr[i] = *(const v4u*)(VT + (size_t)(h * 64 + dim) * MT + NL + b * CTXL + c * 8); } }
#pragma unroll
    for (int i = 0; i < 4; ++i) { const int pid = tid_ + 512 * i; { const int key = pid >> 3, c = pid & 7; *(LAS v4u*)(F.lds + AK_C + key * 128 + ((c ^ kswz(key & 31)) << 4)) = kr[i]; }
        { const int dim = pid >> 5, c = pid & 31; *(LAS v4u*)(F.lds + AV_C + dim * 544 + c * 16) = vr[i]; } }
    __syncthreads();
}
__device__ __forceinline__ void attn_load_kw(const bf16* QK, int b, int h, int rb, int tid, v4u (&kr)[9]) {
    asm volatile("" : "+v"(tid));
#pragma unroll
    for (int i = 0; i < 9; ++i) { const int pid = tid + 512 * i, key = pid >> 3, c = pid & 7; int row = rb + (key >> 6); row = row > 63 ? 63 : row;
        kr[i] = *(const v4u*)(QK + (size_t)(b * SEQ + row * 64 + (key & 63)) * 2048 + 1024 + h * 64 + c * 8); }
}
__device__ __forceinline__ void attn_store_kw(LAS unsigned char* lds, int tid, const v4u (&kr)[9]) {
    asm volatile("" : "+v"(tid));
#pragma unroll
    for (int i = 0; i < 9; ++i) { const int pid = tid + 512 * i, key = pid >> 3, c = pid & 7; *(LAS v4u*)(lds + AK_W + key * 128 + ((c ^ kswz(key & 31)) << 4)) = kr[i]; }
}
__device__ __forceinline__ void attn_load_vw(const bf16* VT, int b, int h, int rb, int tid, v4u (&vr)[9]) {
    asm volatile("" : "+v"(tid));
#pragma unroll
    for (int i = 0; i < 9; ++i) { const int pid = tid + 512 * i, dim = pid / 72, c = pid % 72; int row = rb + (c >> 3); row = row > 63 ? 63 : row;
        vr[i] = *(const v4u*)(VT + (size_t)(h * 64 + dim) * MT + b * SEQ + row * 64 + (c & 7) * 8); }
}
__device__ __forceinline__ void attn_store_vw(LAS unsigned char* lds, int tid, const v4u (&vr)[9]) {
    asm volatile("" : "+v"(tid));
#pragma unroll
    for (int i = 0; i < 9; ++i) { const int pid = tid + 512 * i, dim = pid / 72, c = pid % 72; *(LAS v4u*)(lds + AV_W + dim * 1184 + c * 16) = vr[i]; }
}
constexpr int AV_T = LDSCTL_OFF + 1024;
__device__ __forceinline__ void attn_dma_vw(LAS unsigned char* lds, const bf16* VT, int b, int h, int rb, int w, int lane) {
    unsigned voff = (unsigned)lane * 16u; asm volatile("" : "+v"(voff));
#pragma unroll
    for (int j = 0; j < 8; ++j) { const int dim = 8 * w + j;
        const char* src = (const char*)(VT + (size_t)(h * 64 + dim) * MT + b * SEQ + rb * 64);
        __builtin_amdgcn_global_load_lds((const unsigned*)(src + voff), (LAS unsigned*)(lds + AV_W + dim * 1184), 16, 0, 0); }
    { const char* src = (const char*)(VT + (size_t)(h * 64 + 8 * w) * MT + b * SEQ + (rb + 8) * 64);
      __builtin_amdgcn_global_load_lds((const unsigned*)(src + (size_t)(voff >> 7) * (MT * 2) + (voff & 127u)), (LAS unsigned*)(lds + AV_T + w * 1024), 16, 0, 0); }
}
__device__ __forceinline__ float xrow_max(float x) {
    auto s = __builtin_amdgcn_permlane16_swap(__float_as_uint(x), __float_as_uint(x), false, false); x = fmaxf(__uint_as_float(s[0]), __uint_as_float(s[1]));
    auto t = __builtin_amdgcn_permlane32_swap(__float_as_uint(x), __float_as_uint(x), false, false); return fmaxf(__uint_as_float(t[0]), __uint_as_float(t[1]));
}
__device__ __forceinline__ float xrow_sum(float x) {
    auto s = __builtin_amdgcn_permlane16_swap(__float_as_uint(x), __float_as_uint(x), false, false); x = __uint_as_float(s[0]) + __uint_as_float(s[1]);
    auto t = __builtin_amdgcn_permlane32_swap(__float_as_uint(x), __float_as_uint(x), false, false); return __uint_as_float(t[0]) + __uint_as_float(t[1]);
}
template <bool LAT>
__device__ __forceinline__ void attn_unit(Frame& F, const bf16* QK, const bf16* VT, bf16* O, int b, int h, int rp_or_half, v4u (&kr)[9], bool has_next, int nrb) {
    int lane_ = F.lane; asm volatile("" : "+v"(lane_));
    const int lane = lane_, g = lane >> 4, lc = lane & 15, w = F.wave;
    const f32x4 zero4 = (f32x4){0.f, 0.f, 0.f, 0.f};
    int r = 0, qt = 0, tokq0, span0 = 0, rs = 0, rb = 0, wro = 0;
    if (LAT) { r = 2 * rp_or_half + (w >> 2); qt = w & 3; tokq0 = b * SEQ + r * 64 + 16 * qt; span0 = qt == 0 ? 0 : (qt == 1 ? 8 : (qt == 2 ? 24 : 32));
        rs = r - 4 < 0 ? 0 : (r - 4 > 56 ? 56 : r - 4); const int r0 = 2 * rp_or_half; rb = r0 - 4 < 0 ? 0 : (r0 - 4 > 56 ? 56 : r0 - 4); wro = rs - rb; }
    else { tokq0 = NL + b * CTXL + rp_or_half * 128 + 16 * w; }
    const bf16* qp = QK + (size_t)(tokq0 + lc) * 2048 + h * 64 + 8 * g;
    const bf16x8 qf0 = *(const bf16x8*)qp, qf1 = *(const bf16x8*)(qp + 32);
    if (LAT) { attn_store_kw(F.lds, F.tid, kr); __builtin_amdgcn_sched_barrier(0); }
    const int kk0 = 8 * (lc >> 2) + (lc & 3);
    f32x4 sc[8][2]; bf16x8 pc[8]; f32x4 o[4];
#pragma unroll
    for (int cp = 0; cp < 8; ++cp)
#pragma unroll
        for (int p = 0; p < 2; ++p) { const int key = 32 * cp + kk0 + 4 * p; const int sz = kswz(key & 31);
            const bf16x8 k0 = *(const LAS bf16x8*)(F.lds + AK_C + key * 128 + ((g ^ sz) << 4)), k1 = *(const LAS bf16x8*)(F.lds + AK_C + key * 128 + (((4 + g) ^ sz) << 4));
            f32x4 a = __builtin_amdgcn_mfma_f32_16x16x32_bf16(k0, qf0, zero4, 0, 0, 0);
            sc[cp][p] = __builtin_amdgcn_mfma_f32_16x16x32_bf16(k1, qf1, a, 0, 0, 0); if (p == 1) asm volatile("" ::: "memory"); }
    float l = 0.f, mc = -1e30f;
#define ATT_CMAX() do { _Pragma("unroll") for (int i_ = 0; i_ < 8; ++i_) _Pragma("unroll") for (int p_ = 0; p_ < 2; ++p_) _Pragma("unroll") for (int j_ = 0; j_ < 4; ++j_) mc = fmaxf(mc, sc[i_][p_][j_]); mc = xrow_max(mc); } while (0)
#define ATT_CEXP(cp_) do { f32x4 e_[2]; _Pragma("unroll") for (int p_ = 0; p_ < 2; ++p_) _Pragma("unroll") for (int j_ = 0; j_ < 4; ++j_) { e_[p_][j_] = __builtin_amdgcn_exp2f(sc[cp_][p_][j_] - mc); l += e_[p_][j_]; } \
        pc[cp_] = pack8(e_[0], e_[1]); asm volatile("" : "+v"(l));   } while (0)
#define ATT_PVC(cp_) do { _Pragma("unroll") for (int dt = 0; dt < 4; ++dt) { const bf16x8 vf = *(const LAS bf16x8*)(F.lds + AV_C + (16 * dt + lc) * 544 + (32 * (cp_) + 8 * g) * 2); \
        o[dt] = __builtin_amdgcn_mfma_f32_16x16x32_bf16(vf, pc[cp_], o[dt], 0, 0, 0); } asm volatile("" ::: "memory"); } while (0)
    if (LAT) {
        f32x4 sw[8][2]; bf16x8 pw[8];
        __syncthreads();
#pragma unroll
        for (int i = 0; i < 8; ++i) {
#pragma unroll
            for (int p = 0; p < 2; ++p) { const int key = (wro + i) * 64 + span0 + kk0 + 4 * p; const int sz = kswz(key & 31);
                const bf16x8 k0 = *(const LAS bf16x8*)(F.lds + AK_W + key * 128 + ((g ^ sz) << 4)), k1 = *(const LAS bf16x8*)(F.lds + AK_W + key * 128 + (((4 + g) ^ sz) << 4));
                f32x4 a = __builtin_amdgcn_mfma_f32_16x16x32_bf16(k0, qf0, zero4, 0, 0, 0);
                sw[i][p] = __builtin_amdgcn_mfma_f32_16x16x32_bf16(k1, qf1, a, 0, 0, 0); }
            asm volatile("" ::: "memory");
            if (i == 0) ATT_CMAX(); else ATT_CEXP(i - 1);
            __builtin_amdgcn_sched_barrier(0);
        }
        ATT_CEXP(7);
        __syncthreads();
        attn_dma_vw(F.lds, VT, b, h, rb, w, lane);
        const LAS float* RPB = (const LAS float*)(F.lds + A_RPB);
        const int c = 16 * qt + lc; const int cs = c - 8 < 0 ? 0 : (c - 8 > 48 ? 48 : c - 8);
        const int cb0 = span0 + 8 * g;
        float mw = -1e30f, m2 = mc, alpha = 1.f;
#pragma unroll
        for (int dt = 0; dt < 4; ++dt) o[dt] = zero4;
#define ATT_WBIAS(i_) do { const LAS float* rowb = RPB + (rs + (i_) - r + 7) * 31 + (cb0 - c + 15); float bv[8]; \
        _Pragma("unroll") for (int x = 0; x < 8; ++x) bv[x] = rowb[x]; \
        asm volatile("" : "+v"(bv[0]), "+v"(bv[1]), "+v"(bv[2]), "+v"(bv[3]), "+v"(bv[4]), "+v"(bv[5]), "+v"(bv[6]), "+v"(bv[7]));   \
        _Pragma("unroll") for (int p_ = 0; p_ < 2; ++p_) _Pragma("unroll") for (int j_ = 0; j_ < 4; ++j_) { const bool ok = (unsigned)(cb0 - cs + 4 * p_ + j_) < 16u; \
            const float v_ = ok ? sw[i_][p_][j_] + bv[4 * p_ + j_] : -1e30f; sw[i_][p_][j_] = v_; mw = fmaxf(mw, v_); } } while (0)
#define ATT_WEXP(i_) do { f32x4 e_[2]; _Pragma("unroll") for (int p_ = 0; p_ < 2; ++p_) _Pragma("unroll") for (int j_ = 0; j_ < 4; ++j_) { e_[p_][j_] = __builtin_amdgcn_exp2f(sw[i_][p_][j_] - m2); l += e_[p_][j_]; } \
        pw[i_] = pack8(e_[0], e_[1]); asm volatile("" : "+v"(l)); } while (0)
#pragma unroll
        for (int cp = 0; cp < 8; ++cp) {
            ATT_PVC(cp);
            if (cp < 4) { ATT_WBIAS(2 * cp); ATT_WBIAS(2 * cp + 1); }
            else if (cp == 4) { mw = xrow_max(mw); m2 = fmaxf(mc, mw); alpha = __builtin_amdgcn_exp2f(mc - m2); l *= alpha; }
            else if (cp == 5) { ATT_WEXP(0); ATT_WEXP(1); ATT_WEXP(2); }
            else if (cp == 6) { ATT_WEXP(3); ATT_WEXP(4); ATT_WEXP(5); }
            else { ATT_WEXP(6); ATT_WEXP(7); }
            __builtin_amdgcn_sched_barrier(0);
        }
#pragma unroll
        for (int dt = 0; dt < 4; ++dt) o[dt] = o[dt] * alpha;
        asm volatile("s_waitcnt vmcnt(0)" ::: "memory");
        __syncthreads();
        if (has_next) attn_load_kw(QK, b, h, nrb, F.tid, kr);
#pragma unroll
        for (int i = 0; i < 8; ++i)
#pragma unroll
            for (int dt = 0; dt < 4; ++dt) { const int dim = 16 * dt + lc;
                const int voffs = (i == 7 && wro == 1) ? AV_T + dim * 128 + (span0 + 8 * g) * 2 : AV_W + dim * 1184 + ((wro + i) * 64 + span0 + 8 * g) * 2;
                const bf16x8 vf = *(const LAS bf16x8*)(F.lds + voffs); o[dt] = __builtin_amdgcn_mfma_f32_16x16x32_bf16(vf, pw[i], o[dt], 0, 0, 0); if (dt == 3) asm volatile("" ::: "memory"); }
#undef ATT_WBIAS
#undef ATT_WEXP
    } else {
        ATT_CMAX();
#pragma unroll
        for (int cp = 0; cp < 8; ++cp) ATT_CEXP(cp);
#pragma unroll
        for (int dt = 0; dt < 4; ++dt) o[dt] = zero4;
#pragma unroll
        for (int cp = 0; cp < 8; ++cp) ATT_PVC(cp);
    }
#undef ATT_CMAX
#undef ATT_CEXP
#undef ATT_PVC
    l = xrow_sum(l);
    const float inv = __builtin_amdgcn_rcpf(l);
    unsigned char* op = (unsigned char*)O + (size_t)(tokq0 + lc) * D + h * 64 + 4 * g;
#pragma unroll
    for (int dt = 0; dt < 4; ++dt) *(unsigned*)(op + 16 * dt) = pk4_fp8(o[dt].x * inv, o[dt].y * inv, o[dt].z * inv, o[dt].w * inv);
    if (LAT) __syncthreads();
}
__device__ __forceinline__ void attn_phase(Frame& F) {
    const bf16* QK = (const bf16*)(F.ws + WS_B);
    const bf16* VT = (const bf16*)(F.ws + WS_C);
    bf16* O = (bf16*)(F.ws + WS_A);
    const int NUB = BATCH * NHEAD * 32, per = (NUB + F.G - 1) / F.G;
    int u0 = F.vcu * per, u1 = u0 + per; if (u1 > NUB) u1 = NUB;
    int cb = -1, ch = -1; v4u kr[9];
    for (int u = u0; u < u1; ++u) {
        const int b = u >> 9, h = (u >> 5) & 15, rp = u & 31;
        if (b != cb || h != ch) { __syncthreads(); attn_stage_ctx(F, QK, VT, b, h); if (F.tid < 465) ((LAS float*)(F.lds + A_RPB))[F.tid] = F.in[I_RPB][h * 465 + F.tid] * LOG2E; cb = b; ch = h;
            { const int r0 = 2 * rp; attn_load_kw(QK, b, h, r0 - 4 < 0 ? 0 : (r0 - 4 > 56 ? 56 : r0 - 4), F.tid, kr); } __syncthreads(); }
        const int un = u + 1; const bool hn = un < u1 && (un >> 5) == (u >> 5); const int nr0 = 2 * (un & 31);
        attn_unit<true>(F, QK, VT, O, b, h, rp, kr, hn, nr0 - 4 < 0 ? 0 : (nr0 - 4 > 56 ? 56 : nr0 - 4));
        if (un < u1 && !hn) { cb = -1; }
    }
    for (int u = F.vcu; u < BATCH * NHEAD * 2; u += F.G) {
        const int b = u >> 5, h = (u >> 1) & 15, half = u & 1;
        if (b != cb || h != ch) { __syncthreads(); attn_stage_ctx(F, QK, VT, b, h); cb = b; ch = h; }
        attn_unit<false>(F, QK, VT, O, b, h, half, kr, false, 0);
    }
    __syncthreads();
}
constexpr int LC_CNT = 256, LC_BASE = 384, LC_TSTART = 512, LC_ECNT = 768, LC_REC = 1024;
struct RouteRec { int e0, e1, p0, p1; float w0, w1; int pad0, pad1; };
__device__ __forceinline__ void reduce8(const float (&a)[8], float (&out)[8], int lane) {
#define R8_DPP(x, ctrl) __builtin_bit_cast(float, __builtin_amdgcn_update_dpp(0, __builtin_bit_cast(int, x), ctrl, 0xF, 0xF, false))
    float t[4], u[2];
#pragma unroll
    for (int i = 0; i < 4; ++i) { auto r = __builtin_amdgcn_permlane32_swap(__float_as_uint(a[i]), __float_as_uint(a[i + 4]), false, false); t[i] = __uint_as_float(r[0]) + __uint_as_float(r[1]); }
#pragma unroll
    for (int i = 0; i < 2; ++i) { auto r = __builtin_amdgcn_permlane16_swap(__float_as_uint(t[i]), __float_as_uint(t[i + 2]), false, false); u[i] = __uint_as_float(r[0]) + __uint_as_float(r[1]); }
    const bool hi8 = (lane & 8) != 0;
    float keep = hi8 ? u[1] : u[0]; const float send = hi8 ? u[0] : u[1];
    keep += R8_DPP(send, 0x128);
    keep += R8_DPP(keep, 0x141); keep += R8_DPP(keep, 0xB1); keep += R8_DPP(keep, 0x4E);
#pragma unroll
    for (int k = 0; k < 8; ++k) out[k] = __builtin_bit_cast(float, __builtin_amdgcn_readlane(__builtin_bit_cast(int, keep), 8 * k));
#undef R8_DPP
}
__device__ __forceinline__ void norm2_router(Frame& F, int layer, int nrows) {
    LAS f32x4* WT = (LAS f32x4*)F.lds;
    LAS int* cnt = (LAS int*)(F.lds + LDSCTL_OFF + LC_CNT); LAS int* base = (LAS int*)(F.lds + LDSCTL_OFF + LC_BASE);
    LAS v4u* rec = (LAS v4u*)(F.lds + LDSCTL_OFF + LC_REC);
    const float* wg = F.in[I_MWG] + (size_t)layer * D * 4; const float* we = F.in[I_MWE] + (size_t)layer * 4 * D * 8;
    { f32x4 wt[18];
#pragma unroll
      for (int q = 0; q < 18; ++q) { const int pid = F.tid + NTHREADS * q; const int plane = pid >> 10, pos = pid & 1023, k = 4 * (pos & 63) + 256 * (pos >> 8) + ((pos >> 6) & 3);
          wt[q] = plane == 0 ? *(const f32x4*)(wg + k * 4) : *(const f32x4*)(we + ((size_t)((plane - 1) >> 1) * 1024 + k) * 8 + ((plane - 1) & 1) * 4); }
#pragma unroll
      for (int q = 0; q < 18; ++q) WT[F.tid + NTHREADS * q] = wt[q]; }
    if (F.tid < 32) cnt[F.tid] = 0;
    __syncthreads();
    const int rpb = nrows / F.G, rbase = blockIdx.x * rpb;
    const float* gam = F.in[I_NORMG] + (layer * 2 + 1) * D;
    unsigned char* HL2 = F.ws + WS_HL2;
    const float* bg = F.in[I_MBG] + layer * 4; const float* be = F.in[I_MBE] + layer * 32;
    typedef float f32x2 __attribute__((ext_vector_type(2)));
    int cur_mr = -1; f32x4 mA[4], mB[4]; v2u raw[2][4];
    const bf16* XLp = (const bf16*)(F.ws + WS_XL);
    if (F.wave < rpb / 2) {
#pragma unroll
        for (int q = 0; q < 2; ++q)
#pragma unroll
            for (int j = 0; j < 4; ++j) raw[q][j] = ((const v2u*)(XLp + (size_t)(rbase + 2 * F.wave + q) * D))[64 * j + F.lane]; }
    for (int pr = F.wave; pr < rpb / 2; pr += NWAVES) {
        f32x4 v[2][4];
#pragma unroll
        for (int q = 0; q < 2; ++q)
#pragma unroll
            for (int j = 0; j < 4; ++j) { const v2u w = raw[q][j]; v[q][j] = (f32x4){bflo(w.x), bfhi(w.x), bflo(w.y), bfhi(w.y)}; }
        if (pr + NWAVES < rpb / 2) {
#pragma unroll
            for (int q = 0; q < 2; ++q)
#pragma unroll
                for (int j = 0; j < 4; ++j) raw[q][j] = ((const v2u*)(XLp + (size_t)(rbase + 2 * (pr + NWAVES) + q) * D))[64 * j + F.lane]; }
#pragma unroll
        for (int q = 0; q < 2; ++q) { const int r = rbase + 2 * pr + q; const int mr = row_mod(r);
            if (mr != cur_mr) { cur_mr = mr; const float* sc = modp(F, layer, mr, 4); const float* sh = modp(F, layer, mr, 3);
#pragma unroll
                for (int j = 0; j < 4; ++j) { mA[j] = ((const f32x4*)gam)[64 * j + F.lane] * (((const f32x4*)sc)[64 * j + F.lane] + 1.0f); mB[j] = ((const f32x4*)sh)[64 * j + F.lane]; } }
            const float rstd = row_rstd(v[q]);
#pragma unroll
            for (int j = 0; j < 4; ++j) v[q][j] = (v[q][j] * rstd) * mA[j] + mB[j];
#pragma unroll
            for (int j = 0; j < 4; ++j) ((unsigned*)(HL2 + (size_t)r * D))[64 * j + F.lane] = pk4_fp8(v[q][j].x, v[q][j].y, v[q][j].z, v[q][j].w); }
        f32x2 ga2[2][2];
#pragma unroll
        for (int q = 0; q < 2; ++q) { ga2[q][0] = (f32x2){0.f, 0.f}; ga2[q][1] = (f32x2){0.f, 0.f}; }
#pragma unroll
        for (int j = 0; j < 4; ++j)
#pragma unroll
            for (int i = 0; i < 4; ++i) { const f32x4 w = WT[(4 * j + i) * 64 + F.lane];
                const f32x2 wlo = (f32x2){w.x, w.y}, whi = (f32x2){w.z, w.w};
#pragma unroll
                for (int q = 0; q < 2; ++q) { const float x = v[q][j][i]; const f32x2 xs = (f32x2){x, x};
                    ga2[q][0] = __builtin_elementwise_fma(xs, wlo, ga2[q][0]); ga2[q][1] = __builtin_elementwise_fma(xs, whi, ga2[q][1]); } }
        float ga[2][4];
#pragma unroll
        for (int q = 0; q < 2; ++q) { ga[q][0] = ga2[q][0].x; ga[q][1] = ga2[q][0].y; ga[q][2] = ga2[q][1].x; ga[q][3] = ga2[q][1].y; }
        float gsum[8];
        { float gin[8];
#pragma unroll
          for (int q = 0; q < 2; ++q)
#pragma unroll
              for (int n = 0; n < 4; ++n) gin[4 * q + n] = ga[q][n];
          reduce8(gin, gsum, F.lane); }
#pragma unroll
        for (int q = 0; q < 2; ++q) {
            float gl[4];
#pragma unroll
            for (int n = 0; n < 4; ++n) gl[n] = gsum[4 * q + n] + bg[n];
            int gs = 0; float gm = gl[0];
#pragma unroll
            for (int n = 1; n < 4; ++n) if (gl[n] > gm) { gm = gl[n]; gs = n; }
            gs = __builtin_amdgcn_readfirstlane(gs);
            float den = 0.f;
#pragma unroll
            for (int n = 0; n < 4; ++n) den += __expf(gl[n] - gm);
            const float gprob = 1.f / den;
            const LAS f32x4* wb = WT + (1 + 2 * gs) * 1024 + F.lane;
            float el[8]; f32x2 el2[4];
#pragma unroll
            for (int x = 0; x < 4; ++x) el2[x] = (f32x2){0.f, 0.f};
#pragma unroll
            for (int j = 0; j < 4; ++j)
#pragma unroll
                for (int i = 0; i < 4; ++i) { const f32x4 w0 = wb[(4 * j + i) * 64], w1 = wb[1024 + (4 * j + i) * 64];
                    const float x_ = v[q][j][i]; const f32x2 xs = (f32x2){x_, x_};
                    el2[0] = __builtin_elementwise_fma(xs, (f32x2){w0.x, w0.y}, el2[0]); el2[1] = __builtin_elementwise_fma(xs, (f32x2){w0.z, w0.w}, el2[1]);
                    el2[2] = __builtin_elementwise_fma(xs, (f32x2){w1.x, w1.y}, el2[2]); el2[3] = __builtin_elementwise_fma(xs, (f32x2){w1.z, w1.w}, el2[3]); }
#pragma unroll
            for (int x = 0; x < 4; ++x) { el[2 * x] = el2[x].x; el[2 * x + 1] = el2[x].y; }
            { float es[8]; reduce8(el, es, F.lane);
#pragma unroll
              for (int x = 0; x < 8; ++x) el[x] = es[x] + be[gs * 8 + x]; }
            int i0 = 0; float v0 = el[0];
#pragma unroll
            for (int x = 1; x < 8; ++x) if (el[x] > v0) { v0 = el[x]; i0 = x; }
            int i1 = -1; float v1 = -3.0e38f;
#pragma unroll
            for (int x = 0; x < 8; ++x) if (x != i0 && el[x] > v1) { v1 = el[x]; i1 = x; }
            const float w0 = 1.f / (1.f + __expf(v1 - v0));
            if (F.lane == 0) { const int e0 = gs * 8 + i0, e1 = gs * 8 + i1;
                const int p0 = __hip_atomic_fetch_add(&cnt[e0], 1, __ATOMIC_RELAXED, __HIP_MEMORY_SCOPE_WORKGROUP), p1 = __hip_atomic_fetch_add(&cnt[e1], 1, __ATOMIC_RELAXED, __HIP_MEMORY_SCOPE_WORKGROUP);
                rec[2 * (2 * pr + q)] = (v4u){(unsigned)e0, (unsigned)e1, (unsigned)p0, (unsigned)p1};
                rec[2 * (2 * pr + q) + 1] = (v4u){__builtin_bit_cast(unsigned, gprob * w0), __builtin_bit_cast(unsigned, gprob * (1.f - w0)), 0u, 0u}; }
        }
    }
    __syncthreads();
    unsigned* gcnt = (unsigned*)(F.ws + WS_CTL) + CW_ECNT + layer * 1024;
    if (F.tid < 32) base[F.tid] = (int)__hip_atomic_fetch_add(gcnt + F.tid * 32, (unsigned)cnt[F.tid], RLX_AGENT);
    __syncthreads();
    v4u* ROUTE = (v4u*)(F.ws + WS_ROUTE); int* SRCROW = (int*)(F.ws + WS_SRCROW);
    for (int i = F.tid; i < rpb; i += NTHREADS) { v4u a = rec[2 * i]; const v4u b2 = rec[2 * i + 1]; a.z += (unsigned)base[a.x]; a.w += (unsigned)base[a.y]; ROUTE[2 * (rbase + i)] = a; ROUTE[2 * (rbase + i) + 1] = b2;
        SRCROW[(size_t)a.x * MT + a.z] = rbase + i; SRCROW[(size_t)a.y * MT + a.w] = rbase + i; }
    __syncthreads();
}
__device__ __forceinline__ void moe_tile_starts(Frame& F, int layer) {
    LAS int* ts = (LAS int*)(F.lds + LDSCTL_OFF + LC_TSTART);
    if (F.wave == 0) {
        const unsigned* gcnt = (const unsigned*)(F.ws + WS_CTL) + CW_ECNT + layer * 1024; LAS int* ec = (LAS int*)(F.lds + LDSCTL_OFF + LC_ECNT);
        const int lane = F.lane; const int cn = lane < 32 ? (int)__hip_atomic_load(gcnt + lane * 32, RLX_AGENT) : 0; const int tiles = (cn + 255) >> 8;
        int incl = tiles;
#pragma unroll
        for (int d = 1; d < 32; d <<= 1) { const int t = __shfl_up(incl, d); if (lane >= d) incl += t; }
        if (lane < 32) { ec[lane] = cn; ts[lane] = incl - tiles; }
        if (lane == 31) ts[32] = incl; }
    __syncthreads();
}
template <bool GATHER_>
struct MoeSched {
    static constexpr bool GATHER = GATHER_;
    const LAS int* ts; int G, c; const char* A; const char* B; size_t strideA, strideBe, strideBn; const int* srcrow;
    __device__ __forceinline__ bool next(int i, pg8::Unit& u) const {
        if (!pg8::order_next(__builtin_amdgcn_readfirstlane(ts[32]), 4, G, c, i, u.pm, u.pn)) return false;
        const int lane = (int)__builtin_amdgcn_mbcnt_hi(~0u, __builtin_amdgcn_mbcnt_lo(~0u, 0u));
        const int e = __builtin_popcount((unsigned)__builtin_amdgcn_ballot_w64(ts[lane & 31] <= u.pm)) - 1;
        u.a = GATHER ? A : A + (size_t)u.pm * strideA; u.b = B + (size_t)e * strideBe + (size_t)u.pn * strideBn; u.aux = e; return true;
    }
    __device__ __forceinline__ const int* row_ptr(const pg8::Unit& u, int r) const {
        const int e = u.aux; const int p0 = (u.pm - __builtin_amdgcn_readfirstlane(ts[e])) * 256; const int cn = __builtin_amdgcn_readfirstlane(ts[64 + e]);
        const int pos = p0 + r; return srcrow + (size_t)e * MT + (pos < cn ? pos : p0);
    }
    __device__ __forceinline__ int row_of(const pg8::Unit& u, int r) const { return *row_ptr(u, r); }
    __device__ __forceinline__ void a_offsets(const pg8::Unit& u, const pg8::Gemm& g, const int (&R)[2], const int (&C)[2], unsigned (&v)[2][2]) const {
        if (GATHER) {
            int row[2][2];
#pragma unroll
            for (int h = 0; h < 2; ++h)
#pragma unroll
                for (int i = 0; i < 2; ++i) row[h][i] = row_of(u, h * 128 + R[i]);
#pragma unroll
            for (int h = 0; h < 2; ++h)
#pragma unroll
                for (int i = 0; i < 2; ++i) v[h][i] = (unsigned)(row[h][i] * g.lda + C[i]);
        } else {
#pragma unroll
            for (int h = 0; h < 2; ++h)
#pragma unroll
                for (int i = 0; i < 2; ++i) v[h][i] = (unsigned)((h * 128 + R[i]) * g.lda + C[i]);
        }
    }
};
static_assert(LC_ECNT - LC_TSTART == 256, "MoeSched reads the expert counts at ts[64 + e]");
struct EpiSwiglu {
    static constexpr bool PERM = true;
    unsigned char* O;
    __device__ __forceinline__ void operator()(const f32x4 (&acc)[2][2][4][2], const pg8::Unit& u, int wr, int wc, int fr, int fq) const {
        const int row0 = u.pm * 256 + wr * 64 + fr, col0 = u.pn * 128 + wc * 32 + 8 * fq;
#pragma unroll
        for (int ai = 0; ai < 2; ++ai)
#pragma unroll
            for (int m = 0; m < 4; ++m) {
                f32x4 h0, h1;
#pragma unroll
                for (int j = 0; j < 4; ++j) { const float a = acc[ai][0][m][0][j], b = acc[ai][0][m][1][j]; h0[j] = a * __builtin_amdgcn_rcpf(1.f + __expf(-a)) * acc[ai][1][m][0][j]; h1[j] = b * __builtin_amdgcn_rcpf(1.f + __expf(-b)) * acc[ai][1][m][1][j]; }
                v2u w; w.x = pk4_fp8(h0.x, h0.y, h0.z, h0.w); w.y = pk4_fp8(h1.x, h1.y, h1.z, h1.w);
                *(v2u*)(O + (size_t)(row0 + ai * 128 + m * 16) * EFF + col0) = w;
            }
    }
};
__device__ __forceinline__ void moe_gemm1(Frame& F, int layer) {
    moe_tile_starts(F, layer);
    const pg8::Gemm g{8, D, D};
    MoeSched<true> S{(const LAS int*)(F.lds + LDSCTL_OFF + LC_TSTART), F.G, (int)blockIdx.x, (const char*)(F.ws + WS_HL2), (const char*)(F.ws + WS_W13), 0, (size_t)1024 * 1024, (size_t)256 * D, (const int*)(F.ws + WS_SRCROW)};
    EpiSwiglu E{F.ws + WS_HDN};
    pg8::gemm_phase<EpiSwiglu, MoeSched<true>, true>(F.lds, g, S, E, F.wave);
}
__device__ __forceinline__ void moe_gemm2(Frame& F, int layer) {
    moe_tile_starts(F, layer);
    const pg8::Gemm g{4, EFF, EFF};
    MoeSched<false> S{(const LAS int*)(F.lds + LDSCTL_OFF + LC_TSTART), F.G, (int)blockIdx.x, (const char*)(F.ws + WS_HDN), (const char*)(F.ws + WS_W2), (size_t)256 * EFF, (size_t)1024 * 512, (size_t)256 * EFF, nullptr};
    EpiF8 E{F.ws + WS_XS, D};
    pg8::gemm_phase<EpiF8, MoeSched<false>, true>(F.lds, g, S, E, F.wave);
}
template <int MODE>
__device__ __forceinline__ void moe_combine(Frame& F, int layer, int nrows) {
    moe_tile_starts(F, layer);
    const LAS int* ts = (const LAS int*)(F.lds + LDSCTL_OFF + LC_TSTART);
    const int gw = F.vcu * NWAVES + F.wave, NGW = F.G * NWAVES;
    const RouteRec* ROUTE = (const RouteRec*)(F.ws + WS_ROUTE); const unsigned char* YS = F.ws + WS_XS;
    bf16* HL = (bf16*)(F.ws + WS_A);
    for (int r0 = gw * 2; r0 < nrows; r0 += NGW * 2) {
        RouteRec rr[2]; f32x4 v[2][4]; unsigned ya[2][4], yb[2][4];
#pragma unroll
        for (int q = 0; q < 2; ++q) { rr[q] = ROUTE[r0 + q]; load_row_bf16((const bf16*)(F.ws + WS_XL) + (size_t)(r0 + q) * D, F.lane, v[q]); }
#pragma unroll
        for (int q = 0; q < 2; ++q) { const int p0 = rr[q].p0 + ts[rr[q].e0] * 256, p1 = rr[q].p1 + ts[rr[q].e1] * 256;
#pragma unroll
            for (int j = 0; j < 4; ++j) { ya[q][j] = ((const unsigned*)(YS + (size_t)p0 * D))[64 * j + F.lane]; yb[q][j] = ((const unsigned*)(YS + (size_t)p1 * D))[64 * j + F.lane]; } }
#pragma unroll
        for (int q = 0; q < 2; ++q) { const int r = r0 + q;
            bf16* xp = (bf16*)(F.ws + WS_XL) + (size_t)r * D;
            const int mr = row_mod(r); const float* gt = modp(F, layer, mr, 5);
#pragma unroll
            for (int j = 0; j < 4; ++j) { const f32x2 a0 = __builtin_amdgcn_cvt_pk_f32_fp8((int)ya[q][j], false), a1 = __builtin_amdgcn_cvt_pk_f32_fp8((int)ya[q][j], true);
                const f32x2 b0 = __builtin_amdgcn_cvt_pk_f32_fp8((int)yb[q][j], false), b1 = __builtin_amdgcn_cvt_pk_f32_fp8((int)yb[q][j], true);
                const f32x4 fa = (f32x4){a0.x, a0.y, a1.x, a1.y}, fb = (f32x4){b0.x, b0.y, b1.x, b1.y};
                v[q][j] = v[q][j] + ((const f32x4*)gt)[64 * j + F.lane] * (fa * rr[q].w0 + fb * rr[q].w1); }
            if (MODE == 0) {
                store_row_bf16(xp, F.lane, v[q]);
                norm_mod(v[q], F.lane, F.in[I_NORMG] + 2 * D, modp(F, 1, mr, 0), modp(F, 1, mr, 1));
                store_row_bf16(HL + (size_t)r * D, F.lane, v[q]);
            } else {
                const float rstd = row_rstd(v[q]);
#pragma unroll
                for (int j = 0; j < 4; ++j) v[q][j] = (v[q][j] * rstd) * ((const f32x4*)F.in[I_FINALG])[64 * j + F.lane];
                store_row_f32(F.out + (size_t)r * D, F.lane, v[q]);
            }
            asm volatile("" ::: "memory");
        }
    }
}

__global__ void __launch_bounds__(NTHREADS, 2) fwd_kernel(Args args) {
    extern __shared__ __attribute__((aligned(16))) unsigned char lds[];
    Frame F;
    F.lds = (LAS unsigned char*)lds;
    F.tid = threadIdx.x; F.lane = F.tid & 63; F.wave = __builtin_amdgcn_readfirstlane(F.tid >> 6);
    F.G = gridDim.x; { const int bx = blockIdx.x; F.vcu = (F.G % 8 == 0) ? (bx % 8) * (F.G / 8) + bx / 8 : bx; }
    F.in = (const float* const __attribute__((address_space(4)))*)__builtin_amdgcn_kernarg_segment_ptr(); F.out = args.out; F.ws = args.ws;
    static_assert(offsetof(Args, in) == 0 && offsetof(Args, out) == N_IN * 8 && offsetof(Args, ws) == N_IN * 8 + 8, "kernarg table: inputs, out, ws");
    unsigned* ctl = (unsigned*)(F.ws + WS_CTL);
    for (int u = F.tid; u < (LDS_BYTES - LDSCTL_OFF) / 4; u += NTHREADS) ((LAS unsigned*)(F.lds + LDSCTL_OFF))[u] = 0u;
    __syncthreads();
    XcdBarrier bar = xcd_barrier_post(ctl + CW_BAR, (volatile LAS unsigned*)(F.lds + LDSCTL_OFF + 64));
    const int lo = args.ph_lo, hi = args.ph_hi;
#define PH_BEGIN(k) { constexpr int k_ = (k); { asm volatile("" : "+s"(F.in));  F.out = (float*)F.in[N_IN]; F.ws = (unsigned char*)F.in[N_IN + 1]; if (lo <= k_ && k_ < hi)
#define PH_END } if (lo <= k_ && k_ + 1 < hi) xcd_barrier(bar); }

    PH_BEGIN(0) { p0_mod(F); __syncthreads(); p0_small_weights(F); conv_moe_weights(F, 0, MOE_CONV_SIDE0 + F.vcu * NWAVES + F.wave, F.G * NWAVES, MOE_CONV_ITEMS); }
    PH_END
    PH_BEGIN(1) { p1_norm0(F); }
    PH_END
    PH_BEGIN(2) {
        const pg8::Gemm g{16, 2 * D, 2 * D};
        if ((int)blockIdx.x < GEMM_G) {
        { DenseSched S{136, 8, GEMM_G, (int)blockIdx.x, (const char*)(F.ws + WS_A), (const char*)(F.ws + WS_WQK), (size_t)256 * D * 2, (size_t)256 * D * 2};
          EpiBf16<0> E{(bf16*)(F.ws + WS_B), 2048, F.in[I_BQKV], 4, 0.125f * LOG2E};
          pg8::gemm_phase(F.lds, g, S, E, F.wave); }
        { DenseSched S{4, 136, GEMM_G, GEMM_G - 1 - (int)blockIdx.x, (const char*)(F.ws + WS_WV), (const char*)(F.ws + WS_A), (size_t)256 * D * 2, (size_t)256 * D * 2};
          EpiBf16RowBias E{(bf16*)(F.ws + WS_C), MT, F.in[I_BQKV] + 2 * D};
          pg8::gemm_phase(F.lds, g, S, E, F.wave); }
        } else conv_moe_weights(F, 0, ((int)blockIdx.x - GEMM_G) * NWAVES + F.wave, (F.G - GEMM_G) * NWAVES, MOE_CONV_SIDE0);
    }
    PH_END
    PH_BEGIN(3) { attn_phase(F); }
    PH_END
    PH_BEGIN(4) {
        const pg8::Gemm g{8, D, D};
        DenseSched S{136, 4, F.G, (int)blockIdx.x, (const char*)(F.ws + WS_A), (const char*)(F.ws + WS_WO), (size_t)256 * D, (size_t)256 * D};
        EpiResid<false> E{F.in[I_X], F.in[I_CTX], (bf16*)(F.ws + WS_XL), F.in[I_NABO], modp(F, 0, 0, 2)};
        pg8::gemm_phase<EpiResid<false>, DenseSched, true>(F.lds, g, S, E, F.wave);
    }
    PH_END
    PH_BEGIN(5) { norm2_router(F, 0, MT); }
    PH_END
    PH_BEGIN(6) { moe_gemm1(F, 0); }
    PH_END
    PH_BEGIN(7) { moe_gemm2(F, 0); }
    PH_END
    PH_BEGIN(8) { moe_combine<0>(F, 0, MT); conv_moe_weights(F, 1, MOE_CONV_SIDE1 + F.vcu * NWAVES + F.wave, F.G * NWAVES, MOE_CONV_ITEMS); }
    PH_END
    PH_BEGIN(9) {
        const pg8::Gemm g{16, 2 * D, 2 * D};
        if ((int)blockIdx.x < GEMM_G) {
        { DenseSched S{128, 4, GEMM_G, (int)blockIdx.x, (const char*)(F.ws + WS_A), (const char*)(F.ws + WS_WIN), (size_t)256 * D * 2, (size_t)256 * D * 2};
          EpiBf16<1> E{(bf16*)(F.ws + WS_G), D, F.in[I_LBIN], 0, 1.f};
          pg8::gemm_phase(F.lds, g, S, E, F.wave); }
        { DenseSched S{136, 4, GEMM_G, GEMM_G - 1 - (int)blockIdx.x, (const char*)(F.ws + WS_A), (const char*)(F.ws + WS_WIN) + (size_t)D * D * 2, (size_t)256 * D * 2, (size_t)256 * D * 2};
          EpiBf16<0> E{(bf16*)(F.ws + WS_UPRE), D, F.in[I_LBIN] + D, 0, 1.f};
          pg8::gemm_phase(F.lds, g, S, E, F.wave); }
        } else conv_moe_weights(F, 1, ((int)blockIdx.x - GEMM_G) * NWAVES + F.wave, (F.G - GEMM_G) * NWAVES, MOE_CONV_SIDE1);
    }
    PH_END
    PH_BEGIN(10) { conv_phase(F); }
    PH_END
    PH_BEGIN(11) { scan_sweep<0>(F); asm volatile("s_waitcnt vmcnt(0)" ::: "memory"); __syncthreads(); scan_sweep<1>(F); }
    PH_END
    PH_BEGIN(12) {
        const pg8::Gemm g{16, 2 * D, 2 * D};
        DenseSched S{128, 4, F.G, (int)blockIdx.x, (const char*)(F.ws + WS_GH), (const char*)(F.ws + WS_WLO), (size_t)256 * D * 2, (size_t)256 * D * 2};
        EpiResid<true> E{nullptr, nullptr, (bf16*)(F.ws + WS_XL), F.in[I_LBO], modp(F, 1, 0, 2)};
        pg8::gemm_phase(F.lds, g, S, E, F.wave);
    }
    PH_END
    PH_BEGIN(13) { norm2_router(F, 1, NL); }
    PH_END
    PH_BEGIN(14) { moe_gemm1(F, 1); }
    PH_END
    PH_BEGIN(15) { moe_gemm2(F, 1); }
    PH_END
    PH_BEGIN(16) { moe_combine<1>(F, 1, NL); }
    PH_END
#undef PH_BEGIN
#undef PH_END
}

__global__ void diag_fill(float* out, float v, int n) { for (int i = blockIdx.x * blockDim.x + threadIdx.x; i < n; i += gridDim.x * blockDim.x) out[i] = v; }
extern "C" void kernel_launch(void* const* d_in, const int* in_sizes, int n_in, void* d_out, int out_size, void* d_ws, size_t ws_size, hipStream_t stream) {
    static int grid = 0; static float diag = 0.f;
    if (grid == 0) {
        if (n_in != N_IN || out_size != NL * D || ws_size < WS_END) { fprintf(stderr, "kernel_launch: unexpected shapes: n_in %d out %d ws %zu (need %zu)\n", n_in, out_size, ws_size, (size_t)WS_END); grid = -1; diag = 2.f; }
        else {
        int dev = 0, cus = 0, per_cu = 0;
        if (hipGetDevice(&dev) != hipSuccess || hipDeviceGetAttribute(&cus, hipDeviceAttributeMultiprocessorCount, dev) != hipSuccess) { grid = -1; diag = 3.f; }
        else if (hipFuncSetAttribute((const void*)fwd_kernel, hipFuncAttributeMaxDynamicSharedMemorySize, LDS_BYTES) != hipSuccess) { fprintf(stderr, "kernel_launch: hipFuncSetAttribute failed\n"); grid = -1; diag = 4.f; }
        else if (hipOccupancyMaxActiveBlocksPerMultiprocessor(&per_cu, (const void*)fwd_kernel, NTHREADS, LDS_BYTES) != hipSuccess || per_cu < 1) { fprintf(stderr, "kernel_launch: occupancy query says %d blocks/CU\n", per_cu); (void)hipGetLastError(); grid = -1; diag = 5.f; }
        else if (cus != 256) { fprintf(stderr, "kernel_launch: built for 256 CUs, device has %d\n", cus); grid = -1; diag = 7.f; }
        else grid = cus;
        }
    }
    if (grid < 0) { diag_fill<<<256, 256, 0, stream>>>((float*)d_out, diag, out_size); return; }
    if (hipMemsetAsync((char*)d_ws + WS_CTL, 0, CTL_ZERO_BYTES, stream) != hipSuccess) { fprintf(stderr, "kernel_launch: memset failed\n"); return; }
    Args a{};
    for (int i = 0; i < N_IN; ++i) a.in[i] = (const float*)d_in[i];
    a.out = (float*)d_out; a.ws = (unsigned char*)d_ws; a.ph_lo = 0; a.ph_hi = 1000;
    void* kargs[] = {&a};
    hipError_t e = hipLaunchCooperativeKernel((const void*)fwd_kernel, dim3(grid), dim3(NTHREADS), kargs, LDS_BYTES, stream);
    if (e != hipSuccess) { fprintf(stderr, "kernel_launch: cooperative launch failed: %s (grid %d)\n", hipGetErrorString(e), grid); (void)hipGetLastError(); diag_fill<<<256, 256, 0, stream>>>((float*)d_out, 6.f, out_size); }
}
```

```cpp
#include <hip/hip_runtime.h>
#include <cstdio>
#include <cstdint>
#include <cstddef>

#define GAS __attribute__((address_space(1)))
#define LAS __attribute__((address_space(3)))
typedef unsigned short bf16;
typedef unsigned v4u __attribute__((ext_vector_type(4)));
typedef unsigned v2u __attribute__((ext_vector_type(2)));
typedef float f32x4 __attribute__((ext_vector_type(4)));
typedef float f32x2 __attribute__((ext_vector_type(2)));
typedef short bf16x8 __attribute__((ext_vector_type(8)));

constexpr int D = 1024, BATCH = 8, SEQ = 4096, CTXL = 256, GRIDW = 64;
constexpr int NL = BATCH * SEQ;
constexpr int NC = BATCH * CTXL;
constexpr int MT = NL + NC;
constexpr int NMOD = 6, NHEAD = 16, HD = 64;
constexpr int NEXP = 32, EFF = 512;
constexpr float EPS = 1e-6f;
constexpr int NWAVES = 8, NTHREADS = 512;

enum { I_X = 0, I_C, I_CTX, I_CCTX, I_ADAW, I_ADAB, I_NORMG, I_WQKV, I_BQKV, I_RPB, I_NAWO, I_NABO, I_LWIN, I_LBIN, I_CONVW, I_CONVB, I_WGATE, I_BGATE,
       I_LAMBDA, I_LWO, I_LBO, I_MWG, I_MBG, I_MWE, I_MBE, I_MW1, I_MW3, I_MW2, I_FINALG, N_IN };

constexpr size_t MiB = 1u << 20;
constexpr size_t WS_CTL = 0, CTL_ZERO_BYTES = 1 * MiB;
constexpr size_t WS_MOD = 1 * MiB;
constexpr size_t WS_WQK = 2 * MiB;
constexpr size_t WS_WV = 6 * MiB;
constexpr size_t WS_WO = 8 * MiB;
constexpr size_t WS_WIN = 10 * MiB;
constexpr size_t WS_WG = 14 * MiB;
constexpr size_t WS_WLO = 16 * MiB;
constexpr size_t WS_SRCROW = 18 * MiB;
constexpr size_t WS_W13 = 32 * MiB;
constexpr size_t WS_W2 = 112 * MiB;
constexpr size_t WS_XL = 428 * MiB;
constexpr size_t WS_ROUTE = 136 * MiB;
constexpr size_t WS_A = 140 * MiB;
constexpr size_t WS_B = 208 * MiB;
constexpr size_t WS_C = 344 * MiB;
constexpr size_t WS_HL2 = 208 * MiB;
constexpr size_t WS_XS = 276 * MiB;
constexpr size_t WS_HDN = 64 * MiB;
constexpr size_t WS_END = 504 * MiB;
constexpr int CW_BAR = 4096;
constexpr int CW_ECNT = 16384;

constexpr int RING_BYTES = 131072;
constexpr int RTAB_BYTES = 36 * 1024 * 4;
constexpr int LDSCTL_OFF = RTAB_BYTES;
constexpr int LDS_BYTES = 163840;

#define RLX_AGENT __ATOMIC_RELAXED, __HIP_MEMORY_SCOPE_AGENT
#define LDS_WAIT() asm volatile("s_waitcnt lgkmcnt(0)" ::: "memory")
#define VM_WAIT() asm volatile("s_waitcnt vmcnt(0)" ::: "memory")
__device__ __forceinline__ unsigned f2bf(float f) { unsigned u = __builtin_bit_cast(unsigned, f); return (u + 0x7fffu + ((u >> 16) & 1u)) >> 16; }
__device__ __forceinline__ unsigned pk2(float lo, float hi) { return f2bf(lo) | (f2bf(hi) << 16); }
__device__ __forceinline__ float bf2f(unsigned short h) { return __builtin_bit_cast(float, (unsigned)h << 16); }
__device__ __forceinline__ float bflo(unsigned w) { return __builtin_bit_cast(float, w << 16); }
__device__ __forceinline__ float bfhi(unsigned w) { return __builtin_bit_cast(float, w & 0xffff0000u); }
__device__ __forceinline__ float wave_sum(float v) {
#define WS_DPP(x, ctrl, rmask) __builtin_bit_cast(float, __builtin_amdgcn_update_dpp(0, __builtin_bit_cast(int, x), ctrl, rmask, 0xF, false))
    v += WS_DPP(v, 0xB1, 0xF); v += WS_DPP(v, 0x4E, 0xF); v += WS_DPP(v, 0x124, 0xF); v += WS_DPP(v, 0x128, 0xF);
    v += WS_DPP(v, 0x142, 0xA); v += WS_DPP(v, 0x143, 0xC);
#undef WS_DPP
    return __builtin_bit_cast(float, __builtin_amdgcn_readlane(__builtin_bit_cast(int, v), 63));
}

#define XB_TMO      128
#define XB_XCNT(j)  (256  + 64 * (j))
#define XB_XSUB(j)  (1280 + 64 * (j))
#define XB_XGEN(j)  (2304 + 64 * (j))
#define XB_TOP      3328
#define XB_TOPGEN   3392
#define XCD_BAR_WORDS 3456
#define XB_SPIN_CAP (1u << 20)
__device__ __forceinline__ unsigned xb_ld(unsigned* p)              { return __hip_atomic_load(p, __ATOMIC_RELAXED, __HIP_MEMORY_SCOPE_AGENT); }
__device__ __forceinline__ unsigned xb_add(unsigned* p, unsigned v) { return __hip_atomic_fetch_add(p, v, __ATOMIC_RELAXED, __HIP_MEMORY_SCOPE_AGENT); }
__device__ __forceinline__ unsigned xb_xcc_id() { return (unsigned)__builtin_amdgcn_s_getreg((3 << 11) | 20) & 0xFu; }
#define XB_SPIN(cond, bar) do { unsigned _sp = 0; while (cond) { __builtin_amdgcn_s_sleep(1); \
    if ((++_sp & 255u) == 0u) { if (xb_ld(&(bar)[XB_TMO])) break; if (_sp > XB_SPIN_CAP) { atomicAdd(&(bar)[XB_TMO], 1u); break; } } } } while (0)
struct XcdBarrier { unsigned* bar; unsigned x; volatile LAS unsigned* st; };
__device__ __forceinline__ XcdBarrier xcd_barrier_post(unsigned* bar, volatile LAS unsigned* st) {
    XcdBarrier b; b.bar = bar; b.x = xb_xcc_id(); b.st = st;
    if (threadIdx.x == 0) (void)xb_add(&bar[XB_XCNT(b.x)], 1u);
    return b;
}
__device__ __forceinline__ void xcd_barrier_complete(unsigned* bar, unsigned x, unsigned& nloc, unsigned& nx) {
    const unsigned G = gridDim.x * gridDim.y * gridDim.z;
    unsigned sum, cnt, mine, sp = 0u;
    for (;;) {
        sum = 0u; cnt = 0u; mine = 0u;
#pragma unroll
        for (unsigned j = 0; j < 16; ++j) { const unsigned c = xb_ld(&bar[XB_XCNT(j)]); sum += c; cnt += (c > 0u) ? 1u : 0u; mine = (j == x) ? c : mine; }
        if (sum == G) break;
        __builtin_amdgcn_s_sleep(1);
        if ((++sp & 255u) == 0u) { if (xb_ld(&bar[XB_TMO])) break; if (sp > XB_SPIN_CAP) { atomicAdd(&bar[XB_TMO], 1u); break; } }
    }
    nloc = mine > 0u ? mine : 1u; nx = cnt > 0u ? cnt : 1u;
}
__device__ __forceinline__ void xcd_barrier(const XcdBarrier& b) {
    asm volatile("s_waitcnt vmcnt(0)" ::: "memory");
    __syncthreads();
    if (threadIdx.x == 0) {
        unsigned* bar = b.bar;
        __builtin_amdgcn_s_waitcnt(0);
        unsigned nloc = b.st[0], nx = b.st[1];
        if (nloc == 0u) { xcd_barrier_complete(bar, b.x, nloc, nx); b.st[0] = nloc; b.st[1] = nx; }
        const unsigned old = xb_add(&bar[XB_XSUB(b.x)], 1u);
        const unsigned gen = old / nloc;
        if (old + 1u == (gen + 1u) * nloc) {
            __builtin_amdgcn_fence(__ATOMIC_RELEASE, "agent");
            asm volatile("s_waitcnt vmcnt(0)" ::: "memory");
            const unsigned og = xb_add(&bar[XB_TOP], 1u);
            const unsigned tg = og / nx;
            if (og + 1u == (tg + 1u) * nx) xb_add(&bar[XB_TOPGEN], 1u);
            else XB_SPIN(xb_ld(&bar[XB_TOPGEN]) == tg, bar);
            __builtin_amdgcn_fence(__ATOMIC_ACQUIRE, "agent");
            xb_add(&bar[XB_XGEN(b.x)], 1u);
            asm volatile("s_waitcnt vmcnt(0)" ::: "memory");
        } else {
            XB_SPIN(xb_ld(&bar[XB_XGEN(b.x)]) == gen, bar);
            __builtin_amdgcn_fence(__ATOMIC_ACQUIRE, "agent");
            asm volatile("s_waitcnt vmcnt(0)" ::: "memory");
        }
    }
    __syncthreads();
}

struct Args { const float* in[N_IN]; float* out; unsigned char* ws; int ph_lo, ph_hi; };
struct Frame {
    LAS unsigned char* lds;
    int tid, lane, wave, vcu, G;
    const float* const __attribute__((address_space(4)))* in;
    float* out; unsigned char* ws;
};
__device__ __forceinline__ const float* row_x_in(const Frame& F, int r) {
    return r < NL ? F.in[I_X] + (size_t)r * D : F.in[I_CTX] + (size_t)(r - NL) * D;
}
__device__ __forceinline__ int row_mod(int r) { return r < NL ? (r >> 12) : 8; }
__device__ __forceinline__ const float* modp(const Frame& F, int layer, int mrow, int which) {
    return (const float*)(F.ws + WS_MOD) + ((size_t)(layer * 9 + mrow) * NMOD + which) * D;
}

__device__ __forceinline__ float silu_f(float v) { return v * __builtin_amdgcn_rcpf(1.f + __expf(-v)); }
__device__ __forceinline__ void p0_mod(Frame& F) {
    LAS float* S = (LAS float*)F.lds;
    LAS float* P = (LAS float*)(F.lds + 9 * 1024 * 4);
    for (int it = blockIdx.x; it < 192; it += F.G) {
        const int layer = it / 96, n0 = (it % 96) * 64;
        { float sv[18];
#pragma unroll
          for (int q = 0; q < 18; ++q) { const int e = F.tid + NTHREADS * q; const int m = e >> 10, k = e & 1023; sv[q] = m < 8 ? F.in[I_C][m * D + k] : F.in[I_CCTX][k]; }
#pragma unroll
          for (int q = 0; q < 18; ++q) S[F.tid + NTHREADS * q] = silu_f(sv[q]); }
        __syncthreads();
        const float* W = F.in[I_ADAW] + (size_t)layer * D * (NMOD * D) + n0 + F.lane;
        float acc[9];
#pragma unroll
        for (int m = 0; m < 9; ++m) acc[m] = 0.f;
        const int kb = F.wave * 128;
#pragma unroll 8
        for (int k = 0; k < 128; ++k) { const float w = W[(size_t)(kb + k) * (NMOD * D)];
#pragma unroll
            for (int m = 0; m < 9; ++m) acc[m] += S[m * 1024 + kb + k] * w; }
#pragma unroll
        for (int m = 0; m < 9; ++m) P[(F.wave * 9 + m) * 64 + F.lane] = acc[m];
        __syncthreads();
        for (int e = F.tid; e < 9 * 64; e += NTHREADS) { const int m = e >> 6, n = e & 63; float s = F.in[I_ADAB][layer * (NMOD * D) + n0 + n];
#pragma unroll
            for (int w = 0; w < 8; ++w) s += P[(w * 9 + m) * 64 + n];
            ((float*)(F.ws + WS_MOD))[(size_t)(layer * 9 + m) * (NMOD * D) + n0 + n] = s; }
        __syncthreads();
    }
}
__device__ __forceinline__ void transpose_item(const float* W, int ldw, int k0, int n0, bf16* dst, int dld, int drow0, LAS float* scr, int lane) {
    const int lq = lane >> 4, ln = 4 * (lane & 15);
    f32x4 v[16];
#pragma unroll
    for (int i = 0; i < 16; ++i) v[i] = *(const f32x4*)(W + (size_t)(k0 + lq + 4 * i) * ldw + n0 + ln);
#pragma unroll
    for (int i = 0; i < 16; ++i) { LAS float* q = scr + (lq + 4 * i) * 65 + ln; q[0] = v[i].x; q[1] = v[i].y; q[2] = v[i].z; q[3] = v[i].w; }
    LDS_WAIT(); asm volatile("" ::: "memory");
    const int c = lane & 7;
#pragma unroll
    for (int j = 0; j < 8; ++j) { const int n = (lane >> 3) + 8 * j; const LAS float* q = scr + (8 * c) * 65 + n;
        v4u o; o.x = pk2(q[0 * 65], q[1 * 65]); o.y = pk2(q[2 * 65], q[3 * 65]); o.z = pk2(q[4 * 65], q[5 * 65]); o.w = pk2(q[6 * 65], q[7 * 65]);
        *(v4u*)(dst + (size_t)(drow0 + n) * dld + k0 + 8 * c) = o; }
    LDS_WAIT(); asm volatile("" ::: "memory");
}
constexpr int TR_SCR = 64 * 65 * 4;
__device__ __forceinline__ unsigned pk4_fp8(float a, float b, float c, float d) { int w = __builtin_amdgcn_cvt_pk_fp8_f32(a, b, 0, false); w = __builtin_amdgcn_cvt_pk_fp8_f32(c, d, w, true); return (unsigned)w; }
__device__ __forceinline__ void transpose_item_f8(const float* W, int ldw, int k0, int n0, unsigned char* dst, int dld, int drow0, LAS float* scr, int lane, float wsc = 64.f) {
    const int lq = lane >> 4, ln = 4 * (lane & 15);
    f32x4 v[16];
#pragma unroll
    for (int i = 0; i < 16; ++i) v[i] = *(const f32x4*)(W + (size_t)(k0 + lq + 4 * i) * ldw + n0 + ln);
#pragma unroll
    for (int i = 0; i < 16; ++i) { LAS float* q = scr + (lq + 4 * i) * 65 + ln; q[0] = v[i].x; q[1] = v[i].y; q[2] = v[i].z; q[3] = v[i].w; }
    LDS_WAIT(); asm volatile("" ::: "memory");
    const int c = lane & 3;
#pragma unroll
    for (int j = 0; j < 4; ++j) { const int n = (lane >> 2) + 16 * j; const LAS float* q = scr + (16 * c) * 65 + n;
        v4u o;
        o.x = pk4_fp8(wsc * q[0 * 65], wsc * q[1 * 65], wsc * q[2 * 65], wsc * q[3 * 65]); o.y = pk4_fp8(wsc * q[4 * 65], wsc * q[5 * 65], wsc * q[6 * 65], wsc * q[7 * 65]);
        o.z = pk4_fp8(wsc * q[8 * 65], wsc * q[9 * 65], wsc * q[10 * 65], wsc * q[11 * 65]); o.w = pk4_fp8(wsc * q[12 * 65], wsc * q[13 * 65], wsc * q[14 * 65], wsc * q[15 * 65]);
        *(v4u*)(dst + (size_t)(drow0 + n) * dld + k0 + 16 * c) = o; }
    LDS_WAIT(); asm volatile("" ::: "memory");
}
__device__ __forceinline__ void p0_small_weights(Frame& F) {
    LAS float* scr = (LAS float*)(F.lds + F.wave * TR_SCR);
    const int gw = F.vcu * NWAVES + F.wave, NGW = F.G * NWAVES;
    constexpr int I_QK = 16 * 32, I_V = 16 * 16, I_O = 16 * 16, I_IN = 16 * 32, I_G = 16 * 16, I_LO = 16 * 16;
    constexpr int NIT = I_QK + I_V + I_O + I_IN + I_G + I_LO;
    for (int it = gw; it < NIT; it += NGW) {
        int r = it;
        if (r < I_QK) { transpose_item(F.in[I_WQKV], 3 * D, (r / 32) * 64, (r % 32) * 64, (bf16*)(F.ws + WS_WQK), D, (r % 32) * 64, scr, F.lane); continue; } r -= I_QK;
        if (r < I_V) { transpose_item(F.in[I_WQKV], 3 * D, (r / 16) * 64, 2 * D + (r % 16) * 64, (bf16*)(F.ws + WS_WV), D, (r % 16) * 64, scr, F.lane); continue; } r -= I_V;
        if (r < I_O) { transpose_item_f8(F.in[I_NAWO], D, (r / 16) * 64, (r % 16) * 64, F.ws + WS_WO, D, (r % 16) * 64, scr, F.lane); continue; } r -= I_O;
        if (r < I_IN) { transpose_item(F.in[I_LWIN], 2 * D, (r / 32) * 64, (r % 32) * 64, (bf16*)(F.ws + WS_WIN), D, (r % 32) * 64, scr, F.lane); continue; } r -= I_IN;
        if (r < I_G) { const int mat = r / 16, q = r % 16; transpose_item_f8(F.in[I_WGATE] + (size_t)mat * 65536, 256, (q / 4) * 64, (q % 4) * 64, F.ws + WS_WG + (size_t)mat * 65536, 256, (q % 4) * 64, scr, F.lane, 16.f); continue; } r -= I_G;
        transpose_item(F.in[I_LWO], D, (r / 16) * 64, (r % 16) * 64, (bf16*)(F.ws + WS_WLO), D, (r % 16) * 64, scr, F.lane);
    }
}
constexpr int MOE_CONV_ITEMS = 3 * NEXP * 128;
constexpr int MOE_CONV_SIDE0 = 4096, MOE_CONV_SIDE1 = 3072, GEMM_G = 240;
constexpr int MOE_CONV_TAIL0 = 12288 - 224 * 16, MOE_CONV_TAIL1 = 12288 - 144 * 16;
struct ConvItem { const float* W; int ldw, k0, n0; unsigned char* dst; int dld, drow0; };
__device__ __forceinline__ ConvItem moe_conv_item(Frame& F, int layer, int it) {
    constexpr int I_1 = NEXP * 16 * 8;
    ConvItem c; int r = it;
    if (r < 2 * I_1) { const int which = r / I_1; r %= I_1; const int e = r / 128, q = r % 128, kb = q / 8, nb = q % 8, n0 = nb * 64;
        c.W = F.in[which ? I_MW3 : I_MW1] + ((size_t)layer * NEXP + e) * (size_t)(D * EFF); c.ldw = EFF; c.k0 = kb * 64; c.n0 = n0;
        c.dst = F.ws + WS_W13 + (size_t)e * (1024 * 1024); c.dld = D; c.drow0 = (n0 / 128) * 256 + which * 128 + (n0 % 128); }
    else { r -= 2 * I_1; const int e = r / 128, q = r % 128, kb = q / 16, nb = q % 16;
        c.W = F.in[I_MW2] + ((size_t)layer * NEXP + e) * (size_t)(EFF * D); c.ldw = D; c.k0 = kb * 64; c.n0 = nb * 64;
        c.dst = F.ws + WS_W2 + (size_t)e * (1024 * 512); c.dld = EFF; c.drow0 = nb * 64; }
    return c;
}
__device__ __forceinline__ void conv_load(const ConvItem& c, int lane, f32x4 (&v)[16]) {
    const int lq = lane >> 4, ln = 4 * (lane & 15);
#pragma unroll
    for (int i = 0; i < 16; ++i) v[i] = *(const f32x4*)(c.W + (size_t)(c.k0 + lq + 4 * i) * c.ldw + c.n0 + ln);
}
__device__ __forceinline__ void conv_moe_weights(Frame& F, int layer, int first, int stride, int end) {
    LAS float* scr = (LAS float*)(F.lds + F.wave * TR_SCR);
    const int lane = F.lane, lq = lane >> 4, ln = 4 * (lane & 15), c4 = lane & 3;
    if (first >= end) return;
    ConvItem cur = moe_conv_item(F, layer, first); f32x4 v[16]; conv_load(cur, lane, v);
    for (int it = first; it < end; it += stride) {
#pragma unroll
        for (int i = 0; i < 16; ++i) { LAS float* q = scr + (lq + 4 * i) * 65 + ln; q[0] = v[i].x; q[1] = v[i].y; q[2] = v[i].z; q[3] = v[i].w; }
        const ConvItem me = cur;
        if (it + stride < end) { cur = moe_conv_item(F, layer, it + stride); conv_load(cur, lane, v); }
        LDS_WAIT(); asm volatile("" ::: "memory");
#pragma unroll
        for (int j = 0; j < 4; ++j) { const int n = (lane >> 2) + 16 * j; const LAS float* q = scr + (16 * c4) * 65 + n;
            v4u o;
            o.x = pk4_fp8(64.f * q[0 * 65], 64.f * q[1 * 65], 64.f * q[2 * 65], 64.f * q[3 * 65]); o.y = pk4_fp8(64.f * q[4 * 65], 64.f * q[5 * 65], 64.f * q[6 * 65], 64.f * q[7 * 65]);
            o.z = pk4_fp8(64.f * q[8 * 65], 64.f * q[9 * 65], 64.f * q[10 * 65], 64.f * q[11 * 65]); o.w = pk4_fp8(64.f * q[12 * 65], 64.f * q[13 * 65], 64.f * q[14 * 65], 64.f * q[15 * 65]);
            *(v4u*)(me.dst + (size_t)(me.drow0 + n) * me.dld + me.k0 + 16 * c4) = o; }
        LDS_WAIT(); asm volatile("" ::: "memory");
    }
}

__device__ __forceinline__ void load_row(const float* p, int lane, f32x4 (&v)[4]) {
#pragma unroll
    for (int j = 0; j < 4; ++j) v[j] = ((const f32x4*)p)[64 * j + lane];
}
__device__ __forceinline__ void load_row_bf16(const bf16* p, int lane, f32x4 (&v)[4]) {
#pragma unroll
    for (int j = 0; j < 4; ++j) { const v2u w = ((const v2u*)p)[64 * j + lane]; v[j] = (f32x4){bflo(w.x), bfhi(w.x), bflo(w.y), bfhi(w.y)}; }
}
__device__ __forceinline__ float row_rstd(const f32x4 (&v)[4]) {
    float s = 0.f;
#pragma unroll
    for (int j = 0; j < 4; ++j) s += (v[j].x * v[j].x + v[j].y * v[j].y) + (v[j].z * v[j].z + v[j].w * v[j].w);
    return __builtin_amdgcn_rsqf(wave_sum(s) * (1.f / D) + EPS);
}
__device__ __forceinline__ void norm_mod(f32x4 (&v)[4], int lane, const float* g, const float* sh, const float* sc) {
    const float rstd = row_rstd(v);
#pragma unroll
    for (int j = 0; j < 4; ++j) { const f32x4 gg = ((const f32x4*)g)[64 * j + lane], s1 = ((const f32x4*)sc)[64 * j + lane], s0 = ((const f32x4*)sh)[64 * j + lane];
        v[j] = (v[j] * rstd) * gg * (s1 + 1.0f) + s0; }
}
__device__ __forceinline__ void store_row_bf16(bf16* o, int lane, const f32x4 (&v)[4]) {
#pragma unroll
    for (int j = 0; j < 4; ++j) { v2u w; w.x = pk2(v[j].x, v[j].y); w.y = pk2(v[j].z, v[j].w); ((v2u*)o)[64 * j + lane] = w; }
}
__device__ __forceinline__ void store_row_f32(float* o, int lane, const f32x4 (&v)[4]) {
#pragma unroll
    for (int j = 0; j < 4; ++j) ((f32x4*)o)[64 * j + lane] = v[j];
}

__device__ __forceinline__ void p1_norm0(Frame& F) {
    const int gw = F.vcu * NWAVES + F.wave, NGW = F.G * NWAVES;
    bf16* HL = (bf16*)(F.ws + WS_A);
    for (int r0 = gw * 4; r0 < MT; r0 += NGW * 4) {
        f32x4 v[4][4];
#pragma unroll
        for (int q = 0; q < 4; ++q) load_row(row_x_in(F, r0 + q), F.lane, v[q]);
#pragma unroll
        for (int q = 0; q < 4; ++q) { const int mr = row_mod(r0 + q);
            norm_mod(v[q], F.lane, F.in[I_NORMG] + 0 * D, modp(F, 0, mr, 0), modp(F, 0, mr, 1));
            store_row_bf16(HL + (size_t)(r0 + q) * D, F.lane, v[q]); asm volatile("" ::: "memory"); }
    }
}

namespace pg8 {
constexpr int FP8_SCALE = 0x7C7C7C7C;
constexpr int BM = 256, BK = 64, HALF = 128, HTB = HALF * BK * 2, STAGE_BYTES = 8 * HTB, NXCD = 8, WGM = 8;
__host__ __device__ __forceinline__ int lds_byte(int r, int c) { const int st = (r >> 4) * 2 + (c >> 5), rr = r & 15, cc = c & 31, ob = rr * 64 + cc * 2; return st * 1024 + (ob ^ (((ob >> 9) & 1) << 5)); }
__host__ __device__ __forceinline__ void stage_rc(int b, int& R, int& C) { const int st = b / 1024, sb = b % 1024, swz = sb ^ (((sb >> 9) & 1) << 5); R = (st >> 1) * 16 + swz / 64; C = (st & 1) * 32 + (swz % 64) / 2; }
__host__ __device__ __forceinline__ int perm32(int rho) { const int n = rho >> 4, i = rho & 15; return 8 * (i >> 2) + 4 * n + (i & 3); }
constexpr int GROW_OFF = 131072;
struct Unit { int pm, pn; const char* a; const char* b; int aux; };
struct Gemm { int nt, lda, ldb; };
__host__ __device__ __forceinline__ bool order_next(int nM, int nN, int G, int c, int i, int& pm, int& pn) {
    const int nwg = nM * nN; const long L = (long)i * G + c; if (L >= nwg) return false;
    int wgid = (int)L; { const int q = nwg / NXCD, r = nwg % NXCD, xcd = wgid % NXCD, off = wgid / NXCD; wgid = (xcd < r ? xcd * (q + 1) : r * (q + 1) + (xcd - r) * q) + off; }
    const int nig = WGM * nN, gid = wgid / nig, fm = gid * WGM, gsz = (nM - fm) < WGM ? (nM - fm) : WGM;
    pm = fm + ((wgid % nig) % gsz); pn = (wgid % nig) / gsz; return true;
}
typedef int v8i __attribute__((ext_vector_type(8)));
typedef int v4i __attribute__((ext_vector_type(4)));
__host__ __device__ __forceinline__ int f8swz(int r) { return ((r >> 1) & 1) | (((r >> 3) & 1) << 2); }
__device__ __forceinline__ unsigned cvt_pk_bf16(float lo, float hi) { unsigned r; asm volatile("v_cvt_pk_bf16_f32 %0, %1, %2" : "=v"(r) : "v"(lo), "v"(hi)); return r; }

template <bool F8> struct Frag;
template <> struct Frag<false> { bf16x8 k[2]; };
template <> struct Frag<true> { v8i v; };
template <class Epi, class Sched, bool FP8 = false, bool ALIGN_EPI = true, bool SP2 = true>
__device__ __forceinline__ void gemm_phase(LAS unsigned char* lds, const Gemm g, const Sched& S, const Epi& E, int wave_id) {
    const int wid = wave_id, lane = (int)__builtin_amdgcn_mbcnt_hi(~0u, __builtin_amdgcn_mbcnt_lo(~0u, 0u)), tid = wid * 64 + lane, wr = wid >> 2, wc = wid & 3, fr = lane & 15, fq = lane >> 4;
    const int nt = g.nt;
    unsigned voffB[2]; int RA[2], CA_[2];
#pragma unroll
    for (int i = 0; i < 2; ++i) { int R, C; const int b_ = tid * 16 + i * 8192;
        if (FP8) { R = b_ >> 7; C = (((b_ >> 4) & 7) ^ f8swz(R)) * 16; } else { stage_rc(b_, R, C); C *= 2; }
        const int Rb = Epi::PERM ? ((R & ~31) + perm32(R & 31)) : R;
        RA[i] = R; CA_[i] = C; voffB[i] = (unsigned)(Rb * g.ldb + C); }
    const size_t kstep = (size_t)(BK * 2);
    const size_t hstepB = (size_t)HALF * g.ldb;
    unsigned vA[2][2], nvA[2][2];
    const unsigned ldsw = (unsigned)wid * 1024u;
    const int aoff = FP8 ? (wr * 64 + fr) * 128 + (((2 * fq) ^ f8swz(fr)) << 4) : lds_byte(wr * 64 + fr, fq * 8);
    const int boff = FP8 ? (wc * 32 + fr) * 128 + (((2 * fq) ^ f8swz(fr)) << 4) : lds_byte(wc * 32 + fr, fq * 8);
#define PG8_SA(b, h) (((b) * 2 + (h)) * HTB)
#define PG8_SB(b, h) ((4 + (b) * 2 + (h)) * HTB)
#define PG8_STAGE(bufoff, gbase, voff) do { _Pragma("unroll") for (int _i = 0; _i < 2; ++_i) \
        __builtin_amdgcn_global_load_lds((const unsigned*)((const char*)(gbase) + (voff)[_i]), (LAS unsigned*)(lds + (bufoff) + ldsw + _i * 8192), 16, 0, 0); } while (0)
#define PG8_LD1(dstf, base_, off_, i_) do { if constexpr (FP8) { dstf.v.lo = *(const LAS v4i*)(lds + (base_) + (off_) + (i_) * 2048); dstf.v.hi = *(const LAS v4i*)(lds + (base_) + ((off_) ^ 16) + (i_) * 2048); } \
        else { dstf.k[0] = *(const LAS bf16x8*)(lds + (base_) + (off_) + (i_) * 2048); dstf.k[1] = *(const LAS bf16x8*)(lds + (base_) + (off_) + (i_) * 2048 + 1024); } } while (0)
#define PG8_LDA(dst, b, h) do { _Pragma("unroll") for (int m = 0; m < 4; ++m) PG8_LD1(dst[m], PG8_SA(b, h), aoff, m); } while (0)
#define PG8_LDB(dst, b, h) do { _Pragma("unroll") for (int n = 0; n < 2; ++n) PG8_LD1(dst[n], PG8_SB(b, h), boff, n); } while (0)
#define PG8_MMA(ai, bj, At, Bt) do { if constexpr (FP8) __builtin_amdgcn_sched_barrier(0); __builtin_amdgcn_s_setprio(1); _Pragma("unroll") for (int m = 0; m < 4; ++m) _Pragma("unroll") for (int n = 0; n < 2; ++n) { \
        if constexpr (FP8) asm volatile("v_mfma_scale_f32_16x16x128_f8f6f4 %0, %1, %2, %0, %3, %4 op_sel_hi:[0,0,0]" : "+v"(acc[ai][bj][m][n]) : "v"(Bt[n].v), "v"(At[m].v), "v"(f8s), "v"(f8s)); \
        else { _Pragma("unroll") for (int k = 0; k < 2; ++k) acc[ai][bj][m][n] = __builtin_amdgcn_mfma_f32_16x16x32_bf16(Bt[n].k[k], At[m].k[k], acc[ai][bj][m][n], 0, 0, 0); } } \
        __builtin_amdgcn_s_setprio(0); if constexpr (FP8) __builtin_amdgcn_sched_barrier(0); } while (0)
#define PG8_NVA(h) ((Sched::GATHER && last) ? nvA[h] : vA[h])
#define PG8_WAIT_V(n) asm volatile("s_waitcnt vmcnt(" #n ")" ::: "memory")
#define PG8_WAIT_L(n) asm volatile("s_waitcnt lgkmcnt(" #n ")" ::: "memory")
#define PG8_BAR __builtin_amdgcn_s_barrier()
#define PG8_SCHED __builtin_amdgcn_sched_barrier(0)
    Unit cur, nxt; int ui = 0;
    if (!S.next(0, cur)) return;
    f32x4 acc[2][2][4][2];
#pragma unroll
    for (int a = 0; a < 2; ++a)
#pragma unroll
        for (int b = 0; b < 2; ++b)
#pragma unroll
            for (int m = 0; m < 4; ++m)
#pragma unroll
                for (int n = 0; n < 2; ++n) acc[a][b][m][n] = (f32x4){0.f, 0.f, 0.f, 0.f};
    Frag<FP8> At[4], B0[2], B1[2];
    int f8s = FP8_SCALE;
    asm volatile("" : "+v"(f8s));
    const char* cA = cur.a; const char* cB = cur.b;
    S.a_offsets(cur, g, RA, CA_, vA);
    if constexpr (SP2) {
        PG8_STAGE(PG8_SB(0, 0), cB, voffB); PG8_STAGE(PG8_SB(0, 1), cB + hstepB, voffB); PG8_STAGE(PG8_SA(0, 0), cA, vA[0]); PG8_STAGE(PG8_SA(0, 1), cA, vA[1]);
        if (wr == 1) PG8_BAR;
        PG8_WAIT_V(2); PG8_BAR;
        PG8_STAGE(PG8_SB(1, 0), cB + kstep, voffB); PG8_STAGE(PG8_SA(1, 0), cA + kstep, vA[0]); PG8_STAGE(PG8_SB(1, 1), cB + hstepB + kstep, voffB);
        PG8_WAIT_V(6); PG8_BAR;
    } else {
        PG8_STAGE(PG8_SB(0, 0), cB, voffB); PG8_STAGE(PG8_SA(0, 0), cA, vA[0]); PG8_STAGE(PG8_SB(0, 1), cB + hstepB, voffB); PG8_STAGE(PG8_SA(0, 1), cA, vA[1]);
        if (wr == 1) PG8_BAR;
        PG8_WAIT_V(4); PG8_BAR;
        PG8_STAGE(PG8_SB(1, 0), cB + kstep, voffB); PG8_STAGE(PG8_SA(1, 0), cA + kstep, vA[0]); PG8_STAGE(PG8_SB(1, 1), cB + hstepB + kstep, voffB);
        PG8_WAIT_V(6); PG8_BAR;
    }
    for (;;) {
        const bool has_next = S.next(ui + 1, nxt);
        const char* nA = has_next ? nxt.a : cA; const char* nB = has_next ? nxt.b : cB;
        if constexpr (Sched::GATHER) {
#pragma unroll
            for (int h = 0; h < 2; ++h)
#pragma unroll
                for (int i = 0; i < 2; ++i) nvA[h][i] = vA[h][i];
        }
        for (int t = 0; t < nt; t += 2) {
            const bool last = (t == nt - 2);
            if constexpr (Sched::GATHER) {
                if (last && has_next) {
#pragma unroll
                    for (int h = 0; h < 2; ++h)
#pragma unroll
                        for (int i = 0; i < 2; ++i) nvA[h][i] = (unsigned)(*(const LAS int*)(lds + GROW_OFF + (h * 128 + RA[i]) * 4) * g.lda + CA_[i]);
                }
                if (t == 0 && has_next && wr == 0) __builtin_amdgcn_global_load_lds((const unsigned*)S.row_ptr(nxt, tid), (LAS unsigned*)(lds + GROW_OFF + wid * 256), 4, 0, 0);
            }
            const char* a1 = cA + (size_t)(t + 1) * kstep;
            const char* a2 = last ? nA : cA + (size_t)(t + 2) * kstep; const char* b2 = last ? nB : cB + (size_t)(t + 2) * kstep;
            const char* a3 = a2 + kstep; const char* b3 = b2 + kstep;
            if constexpr (SP2) {
            PG8_LDB(B0, 0, 0); PG8_LDB(B1, 0, 1); PG8_SCHED; PG8_LDA(At, 0, 0); PG8_STAGE(PG8_SA(1, 1), a1, vA[1]);
            PG8_WAIT_V(8); PG8_WAIT_L(0); PG8_BAR; PG8_MMA(0, 0, At, B0); PG8_MMA(0, 1, At, B1); PG8_BAR; PG8_SCHED;
            PG8_LDA(At, 0, 1); PG8_STAGE(PG8_SB(0, 0), b2, voffB); PG8_STAGE(PG8_SB(0, 1), b2 + hstepB, voffB); PG8_STAGE(PG8_SA(0, 0), a2, PG8_NVA(0));
            PG8_WAIT_V(8); PG8_WAIT_L(0); PG8_BAR; PG8_MMA(1, 0, At, B0); PG8_MMA(1, 1, At, B1); PG8_BAR; PG8_SCHED;
            PG8_LDB(B0, 1, 0); PG8_LDB(B1, 1, 1); PG8_SCHED; PG8_LDA(At, 1, 0); PG8_STAGE(PG8_SA(0, 1), a2, PG8_NVA(1));
            PG8_WAIT_V(8); PG8_WAIT_L(0); PG8_BAR; PG8_MMA(0, 0, At, B0); PG8_MMA(0, 1, At, B1); PG8_BAR; PG8_SCHED;
            PG8_LDA(At, 1, 1); PG8_STAGE(PG8_SB(1, 0), b3, voffB); PG8_STAGE(PG8_SB(1, 1), b3 + hstepB, voffB); PG8_STAGE(PG8_SA(1, 0), a3, PG8_NVA(0));
            PG8_WAIT_V(8); PG8_WAIT_L(0); PG8_BAR; PG8_MMA(1, 0, At, B0); PG8_MMA(1, 1, At, B1); PG8_BAR; PG8_SCHED;
            } else {
            PG8_LDB(B0, 0, 0); PG8_SCHED; PG8_LDA(At, 0, 0); PG8_STAGE(PG8_SA(1, 1), a1, vA[1]);
            PG8_WAIT_L(8); PG8_BAR; PG8_WAIT_L(0); PG8_MMA(0, 0, At, B0); PG8_BAR; PG8_SCHED;
            PG8_LDB(B1, 0, 1); PG8_STAGE(PG8_SB(0, 0), b2, voffB);
            PG8_BAR; PG8_WAIT_L(0); PG8_MMA(0, 1, At, B1); PG8_BAR;
            PG8_LDA(At, 0, 1); PG8_STAGE(PG8_SA(0, 0), a2, PG8_NVA(0));
            PG8_BAR; PG8_WAIT_L(0); PG8_MMA(1, 0, At, B0); PG8_BAR; PG8_SCHED;
            PG8_STAGE(PG8_SB(0, 1), b2 + hstepB, voffB);
            PG8_WAIT_V(6); PG8_BAR; PG8_MMA(1, 1, At, B1); PG8_BAR;
            PG8_LDB(B0, 1, 0); PG8_SCHED; PG8_LDA(At, 1, 0); PG8_STAGE(PG8_SA(0, 1), a2, PG8_NVA(1));
            PG8_WAIT_L(8); PG8_BAR; PG8_WAIT_L(0); PG8_MMA(0, 0, At, B0); PG8_BAR; PG8_SCHED;
            PG8_LDB(B1, 1, 1); PG8_STAGE(PG8_SB(1, 0), b3, voffB);
            PG8_BAR; PG8_WAIT_L(0); PG8_MMA(0, 1, At, B1); PG8_BAR;
            PG8_LDA(At, 1, 1); PG8_STAGE(PG8_SA(1, 0), a3, PG8_NVA(0));
            PG8_BAR; PG8_WAIT_L(0); PG8_MMA(1, 0, At, B0); PG8_BAR; PG8_SCHED;
            PG8_STAGE(PG8_SB(1, 1), b3 + hstepB, voffB);
            PG8_WAIT_V(6); PG8_BAR; PG8_MMA(1, 1, At, B1); PG8_BAR;
            }
        }
        if constexpr (ALIGN_EPI) { if (wr == 0) PG8_BAR; }
        if constexpr (FP8) asm volatile("s_nop 15\n\ts_nop 15" ::: "memory");
        E(acc, cur, wr, wc, fr, fq);
        if (!has_next) break;
#pragma unroll
        for (int a = 0; a < 2; ++a)
#pragma unroll
            for (int b = 0; b < 2; ++b)
#pragma unroll
                for (int m = 0; m < 4; ++m)
#pragma unroll
                    for (int n = 0; n < 2; ++n) acc[a][b][m][n] = (f32x4){0.f, 0.f, 0.f, 0.f};
        cur = nxt; cA = nA; cB = nB; ++ui;
        if constexpr (Sched::GATHER) {
#pragma unroll
            for (int h = 0; h < 2; ++h)
#pragma unroll
                for (int i = 0; i < 2; ++i) vA[h][i] = nvA[h][i];
        }
        if constexpr (ALIGN_EPI) { if (wr == 1) PG8_BAR; }
    }
    PG8_WAIT_V(0);
    if constexpr (!ALIGN_EPI) { if (wr == 0) PG8_BAR; }
    PG8_BAR;
#undef PG8_SA
#undef PG8_SB
#undef PG8_STAGE
#undef PG8_LDA
#undef PG8_LDB
#undef PG8_MMA
#undef PG8_NVA
#undef PG8_LD1
#undef PG8_WAIT_V
#undef PG8_WAIT_L
#undef PG8_BAR
#undef PG8_SCHED
}
}

struct DenseSched {
    static constexpr bool GATHER = false;
    int nM, nN, G, c; const char* A; const char* B; size_t strideA, strideB;
    __device__ __forceinline__ bool next(int i, pg8::Unit& u) const {
        if (!pg8::order_next(nM, nN, G, c, i, u.pm, u.pn)) return false;
        u.a = A + (size_t)u.pm * strideA; u.b = B + (size_t)u.pn * strideB; u.aux = 0; return true;
    }
    __device__ __forceinline__ void a_offsets(const pg8::Unit&, const pg8::Gemm& g, const int (&R)[2], const int (&C)[2], unsigned (&v)[2][2]) const {
#pragma unroll
        for (int h = 0; h < 2; ++h)
#pragma unroll
            for (int i = 0; i < 2; ++i) v[h][i] = (unsigned)((h * 128 + R[i]) * g.lda + C[i]);
    }
};


__device__ __forceinline__ float gelu_tanh(float v) { const float z = 1.5957691216057308f * (v + 0.044715f * v * v * v); return v * __builtin_amdgcn_rcpf(1.f + __expf(-z)); }
__device__ __forceinline__ float sigmoid_f(float v) { return __builtin_amdgcn_rcpf(1.f + __expf(-v)); }
template <int ACT> struct EpiBf16 {
    static constexpr bool PERM = true;
    bf16* O; int ldc; const float* bias; int nscale; float scale;
    __device__ __forceinline__ void operator()(const f32x4 (&acc)[2][2][4][2], const pg8::Unit& u, int wr, int wc, int fr, int fq) const {
        const int row0 = u.pm * 256 + wr * 64 + fr, col0 = u.pn * 256 + wc * 32 + 8 * fq;
        const float sc = u.pn < nscale ? scale : 1.f;
#pragma unroll
        for (int bj = 0; bj < 2; ++bj) {
            const f32x4 zz = (f32x4){0.f, 0.f, 0.f, 0.f};
            const f32x4 b0 = bias ? *(const f32x4*)(bias + col0 + bj * 128) : zz, b1 = bias ? *(const f32x4*)(bias + col0 + bj * 128 + 4) : zz;
#pragma unroll
            for (int ai = 0; ai < 2; ++ai)
#pragma unroll
                for (int m = 0; m < 4; ++m) {
                    f32x4 v0 = (acc[ai][bj][m][0] + b0) * sc, v1 = (acc[ai][bj][m][1] + b1) * sc;
                    if (ACT == 1) { v0 = (f32x4){gelu_tanh(v0.x), gelu_tanh(v0.y), gelu_tanh(v0.z), gelu_tanh(v0.w)}; v1 = (f32x4){gelu_tanh(v1.x), gelu_tanh(v1.y), gelu_tanh(v1.z), gelu_tanh(v1.w)}; }
                    v4u w; w.x = pg8::cvt_pk_bf16(v0.x, v0.y); w.y = pg8::cvt_pk_bf16(v0.z, v0.w); w.z = pg8::cvt_pk_bf16(v1.x, v1.y); w.w = pg8::cvt_pk_bf16(v1.z, v1.w);
                    *(v4u*)(O + (size_t)(row0 + ai * 128 + m * 16) * ldc + col0 + bj * 128) = w;
                    if (m == 3) asm volatile("s_waitcnt vmcnt(0)" ::: "memory");
                }
        }
    }
};
struct EpiF8 {
    static constexpr bool PERM = true;
    unsigned char* O; int ldc;
    __device__ __forceinline__ void operator()(const f32x4 (&acc)[2][2][4][2], const pg8::Unit& u, int wr, int wc, int fr, int fq) const {
        const int row0 = u.pm * 256 + wr * 64 + fr, col0 = u.pn * 256 + wc * 32 + 8 * fq;
#pragma unroll
        for (int bj = 0; bj < 2; ++bj)
#pragma unroll
            for (int ai = 0; ai < 2; ++ai)
#pragma unroll
                for (int m = 0; m < 4; ++m) { const f32x4 v0 = acc[ai][bj][m][0], v1 = acc[ai][bj][m][1];
                    v2u w; w.x = pk4_fp8(v0.x, v0.y, v0.z, v0.w); w.y = pk4_fp8(v1.x, v1.y, v1.z, v1.w);
                    *(v2u*)(O + (size_t)(row0 + ai * 128 + m * 16) * ldc + col0 + bj * 128) = w; }
    }
};
struct EpiBf16RowBias {
    static constexpr bool PERM = true;
    bf16* O; int ldc; const float* bias;
    __device__ __forceinline__ void operator()(const f32x4 (&acc)[2][2][4][2], const pg8::Unit& u, int wr, int wc, int fr, int fq) const {
        const int row0 = u.pm * 256 + wr * 64 + fr, col0 = u.pn * 256 + wc * 32 + 8 * fq;
#pragma unroll
        for (int ai = 0; ai < 2; ++ai)
#pragma unroll
            for (int m = 0; m < 4; ++m) { const int row = row0 + ai * 128 + m * 16; const float b = bias[row];
#pragma unroll
                for (int bj = 0; bj < 2; ++bj) { const f32x4 v0 = acc[ai][bj][m][0] + b, v1 = acc[ai][bj][m][1] + b;
                    v4u w; w.x = pg8::cvt_pk_bf16(v0.x, v0.y); w.y = pg8::cvt_pk_bf16(v0.z, v0.w); w.z = pg8::cvt_pk_bf16(v1.x, v1.y); w.w = pg8::cvt_pk_bf16(v1.z, v1.w);
                    *(v4u*)(O + (size_t)row * ldc + col0 + bj * 128) = w; } }
    }
};
template <bool INPLACE>
struct EpiResid {
    static constexpr bool PERM = true;
    const float* baseL; const float* baseC; bf16* XL; const float* bias; const float* gate;
    __device__ __forceinline__ void operator()(const f32x4 (&acc)[2][2][4][2], const pg8::Unit& u, int wr, int wc, int fr, int fq) const {
        const int rowt = u.pm * 256, col0 = u.pn * 256 + wc * 32 + 8 * fq;
        const bool isc = rowt >= NL; const int mrow = isc ? 8 : (rowt >> 12);
        const float* base = isc ? baseC - (size_t)NL * D : baseL;
        const float* gp = gate + (size_t)mrow * (NMOD * D);
#pragma unroll
        for (int bj = 0; bj < 2; ++bj) { const int col = col0 + bj * 128;
            const f32x4 bv0 = *(const f32x4*)(bias + col), bv1 = *(const f32x4*)(bias + col + 4), gv0 = *(const f32x4*)(gp + col), gv1 = *(const f32x4*)(gp + col + 4);
#pragma unroll
            for (int ai = 0; ai < 2; ++ai) {
                f32x4 x0[4], x1[4];
#pragma unroll
                for (int m = 0; m < 4; ++m) { const size_t off = (size_t)(rowt + ai * 128 + wr * 64 + m * 16 + fr) * D + col;
                    if (INPLACE) { const v4u w = *(const v4u*)(XL + off); x0[m] = (f32x4){bflo(w.x), bfhi(w.x), bflo(w.y), bfhi(w.y)}; x1[m] = (f32x4){bflo(w.z), bfhi(w.z), bflo(w.w), bfhi(w.w)}; }
                    else { x0[m] = *(const f32x4*)(base + off); x1[m] = *(const f32x4*)(base + off + 4); } }
#pragma unroll
                for (int m = 0; m < 4; ++m) { const size_t off = (size_t)(rowt + ai * 128 + wr * 64 + m * 16 + fr) * D + col;
                    const f32x4 y0 = x0[m] + gv0 * (acc[ai][bj][m][0] + bv0), y1 = x1[m] + gv1 * (acc[ai][bj][m][1] + bv1);
                    v4u o; o.x = pg8::cvt_pk_bf16(y0.x, y0.y); o.y = pg8::cvt_pk_bf16(y0.z, y0.w); o.z = pg8::cvt_pk_bf16(y1.x, y1.y); o.w = pg8::cvt_pk_bf16(y1.z, y1.w);
                    *(v4u*)(XL + off) = o; } } }
    }
};

constexpr size_t WS_G = 208 * MiB, WS_UPRE = 272 * MiB, WS_GH = 340 * MiB;
constexpr int SCT = 64, NCHUNK = 68, AT_STRIDE = 528;
typedef float f32x4v __attribute__((ext_vector_type(4)));
constexpr size_t WS_UC8 = WS_HDN;
constexpr size_t WS_UC = WS_A;
__device__ __forceinline__ void conv_phase(Frame& F) {
    const bf16* UPRE = (const bf16*)(F.ws + WS_UPRE); bf16* UC = (bf16*)(F.ws + WS_UC); unsigned char* UC8 = F.ws + WS_UC8;
    const int ch8 = F.tid & 127, c0 = 8 * ch8;
    float cw[4][8], cb[8];
#pragma unroll
    for (int k = 0; k < 4; ++k) { const f32x4 a = *(const f32x4*)(F.in[I_CONVW] + k * D + c0), bq = *(const f32x4*)(F.in[I_CONVW] + k * D + c0 + 4);
        cw[k][0] = a.x; cw[k][1] = a.y; cw[k][2] = a.z; cw[k][3] = a.w; cw[k][4] = bq.x; cw[k][5] = bq.y; cw[k][6] = bq.z; cw[k][7] = bq.w; }
    { const f32x4 a = *(const f32x4*)(F.in[I_CONVB] + c0), bq = *(const f32x4*)(F.in[I_CONVB] + c0 + 4); cb[0] = a.x; cb[1] = a.y; cb[2] = a.z; cb[3] = a.w; cb[4] = bq.x; cb[5] = bq.y; cb[6] = bq.z; cb[7] = bq.w; }
    const int ng = MT / 4;
    for (int gi = F.vcu * 4 + (F.tid >> 7); gi < ng; gi += F.G * 4) {
        const int r0 = gi * 4;
        int s0, len; if (r0 < NL) { s0 = r0 & ~(SEQ - 1); len = SEQ; } else { s0 = NL + ((r0 - NL) & ~(CTXL - 1)); len = CTXL; }
        float x[7][8];
#pragma unroll
        for (int i = 0; i < 7; ++i) { const int r = r0 - 2 + i;
            v4u raw = (v4u){0u, 0u, 0u, 0u};
            if (r >= s0 && r < s0 + len) raw = *(const v4u*)(UPRE + (size_t)r * D + c0);
            x[i][0] = bflo(raw.x); x[i][1] = bfhi(raw.x); x[i][2] = bflo(raw.y); x[i][3] = bfhi(raw.y); x[i][4] = bflo(raw.z); x[i][5] = bfhi(raw.z); x[i][6] = bflo(raw.w); x[i][7] = bfhi(raw.w); }
#pragma unroll
        for (int tt = 0; tt < 4; ++tt) { float o[8];
#pragma unroll
            for (int c = 0; c < 8; ++c) o[c] = cb[c] + x[tt][c] * cw[0][c] + x[tt + 1][c] * cw[1][c] + x[tt + 2][c] * cw[2][c] + x[tt + 3][c] * cw[3][c];
            v4u wv; wv.x = pk2(o[0], o[1]); wv.y = pk2(o[2], o[3]); wv.z = pk2(o[4], o[5]); wv.w = pk2(o[6], o[7]);
            *(v4u*)(UC + (size_t)(r0 + tt) * D + c0) = wv;
            v2u w8; w8.x = pk4_fp8(o[0], o[1], o[2], o[3]); w8.y = pk4_fp8(o[4], o[5], o[6], o[7]); *(v2u*)(UC8 + (size_t)(r0 + tt) * D + c0) = w8; }
    }
}
constexpr int SW_AGG = 16384, SW_A = 20480, SW_ATILE = 32 * 256, SW_U = SW_A + 8 * SW_ATILE, SW_G = SW_U + 8 * 2560;
constexpr int SW_MTN = 2, SW_T = 16 * SW_MTN;
constexpr int SW_NCTX = CTXL / SW_T, SW_NCH = (CTXL + SEQ) / SW_T, SW_STEPS = (SW_NCH + 7) / 8;
constexpr int SW_F8SCALE = 0x7D7D7D7D;
static_assert(SW_MTN == 2 && SW_G + 8 * 2560 <= RTAB_BYTES, "sweep LDS map");
__device__ __forceinline__ void rows4(float x, float (&r)[4]) {
    typedef unsigned u32x2 __attribute__((ext_vector_type(2)));
    const unsigned xi = __builtin_bit_cast(unsigned, x);
    const u32x2 p16 = __builtin_amdgcn_permlane16_swap(xi, xi, false, false);
    const u32x2 pa = __builtin_amdgcn_permlane32_swap(p16.x, p16.x, false, false);
    const u32x2 pb = __builtin_amdgcn_permlane32_swap(p16.y, p16.y, false, false);
    r[0] = __uint_as_float(pa[0]); r[1] = __uint_as_float(pb[0]); r[2] = __uint_as_float(pa[1]); r[3] = __uint_as_float(pb[1]);
}
template <int DIR>
__device__ __forceinline__ void scan_sweep(Frame& F) {
    constexpr int MTN = SW_MTN;
    const int lane = F.lane, w = F.wave, g = lane >> 4, lc = lane & 15;
    const int c = F.vcu, b = c >> 5, nb = (c >> 3) & 3, cg = c & 7;
    const bf16* UC = (const bf16*)(F.ws + WS_UC); const unsigned char* UC8 = F.ws + WS_UC8; const unsigned char* WG8 = F.ws + WS_WG;
    const bf16* Gp = (const bf16*)(F.ws + WS_G); bf16* GH = (bf16*)(F.ws + WS_GH);
#pragma unroll
    for (int i = 0; i < 2; ++i) { const int pid = F.tid + 512 * i, n = pid >> 4, pp = pid & 15; const int nt = n >> 4, j = n & 15, ct = nt >> 1, gate = nt & 1;
        const v4u v = *(const v4u*)(WG8 + ((size_t)(((DIR * 2 + gate) * 4 + nb) * 256 + 32 * cg + 16 * ct + j)) * 256 + pp * 16);
        *(LAS v4u*)(F.lds + n * 256 + ((pp ^ (n & 15)) << 4)) = v; }
    float br[2], bi[2], lam8[2], hprev[2];
#pragma unroll
    for (int ct = 0; ct < 2; ++ct) { const int ch = nb * 256 + 32 * cg + 16 * ct + lc;
        br[ct] = F.in[I_BGATE][(DIR * 2 + 0) * D + ch]; bi[ct] = F.in[I_BGATE][(DIR * 2 + 1) * D + ch];
        lam8[ct] = -8.f * log1pf(__expf(-F.in[I_LAMBDA][DIR * D + ch])); hprev[ct] = 0.f; }
    LAS f32x2* AGG = (LAS f32x2*)(F.lds + SW_AGG);
    LAS unsigned char* AT = F.lds + SW_A + w * SW_ATILE;
    LAS unsigned char* UT = F.lds + SW_U + w * 2560;
    LAS unsigned char* GS = F.lds + SW_G + w * 2560;
    int f8s = SW_F8SCALE; asm volatile("" : "+v"(f8s));
#define SW_CI(idx_) (DIR == 0 ? (idx_) : ((idx_) < SW_NCTX ? SW_NCTX - 1 - (idx_) : SW_NCH + SW_NCTX - 1 - (idx_)))
#define SW_ROW0(ci_) ((ci_) < SW_NCTX ? NL + b * CTXL + (ci_) * SW_T : b * SEQ + ((ci_) - SW_NCTX) * SW_T)
#define SW_LOADA(row0_) do { const unsigned char* ap_ = UC8 + (size_t)((row0_) + (lane >> 4)) * D + nb * 256 + 16 * (lane & 15); \
        _Pragma("unroll") for (int i = 0; i < 8; ++i) areg[i] = *(const v4u*)(ap_ + (size_t)(4 * i) * D); \
        _Pragma("unroll") for (int i = 0; i < 2; ++i) { const int pp_ = lane + 64 * i; ureg[i] = *(const v4u*)(UC + (size_t)((row0_) + (pp_ >> 2)) * D + nb * 256 + 32 * cg + 8 * (pp_ & 3)); } } while (0)
    v4u areg[8], ureg[2];
    { const int ci0 = SW_CI(w); SW_LOADA(SW_ROW0(ci0)); }
    __syncthreads();
    for (int s = 0; s < SW_STEPS; ++s) {
        const int idx = 8 * s + w; const bool active = idx < SW_NCH;
        const int ci = SW_CI(idx); const bool isctx = ci < SW_NCTX; const int row0 = SW_ROW0(ci);
        float Pc[2][MTN][4], Hc[2][MTN][4], CA[2], CB[2]; v4u hfr[MTN], gr[MTN];
        CA[0] = 1.f; CB[0] = 0.f; CA[1] = 1.f; CB[1] = 0.f;
        if (active) {
            f32x4 acc[MTN][4]; float uu[2][MTN][4];
#pragma unroll
            for (int mt = 0; mt < MTN; ++mt)
#pragma unroll
                for (int nt = 0; nt < 4; ++nt) acc[mt][nt] = (f32x4){0.f, 0.f, 0.f, 0.f};
#pragma unroll
            for (int i = 0; i < 8; ++i) { const int r = 4 * i + (lane >> 4); *(LAS v4u*)(AT + r * 256 + (((lane & 15) ^ (r & 15)) << 4)) = areg[i]; }
#pragma unroll
            for (int i = 0; i < 2; ++i) { const int pp = lane + 64 * i; *(LAS v4u*)(UT + (pp >> 2) * 80 + 16 * (pp & 3)) = ureg[i]; }
            asm volatile("s_waitcnt lgkmcnt(0)" ::: "memory");
#pragma unroll
            for (int ct = 0; ct < 2; ++ct)
#pragma unroll
                for (int mt = 0; mt < MTN; ++mt)
#pragma unroll
                    for (int r = 0; r < 4; ++r) uu[ct][mt][r] = bf2f(*(const LAS unsigned short*)(UT + (16 * mt + 4 * g + r) * 80 + (16 * ct + lc) * 2));
#pragma unroll
            for (int kb = 0; kb < 2; ++kb) {
                pg8::v8i bfr[4], afr[MTN];
#pragma unroll
                for (int nt = 0; nt < 4; ++nt) { const LAS unsigned char* rp = F.lds + (16 * nt + lc) * 256;
                    bfr[nt].lo = *(const LAS pg8::v4i*)(rp + (((2 * g + 8 * kb) ^ lc) << 4)); bfr[nt].hi = *(const LAS pg8::v4i*)(rp + (((2 * g + 1 + 8 * kb) ^ lc) << 4)); }
#pragma unroll
                for (int mt = 0; mt < MTN; ++mt) { const LAS unsigned char* rp = AT + (16 * mt + lc) * 256;
                    afr[mt].lo = *(const LAS pg8::v4i*)(rp + (((2 * g + 8 * kb) ^ lc) << 4)); afr[mt].hi = *(const LAS pg8::v4i*)(rp + (((2 * g + 1 + 8 * kb) ^ lc) << 4)); }
#pragma unroll
                for (int mt = 0; mt < MTN; ++mt)
#pragma unroll
                    for (int nt = 0; nt < 4; ++nt)
                        asm volatile("v_mfma_scale_f32_16x16x128_f8f6f4 %0, %1, %2, %0, %3, %3 op_sel_hi:[0,0,0]" : "+v"(acc[mt][nt]) : "v"(afr[mt]), "v"(bfr[nt]), "v"(f8s));
            }
            asm volatile("s_nop 15\n\ts_nop 15\n\ts_waitcnt lgkmcnt(0)" ::: "memory");
            if (idx + 8 < SW_NCH) { const int nci = SW_CI(idx + 8); SW_LOADA(SW_ROW0(nci)); }
            if (DIR == 1 && !isctx) {
#pragma unroll
                for (int i = 0; i < MTN; ++i) { const int pp = lane + 64 * i; const size_t off = (size_t)(row0 + (pp >> 2)) * D + nb * 256 + 32 * cg + 8 * (pp & 3);
                    hfr[i] = *(const v4u*)(GH + off); gr[i] = *(const v4u*)(Gp + off); }
            }
#pragma unroll
            for (int ct = 0; ct < 2; ++ct) {
                float a[MTN][4], bc[MTN][4];
#pragma unroll
                for (int mt = 0; mt < MTN; ++mt)
#pragma unroll
                    for (int r = 0; r < 4; ++r) {
                        const float rg = __builtin_amdgcn_rcpf(1.f + __expf(-(acc[mt][ct * 2 + 0][r] + br[ct]))), ig = __builtin_amdgcn_rcpf(1.f + __expf(-(acc[mt][ct * 2 + 1][r] + bi[ct])));
                        const float av = __expf(lam8[ct] * rg); a[mt][r] = av; bc[mt][r] = __builtin_amdgcn_sqrtf(fmaxf(1.f - av * av, 0.f)) * (ig * uu[ct][mt][r]); }
                float ca = 1.f, cbv = 0.f;
#pragma unroll
                for (int q4 = 0; q4 < MTN; ++q4) { const int mt = DIR == 0 ? q4 : MTN - 1 - q4;
                    float A = 1.f, B = 0.f;
#pragma unroll
                    for (int rr = 0; rr < 4; ++rr) { const int r = DIR == 0 ? rr : 3 - rr; A = A * a[mt][r]; B = a[mt][r] * B + bc[mt][r]; }
                    float ta = 1.f, tb = 0.f, ea = 1.f, eb = 0.f, Ar[4], Br[4];
                    rows4(A, Ar); rows4(B, Br);
#pragma unroll
                    for (int q = 0; q < 4; ++q) { const int gg = DIR == 0 ? q : 3 - q;
                        const float Ag = Ar[gg], Bg = Br[gg];
                        if (gg == g) { ea = ta; eb = tb; }
                        tb = Ag * tb + Bg; ta = ta * Ag; }
                    float pa = ea * ca, pb = ea * cbv + eb;
#pragma unroll
                    for (int rr = 0; rr < 4; ++rr) { const int r = DIR == 0 ? rr : 3 - rr; pb = a[mt][r] * pb + bc[mt][r]; pa = pa * a[mt][r]; Pc[ct][mt][r] = pa; Hc[ct][mt][r] = pb; }
                    cbv = ta * cbv + tb; ca = ca * ta; }
                CA[ct] = ca; CB[ct] = cbv;
            }
        }
        if (g == 0) { AGG[(((s & 1) * 8 + w) * 2 + 0) * 16 + lc] = (f32x2){CA[0], CB[0]}; AGG[(((s & 1) * 8 + w) * 2 + 1) * 16 + lc] = (f32x2){CA[1], CB[1]}; }
        __syncthreads();
        float hin[2];
#pragma unroll
        for (int ct = 0; ct < 2; ++ct) { float h = hprev[ct]; hin[ct] = h;
#pragma unroll
            for (int ww = 0; ww < 8; ++ww) { const f32x2 ab = AGG[(((s & 1) * 8 + ww) * 2 + ct) * 16 + lc]; if (ww == w) hin[ct] = h; h = ab.x * h + ab.y; }
            hprev[ct] = h; }
        if (active && !isctx) {
            LAS unsigned char* US = AT;
            if (DIR == 1) {
#pragma unroll
                for (int i = 0; i < MTN; ++i) { const int pp = lane + 64 * i; *(LAS v4u*)(US + (pp >> 2) * 80 + 16 * (pp & 3)) = hfr[i]; *(LAS v4u*)(GS + (pp >> 2) * 80 + 16 * (pp & 3)) = gr[i]; }
                asm volatile("s_waitcnt lgkmcnt(0)" ::: "memory");
            }
#pragma unroll
            for (int ct = 0; ct < 2; ++ct)
#pragma unroll
                for (int mt = 0; mt < MTN; ++mt)
#pragma unroll
                    for (int r = 0; r < 4; ++r) { const float h = Pc[ct][mt][r] * hin[ct] + Hc[ct][mt][r];
                        const int so = (16 * mt + 4 * g + r) * 80 + (16 * ct + lc) * 2;
                        float o = h;
                        if (DIR == 1) o = (bf2f(*(const LAS unsigned short*)(US + so)) + h) * bf2f(*(const LAS unsigned short*)(GS + so));
                        *(LAS unsigned short*)(US + so) = (unsigned short)f2bf(o); }
            asm volatile("s_waitcnt lgkmcnt(0)" ::: "memory");
#pragma unroll
            for (int i = 0; i < MTN; ++i) { const int pp = lane + 64 * i; const size_t off = (size_t)(row0 + (pp >> 2)) * D + nb * 256 + 32 * cg + 8 * (pp & 3);
                *(v4u*)(GH + off) = *(const LAS v4u*)(US + (pp >> 2) * 80 + 16 * (pp & 3)); }
            asm volatile("s_waitcnt lgkmcnt(0)" ::: "memory");
        }
    }
#undef SW_CI
#undef SW_ROW0
#undef SW_LOADA
    __syncthreads();
}

constexpr float LOG2E = 1.4426950408889634f;
__device__ __forceinline__ bf16x8 pack8(const f32x4 a, const f32x4 b) {
    v4u w; w.x = pg8::cvt_pk_bf16(a.x, a.y); w.y = pg8::cvt_pk_bf16(a.z, a.w); w.z = pg8::cvt_pk_bf16(b.x, b.y); w.w = pg8::cvt_pk_bf16(b.z, b.w);
    return __builtin_bit_cast(bf16x8, w);
}
constexpr int AK_C = 0, AV_C = 32768, AK_W = 67584, AV_W = 67584, A_RPB = 143360;
__device__ __forceinline__ int kswz(int k) { return ((k >> 1) & 1) | (((k >> 3) & 3) << 1); }
__device__ __forceinline__ void attn_stage_ctx(Frame& F, const bf16* QK, const bf16* VT, int b, int h) {
    v4u kr[4], vr[4]; int tid_ = F.tid; asm volatile("" : "+v"(tid_));
#pragma unroll
    for (int i = 0; i < 4; ++i) { const int pid = tid_ + 512 * i; { const int key = pid >> 3, c = pid & 7; kr[i] = *(const v4u*)(QK + (size_t)(NL + b * CTXL + key) * 2048 + 1024 + h * 64 + c * 8); }
        { const int dim = pid >> 5, c = pid & 31; vr[i] = *(const v4u*)(VT + (size_t)(h * 64 + dim) * MT + NL + b * CTXL + c * 8); } }
#pragma unroll
    for (int i = 0; i < 4; ++i) { const int pid = tid_ + 512 * i; { const int key = pid >> 3, c = pid & 7; *(LAS v4u*)(F.lds + AK_C + key * 128 + ((c ^ kswz(key & 31)) << 4)) = kr[i]; }
        { const int dim = pid >> 5, c = pid & 31; *(LAS v4u*)(F.lds + AV_C + dim * 544 + c * 16) = vr[i]; } }
    __syncthreads();
}
__device__ __forceinline__ void attn_load_kw(const bf16* QK, int b, int h, int rb, int tid, v4u (&kr)[9]) {
    asm volatile("" : "+v"(tid));
#pragma unroll
    for (int i = 0; i < 9; ++i) { const int pid = tid + 512 * i, key = pid >> 3, c = pid & 7; int row = rb + (key >> 6); row = row > 63 ? 63 : row;
        kr[i] = *(const v4u*)(QK + (size_t)(b * SEQ + row * 64 + (key & 63)) * 2048 + 1024 + h * 64 + c * 8); }
}
__device__ __forceinline__ void attn_store_kw(LAS unsigned char* lds, int tid, const v4u (&kr)[9]) {
    asm volatile("" : "+v"(tid));
#pragma unroll
    for (int i = 0; i < 9; ++i) { const int pid = tid + 512 * i, key = pid >> 3, c = pid & 7; *(LAS v4u*)(lds + AK_W + key * 128 + ((c ^ kswz(key & 31)) << 4)) = kr[i]; }
}
__device__ __forceinline__ void attn_load_vw(const bf16* VT, int b, int h, int rb, int tid, v4u (&vr)[9]) {
    asm volatile("" : "+v"(tid));
#pragma unroll
    for (int i = 0; i < 9; ++i) { const int pid = tid + 512 * i, dim = pid / 72, c = pid % 72; int row = rb + (c >> 3); row = row > 63 ? 63 : row;
        vr[i] = *(const v4u*)(VT + (size_t)(h * 64 + dim) * MT + b * SEQ + row * 64 + (c & 7) * 8); }
}
__device__ __forceinline__ void attn_store_vw(LAS unsigned char* lds, int tid, const v4u (&vr)[9]) {
    asm volatile("" : "+v"(tid));
#pragma unroll
    for (int i = 0; i < 9; ++i) { const int pid = tid + 512 * i, dim = pid / 72, c = pid % 72; *(LAS v4u*)(lds + AV_W + dim * 1184 + c * 16) = vr[i]; }
}
constexpr int AV_T = LDSCTL_OFF + 1024;
__device__ __forceinline__ void attn_dma_vw(LAS unsigned char* lds, const bf16* VT, int b, int h, int rb, int w, int lane) {
    unsigned voff = (unsigned)lane * 16u; asm volatile("" : "+v"(voff));
#pragma unroll
    for (int j = 0; j < 8; ++j) { const int dim = 8 * w + j;
        const char* src = (const char*)(VT + (size_t)(h * 64 + dim) * MT + b * SEQ + rb * 64);
        __builtin_amdgcn_global_load_lds((const unsigned*)(src + voff), (LAS unsigned*)(lds + AV_W + dim * 1184), 16, 0, 0); }
    { const char* src = (const char*)(VT + (size_t)(h * 64 + 8 * w) * MT + b * SEQ + (rb + 8) * 64);
      __builtin_amdgcn_global_load_lds((const unsigned*)(src + (size_t)(voff >> 7) * (MT * 2) + (voff & 127u)), (LAS unsigned*)(lds + AV_T + w * 1024), 16, 0, 0); }
}
__device__ __forceinline__ float xrow_max(float x) {
    auto s = __builtin_amdgcn_permlane16_swap(__float_as_uint(x), __float_as_uint(x), false, false); x = fmaxf(__uint_as_float(s[0]), __uint_as_float(s[1]));
    auto t = __builtin_amdgcn_permlane32_swap(__float_as_uint(x), __float_as_uint(x), false, false); return fmaxf(__uint_as_float(t[0]), __uint_as_float(t[1]));
}
__device__ __forceinline__ float xrow_sum(float x) {
    auto s = __builtin_amdgcn_permlane16_swap(__float_as_uint(x), __float_as_uint(x), false, false); x = __uint_as_float(s[0]) + __uint_as_float(s[1]);
    auto t = __builtin_amdgcn_permlane32_swap(__float_as_uint(x), __float_as_uint(x), false, false); return __uint_as_float(t[0]) + __uint_as_float(t[1]);
}
template <bool LAT>
__device__ __forceinline__ void attn_unit(Frame& F, const bf16* QK, const bf16* VT, bf16* O, int b, int h, int rp_or_half, v4u (&kr)[9], bool has_next, int nrb) {
    int lane_ = F.lane; asm volatile("" : "+v"(lane_));
    const int lane = lane_, g = lane >> 4, lc = lane & 15, w = F.wave;
    const f32x4 zero4 = (f32x4){0.f, 0.f, 0.f, 0.f};
    int r = 0, qt = 0, tokq0, span0 = 0, rs = 0, rb = 0, wro = 0;
    if (LAT) { r = 2 * rp_or_half + (w >> 2); qt = w & 3; tokq0 = b * SEQ + r * 64 + 16 * qt; span0 = qt == 0 ? 0 : (qt == 1 ? 8 : (qt == 2 ? 24 : 32));
        rs = r - 4 < 0 ? 0 : (r - 4 > 56 ? 56 : r - 4); const int r0 = 2 * rp_or_half; rb = r0 - 4 < 0 ? 0 : (r0 - 4 > 56 ? 56 : r0 - 4); wro = rs - rb; }
    else { tokq0 = NL + b * CTXL + rp_or_half * 128 + 16 * w; }
    const bf16* qp = QK + (size_t)(tokq0 + lc) * 2048 + h * 64 + 8 * g;
    const bf16x8 qf0 = *(const bf16x8*)qp, qf1 = *(const bf16x8*)(qp + 32);
    if (LAT) { attn_store_kw(F.lds, F.tid, kr); __builtin_amdgcn_sched_barrier(0); }
    const int kk0 = 8 * (lc >> 2) + (lc & 3);
    f32x4 sc[8][2]; bf16x8 pc[8]; f32x4 o[4];
#pragma unroll
    for (int cp = 0; cp < 8; ++cp)
#pragma unroll
        for (int p = 0; p < 2; ++p) { const int key = 32 * cp + kk0 + 4 * p; const int sz = kswz(key & 31);
            const bf16x8 k0 = *(const LAS bf16x8*)(F.lds + AK_C + key * 128 + ((g ^ sz) << 4)), k1 = *(const LAS bf16x8*)(F.lds + AK_C + key * 128 + (((4 + g) ^ sz) << 4));
            f32x4 a = __builtin_amdgcn_mfma_f32_16x16x32_bf16(k0, qf0, zero4, 0, 0, 0);
            sc[cp][p] = __builtin_amdgcn_mfma_f32_16x16x32_bf16(k1, qf1, a, 0, 0, 0); if (p == 1) asm volatile("" ::: "memory"); }
    float l = 0.f, mc = -1e30f;
#define ATT_CMAX() do { _Pragma("unroll") for (int i_ = 0; i_ < 8; ++i_) _Pragma("unroll") for (int p_ = 0; p_ < 2; ++p_) _Pragma("unroll") for (int j_ = 0; j_ < 4; ++j_) mc = fmaxf(mc, sc[i_][p_][j_]); mc = xrow_max(mc); } while (0)
#define ATT_CEXP(cp_) do { f32x4 e_[2]; _Pragma("unroll") for (int p_ = 0; p_ < 2; ++p_) _Pragma("unroll") for (int j_ = 0; j_ < 4; ++j_) { e_[p_][j_] = __builtin_amdgcn_exp2f(sc[cp_][p_][j_] - mc); l += e_[p_][j_]; } \
        pc[cp_] = pack8(e_[0], e_[1]); asm volatile("" : "+v"(l));   } while (0)
#define ATT_PVC(cp_) do { _Pragma("unroll") for (int dt = 0; dt < 4; ++dt) { const bf16x8 vf = *(const LAS bf16x8*)(F.lds + AV_C + (16 * dt + lc) * 544 + (32 * (cp_) + 8 * g) * 2); \
        o[dt] = __builtin_amdgcn_mfma_f32_16x16x32_bf16(vf, pc[cp_], o[dt], 0, 0, 0); } asm volatile("" ::: "memory"); } while (0)
    if (LAT) {
        f32x4 sw[8][2]; bf16x8 pw[8];
        __syncthreads();
#pragma unroll
        for (int i = 0; i < 8; ++i) {
#pragma unroll
            for (int p = 0; p < 2; ++p) { const int key = (wro + i) * 64 + span0 + kk0 + 4 * p; const int sz = kswz(key & 31);
                const bf16x8 k0 = *(const LAS bf16x8*)(F.lds + AK_W + key * 128 + ((g ^ sz) << 4)), k1 = *(const LAS bf16x8*)(F.lds + AK_W + key * 128 + (((4 + g) ^ sz) << 4));
                f32x4 a = __builtin_amdgcn_mfma_f32_16x16x32_bf16(k0, qf0, zero4, 0, 0, 0);
                sw[i][p] = __builtin_amdgcn_mfma_f32_16x16x32_bf16(k1, qf1, a, 0, 0, 0); }
            asm volatile("" ::: "memory");
            if (i == 0) ATT_CMAX(); else ATT_CEXP(i - 1);
            __builtin_amdgcn_sched_barrier(0);
        }
        ATT_CEXP(7);
        __syncthreads();
        attn_dma_vw(F.lds, VT, b, h, rb, w, lane);
        const LAS float* RPB = (const LAS float*)(F.lds + A_RPB);
        const int c = 16 * qt + lc; const int cs = c - 8 < 0 ? 0 : (c - 8 > 48 ? 48 : c - 8);
        const int cb0 = span0 + 8 * g;
        float mw = -1e30f, m2 = mc, alpha = 1.f;
#pragma unroll
        for (int dt = 0; dt < 4; ++dt) o[dt] = zero4;
#define ATT_WBIAS(i_) do { const LAS float* rowb = RPB + (rs + (i_) - r + 7) * 31 + (cb0 - c + 15); float bv[8]; \
        _Pragma("unroll") for (int x = 0; x < 8; ++x) bv[x] = rowb[x]; \
        asm volatile("" : "+v"(bv[0]), "+v"(bv[1]), "+v"(bv[2]), "+v"(bv[3]), "+v"(bv[4]), "+v"(bv[5]), "+v"(bv[6]), "+v"(bv[7]));   \
        _Pragma("unroll") for (int p_ = 0; p_ < 2; ++p_) _Pragma("unroll") for (int j_ = 0; j_ < 4; ++j_) { const bool ok = (unsigned)(cb0 - cs + 4 * p_ + j_) < 16u; \
            const float v_ = ok ? sw[i_][p_][j_] + bv[4 * p_ + j_] : -1e30f; sw[i_][p_][j_] = v_; mw = fmaxf(mw, v_); } } while (0)
#define ATT_WEXP(i_) do { f32x4 e_[2]; _Pragma("unroll") for (int p_ = 0; p_ < 2; ++p_) _Pragma("unroll") for (int j_ = 0; j_ < 4; ++j_) { e_[p_][j_] = __builtin_amdgcn_exp2f(sw[i_][p_][j_] - m2); l += e_[p_][j_]; } \
        pw[i_] = pack8(e_[0], e_[1]); asm volatile("" : "+v"(l)); } while (0)
#pragma unroll
        for (int cp = 0; cp < 8; ++cp) {
            ATT_PVC(cp);
            if (cp < 4) { ATT_WBIAS(2 * cp); ATT_WBIAS(2 * cp + 1); }
            else if (cp == 4) { mw = xrow_max(mw); m2 = fmaxf(mc, mw); alpha = __builtin_amdgcn_exp2f(mc - m2); l *= alpha; }
            else if (cp == 5) { ATT_WEXP(0); ATT_WEXP(1); ATT_WEXP(2); }
            else if (cp == 6) { ATT_WEXP(3); ATT_WEXP(4); ATT_WEXP(5); }
            else { ATT_WEXP(6); ATT_WEXP(7); }
            __builtin_amdgcn_sched_barrier(0);
        }
#pragma unroll
        for (int dt = 0; dt < 4; ++dt) o[dt] = o[dt] * alpha;
        asm volatile("s_waitcnt vmcnt(0)" ::: "memory");
        __syncthreads();
        if (has_next) attn_load_kw(QK, b, h, nrb, F.tid, kr);
#pragma unroll
        for (int i = 0; i < 8; ++i)
#pragma unroll
            for (int dt = 0; dt < 4; ++dt) { const int dim = 16 * dt + lc;
                const int voffs = (i == 7 && wro == 1) ? AV_T + dim * 128 + (span0 + 8 * g) * 2 : AV_W + dim * 1184 + ((wro + i) * 64 + span0 + 8 * g) * 2;
                const bf16x8 vf = *(const LAS bf16x8*)(F.lds + voffs); o[dt] = __builtin_amdgcn_mfma_f32_16x16x32_bf16(vf, pw[i], o[dt], 0, 0, 0); if (dt == 3) asm volatile("" ::: "memory"); }
#undef ATT_WBIAS
#undef ATT_WEXP
    } else {
        ATT_CMAX();
#pragma unroll
        for (int cp = 0; cp < 8; ++cp) ATT_CEXP(cp);
#pragma unroll
        for (int dt = 0; dt < 4; ++dt) o[dt] = zero4;
#pragma unroll
        for (int cp = 0; cp < 8; ++cp) ATT_PVC(cp);
    }
#undef ATT_CMAX
#undef ATT_CEXP
#undef ATT_PVC
    l = xrow_sum(l);
    const float inv = __builtin_amdgcn_rcpf(l);
    unsigned char* op = (unsigned char*)O + (size_t)(tokq0 + lc) * D + h * 64 + 4 * g;
#pragma unroll
    for (int dt = 0; dt < 4; ++dt) *(unsigned*)(op + 16 * dt) = pk4_fp8(o[dt].x * inv, o[dt].y * inv, o[dt].z * inv, o[dt].w * inv);
    if (LAT) __syncthreads();
}
__device__ __forceinline__ void attn_phase(Frame& F) {
    const bf16* QK = (const bf16*)(F.ws + WS_B);
    const bf16* VT = (const bf16*)(F.ws + WS_C);
    bf16* O = (bf16*)(F.ws + WS_A);
    const int NUB = BATCH * NHEAD * 32, per = (NUB + F.G - 1) / F.G;
    int u0 = F.vcu * per, u1 = u0 + per; if (u1 > NUB) u1 = NUB;
    int cb = -1, ch = -1; v4u kr[9];
    for (int u = u0; u < u1; ++u) {
        const int b = u >> 9, h = (u >> 5) & 15, rp = u & 31;
        if (b != cb || h != ch) { __syncthreads(); attn_stage_ctx(F, QK, VT, b, h); if (F.tid < 465) ((LAS float*)(F.lds + A_RPB))[F.tid] = F.in[I_RPB][h * 465 + F.tid] * LOG2E; cb = b; ch = h;
            { const int r0 = 2 * rp; attn_load_kw(QK, b, h, r0 - 4 < 0 ? 0 : (r0 - 4 > 56 ? 56 : r0 - 4), F.tid, kr); } __syncthreads(); }
        const int un = u + 1; const bool hn = un < u1 && (un >> 5) == (u >> 5); const int nr0 = 2 * (un & 31);
        attn_unit<true>(F, QK, VT, O, b, h, rp, kr, hn, nr0 - 4 < 0 ? 0 : (nr0 - 4 > 56 ? 56 : nr0 - 4));
        if (un < u1 && !hn) { cb = -1; }
    }
    for (int u = F.vcu; u < BATCH * NHEAD * 2; u += F.G) {
        const int b = u >> 5, h = (u >> 1) & 15, half = u & 1;
        if (b != cb || h != ch) { __syncthreads(); attn_stage_ctx(F, QK, VT, b, h); cb = b; ch = h; }
        attn_unit<false>(F, QK, VT, O, b, h, half, kr, false, 0);
    }
    __syncthreads();
}
constexpr int LC_CNT = 256, LC_BASE = 384, LC_TSTART = 512, LC_ECNT = 768, LC_REC = 1024;
struct RouteRec { int e0, e1, p0, p1; float w0, w1; int pad0, pad1; };
__device__ __forceinline__ void reduce8(const float (&a)[8], float (&out)[8], int lane) {
#define R8_DPP(x, ctrl) __builtin_bit_cast(float, __builtin_amdgcn_update_dpp(0, __builtin_bit_cast(int, x), ctrl, 0xF, 0xF, false))
    float t[4], u[2];
#pragma unroll
    for (int i = 0; i < 4; ++i) { auto r = __builtin_amdgcn_permlane32_swap(__float_as_uint(a[i]), __float_as_uint(a[i + 4]), false, false); t[i] = __uint_as_float(r[0]) + __uint_as_float(r[1]); }
#pragma unroll
    for (int i = 0; i < 2; ++i) { auto r = __builtin_amdgcn_permlane16_swap(__float_as_uint(t[i]), __float_as_uint(t[i + 2]), false, false); u[i] = __uint_as_float(r[0]) + __uint_as_float(r[1]); }
    const bool hi8 = (lane & 8) != 0;
    float keep = hi8 ? u[1] : u[0]; const float send = hi8 ? u[0] : u[1];
    keep += R8_DPP(send, 0x128);
    keep += R8_DPP(keep, 0x141); keep += R8_DPP(keep, 0xB1); keep += R8_DPP(keep, 0x4E);
#pragma unroll
    for (int k = 0; k < 8; ++k) out[k] = __builtin_bit_cast(float, __builtin_amdgcn_readlane(__builtin_bit_cast(int, keep), 8 * k));
#undef R8_DPP
}
__device__ __forceinline__ void norm2_router(Frame& F, int layer, int nrows) {
    LAS f32x4* WT = (LAS f32x4*)F.lds;
    LAS int* cnt = (LAS int*)(F.lds + LDSCTL_OFF + LC_CNT); LAS int* base = (LAS int*)(F.lds + LDSCTL_OFF + LC_BASE);
    LAS v4u* rec = (LAS v4u*)(F.lds + LDSCTL_OFF + LC_REC);
    const float* wg = F.in[I_MWG] + (size_t)layer * D * 4; const float* we = F.in[I_MWE] + (size_t)layer * 4 * D * 8;
    { f32x4 wt[18];
#pragma unroll
      for (int q = 0; q < 18; ++q) { const int pid = F.tid + NTHREADS * q; const int plane = pid >> 10, pos = pid & 1023, k = 4 * (pos & 63) + 256 * (pos >> 8) + ((pos >> 6) & 3);
          wt[q] = plane == 0 ? *(const f32x4*)(wg + k * 4) : *(const f32x4*)(we + ((size_t)((plane - 1) >> 1) * 1024 + k) * 8 + ((plane - 1) & 1) * 4); }
#pragma unroll
      for (int q = 0; q < 18; ++q) WT[F.tid + NTHREADS * q] = wt[q]; }
    if (F.tid < 32) cnt[F.tid] = 0;
    __syncthreads();
    const int rpb = nrows / F.G, rbase = blockIdx.x * rpb;
    const float* gam = F.in[I_NORMG] + (layer * 2 + 1) * D;
    unsigned char* HL2 = F.ws + WS_HL2;
    const float* bg = F.in[I_MBG] + layer * 4; const float* be = F.in[I_MBE] + layer * 32;
    typedef float f32x2 __attribute__((ext_vector_type(2)));
    int cur_mr = -1; f32x4 mA[4], mB[4]; v2u raw[2][4];
    const bf16* XLp = (const bf16*)(F.ws + WS_XL);
    if (F.wave < rpb / 2) {
#pragma unroll
        for (int q = 0; q < 2; ++q)
#pragma unroll
            for (int j = 0; j < 4; ++j) raw[q][j] = ((const v2u*)(XLp + (size_t)(rbase + 2 * F.wave + q) * D))[64 * j + F.lane]; }
    for (int pr = F.wave; pr < rpb / 2; pr += NWAVES) {
        f32x4 v[2][4];
#pragma unroll
        for (int q = 0; q < 2; ++q)
#pragma unroll
            for (int j = 0; j < 4; ++j) { const v2u w = raw[q][j]; v[q][j] = (f32x4){bflo(w.x), bfhi(w.x), bflo(w.y), bfhi(w.y)}; }
        if (pr + NWAVES < rpb / 2) {
#pragma unroll
            for (int q = 0; q < 2; ++q)
#pragma unroll
                for (int j = 0; j < 4; ++j) raw[q][j] = ((const v2u*)(XLp + (size_t)(rbase + 2 * (pr + NWAVES) + q) * D))[64 * j + F.lane]; }
#pragma unroll
        for (int q = 0; q < 2; ++q) { const int r = rbase + 2 * pr + q; const int mr = row_mod(r);
            if (mr != cur_mr) { cur_mr = mr; const float* sc = modp(F, layer, mr, 4); const float* sh = modp(F, layer, mr, 3);
#pragma unroll
                for (int j = 0; j < 4; ++j) { mA[j] = ((const f32x4*)gam)[64 * j + F.lane] * (((const f32x4*)sc)[64 * j + F.lane] + 1.0f); mB[j] = ((const f32x4*)sh)[64 * j + F.lane]; } }
            const float rstd = row_rstd(v[q]);
#pragma unroll
            for (int j = 0; j < 4; ++j) v[q][j] = (v[q][j] * rstd) * mA[j] + mB[j];
#pragma unroll
            for (int j = 0; j < 4; ++j) ((unsigned*)(HL2 + (size_t)r * D))[64 * j + F.lane] = pk4_fp8(v[q][j].x, v[q][j].y, v[q][j].z, v[q][j].w); }
        f32x2 ga2[2][2];
#pragma unroll
        for (int q = 0; q < 2; ++q) { ga2[q][0] = (f32x2){0.f, 0.f}; ga2[q][1] = (f32x2){0.f, 0.f}; }
#pragma unroll
        for (int j = 0; j < 4; ++j)
#pragma unroll
            for (int i = 0; i < 4; ++i) { const f32x4 w = WT[(4 * j + i) * 64 + F.lane];
                const f32x2 wlo = (f32x2){w.x, w.y}, whi = (f32x2){w.z, w.w};
#pragma unroll
                for (int q = 0; q < 2; ++q) { const float x = v[q][j][i]; const f32x2 xs = (f32x2){x, x};
                    ga2[q][0] = __builtin_elementwise_fma(xs, wlo, ga2[q][0]); ga2[q][1] = __builtin_elementwise_fma(xs, whi, ga2[q][1]); } }
        float ga[2][4];
#pragma unroll
        for (int q = 0; q < 2; ++q) { ga[q][0] = ga2[q][0].x; ga[q][1] = ga2[q][0].y; ga[q][2] = ga2[q][1].x; ga[q][3] = ga2[q][1].y; }
        float gsum[8];
        { float gin[8];
#pragma unroll
          for (int q = 0; q < 2; ++q)
#pragma unroll
              for (int n = 0; n < 4; ++n) gin[4 * q + n] = ga[q][n];
          reduce8(gin, gsum, F.lane); }
#pragma unroll
        for (int q = 0; q < 2; ++q) {
            float gl[4];
#pragma unroll
            for (int n = 0; n < 4; ++n) gl[n] = gsum[4 * q + n] + bg[n];
            int gs = 0; float gm = gl[0];
#pragma unroll
            for (int n = 1; n < 4; ++n) if (gl[n] > gm) { gm = gl[n]; gs = n; }
            gs = __builtin_amdgcn_readfirstlane(gs);
            float den = 0.f;
#pragma unroll
            for (int n = 0; n < 4; ++n) den += __expf(gl[n] - gm);
            const float gprob = 1.f / den;
            const LAS f32x4* wb = WT + (1 + 2 * gs) * 1024 + F.lane;
            float el[8]; f32x2 el2[4];
#pragma unroll
            for (int x = 0; x < 4; ++x) el2[x] = (f32x2){0.f, 0.f};
#pragma unroll
            for (int j = 0; j < 4; ++j)
#pragma unroll
                for (int i = 0; i < 4; ++i) { const f32x4 w0 = wb[(4 * j + i) * 64], w1 = wb[1024 + (4 * j + i) * 64];
                    const float x_ = v[q][j][i]; const f32x2 xs = (f32x2){x_, x_};
                    el2[0] = __builtin_elementwise_fma(xs, (f32x2){w0.x, w0.y}, el2[0]); el2[1] = __builtin_elementwise_fma(xs, (f32x2){w0.z, w0.w}, el2[1]);
                    el2[2] = __builtin_elementwise_fma(xs, (f32x2){w1.x, w1.y}, el2[2]); el2[3] = __builtin_elementwise_fma(xs, (f32x2){w1.z, w1.w}, el2[3]); }
#pragma unroll
            for (int x = 0; x < 4; ++x) { el[2 * x] = el2[x].x; el[2 * x + 1] = el2[x].y; }
            { float es[8]; reduce8(el, es, F.lane);
#pragma unroll
              for (int x = 0; x < 8; ++x) el[x] = es[x] + be[gs * 8 + x]; }
            int i0 = 0; float v0 = el[0];
#pragma unroll
            for (int x = 1; x < 8; ++x) if (el[x] > v0) { v0 = el[x]; i0 = x; }
            int i1 = -1; float v1 = -3.0e38f;
#pragma unroll
            for (int x = 0; x < 8; ++x) if (x != i0 && el[x] > v1) { v1 = el[x]; i1 = x; }
            const float w0 = 1.f / (1.f + __expf(v1 - v0));
            if (F.lane == 0) { const int e0 = gs * 8 + i0, e1 = gs * 8 + i1;
                const int p0 = __hip_atomic_fetch_add(&cnt[e0], 1, __ATOMIC_RELAXED, __HIP_MEMORY_SCOPE_WORKGROUP), p1 = __hip_atomic_fetch_add(&cnt[e1], 1, __ATOMIC_RELAXED, __HIP_MEMORY_SCOPE_WORKGROUP);
                rec[2 * (2 * pr + q)] = (v4u){(unsigned)e0, (unsigned)e1, (unsigned)p0, (unsigned)p1};
                rec[2 * (2 * pr + q) + 1] = (v4u){__builtin_bit_cast(unsigned, gprob * w0), __builtin_bit_cast(unsigned, gprob * (1.f - w0)), 0u, 0u}; }
        }
    }
    __syncthreads();
    unsigned* gcnt = (unsigned*)(F.ws + WS_CTL) + CW_ECNT + layer * 64;
    if (F.tid < 32) base[F.tid] = (int)__hip_atomic_fetch_add(gcnt + F.tid, (unsigned)cnt[F.tid], RLX_AGENT);
    __syncthreads();
    v4u* ROUTE = (v4u*)(F.ws + WS_ROUTE); int* SRCROW = (int*)(F.ws + WS_SRCROW);
    for (int i = F.tid; i < rpb; i += NTHREADS) { v4u a = rec[2 * i]; const v4u b2 = rec[2 * i + 1]; a.z += (unsigned)base[a.x]; a.w += (unsigned)base[a.y]; ROUTE[2 * (rbase + i)] = a; ROUTE[2 * (rbase + i) + 1] = b2;
        SRCROW[(size_t)a.x * MT + a.z] = rbase + i; SRCROW[(size_t)a.y * MT + a.w] = rbase + i; }
    __syncthreads();
}
__device__ __forceinline__ void moe_tile_starts(Frame& F, int layer) {
    LAS int* ts = (LAS int*)(F.lds + LDSCTL_OFF + LC_TSTART);
    if (F.wave == 0) {
        const unsigned* gcnt = (const unsigned*)(F.ws + WS_CTL) + CW_ECNT + layer * 64; LAS int* ec = (LAS int*)(F.lds + LDSCTL_OFF + LC_ECNT);
        const int lane = F.lane; const int cn = lane < 32 ? (int)__hip_atomic_load(gcnt + lane, RLX_AGENT) : 0; const int tiles = (cn + 255) >> 8;
        int incl = tiles;
#pragma unroll
        for (int d = 1; d < 32; d <<= 1) { const int t = __shfl_up(incl, d); if (lane >= d) incl += t; }
        if (lane < 32) { ec[lane] = cn; ts[lane] = incl - tiles; }
        if (lane == 31) ts[32] = incl; }
    __syncthreads();
}
template <bool GATHER_>
struct MoeSched {
    static constexpr bool GATHER = GATHER_;
    const LAS int* ts; int G, c; const char* A; const char* B; size_t strideA, strideBe, strideBn; const int* srcrow;
    __device__ __forceinline__ bool next(int i, pg8::Unit& u) const {
        if (!pg8::order_next(__builtin_amdgcn_readfirstlane(ts[32]), 4, G, c, i, u.pm, u.pn)) return false;
        const int lane = (int)__builtin_amdgcn_mbcnt_hi(~0u, __builtin_amdgcn_mbcnt_lo(~0u, 0u));
        const int e = __builtin_popcount((unsigned)__builtin_amdgcn_ballot_w64(ts[lane & 31] <= u.pm)) - 1;
        u.a = GATHER ? A : A + (size_t)u.pm * strideA; u.b = B + (size_t)e * strideBe + (size_t)u.pn * strideBn; u.aux = e; return true;
    }
    __device__ __forceinline__ const int* row_ptr(const pg8::Unit& u, int r) const {
        const int e = u.aux; const int p0 = (u.pm - __builtin_amdgcn_readfirstlane(ts[e])) * 256; const int cn = __builtin_amdgcn_readfirstlane(ts[64 + e]);
        const int pos = p0 + r; return srcrow + (size_t)e * MT + (pos < cn ? pos : p0);
    }
    __device__ __forceinline__ int row_of(const pg8::Unit& u, int r) const { return *row_ptr(u, r); }
    __device__ __forceinline__ void a_offsets(const pg8::Unit& u, const pg8::Gemm& g, const int (&R)[2], const int (&C)[2], unsigned (&v)[2][2]) const {
        if (GATHER) {
            int row[2][2];
#pragma unroll
            for (int h = 0; h < 2; ++h)
#pragma unroll
                for (int i = 0; i < 2; ++i) row[h][i] = row_of(u, h * 128 + R[i]);
#pragma unroll
            for (int h = 0; h < 2; ++h)
#pragma unroll
                for (int i = 0; i < 2; ++i) v[h][i] = (unsigned)(row[h][i] * g.lda + C[i]);
        } else {
#pragma unroll
            for (int h = 0; h < 2; ++h)
#pragma unroll
                for (int i = 0; i < 2; ++i) v[h][i] = (unsigned)((h * 128 + R[i]) * g.lda + C[i]);
        }
    }
};
static_assert(LC_ECNT - LC_TSTART == 256, "MoeSched reads the expert counts at ts[64 + e]");
struct EpiSwiglu {
    static constexpr bool PERM = true;
    unsigned char* O;
    __device__ __forceinline__ void operator()(const f32x4 (&acc)[2][2][4][2], const pg8::Unit& u, int wr, int wc, int fr, int fq) const {
        const int row0 = u.pm * 256 + wr * 64 + fr, col0 = u.pn * 128 + wc * 32 + 8 * fq;
#pragma unroll
        for (int ai = 0; ai < 2; ++ai)
#pragma unroll
            for (int m = 0; m < 4; ++m) {
                f32x4 h0, h1;
#pragma unroll
                for (int j = 0; j < 4; ++j) { const float a = acc[ai][0][m][0][j], b = acc[ai][0][m][1][j]; h0[j] = a * __builtin_amdgcn_rcpf(1.f + __expf(-a)) * acc[ai][1][m][0][j]; h1[j] = b * __builtin_amdgcn_rcpf(1.f + __expf(-b)) * acc[ai][1][m][1][j]; }
                v2u w; w.x = pk4_fp8(h0.x, h0.y, h0.z, h0.w); w.y = pk4_fp8(h1.x, h1.y, h1.z, h1.w);
                *(v2u*)(O + (size_t)(row0 + ai * 128 + m * 16) * EFF + col0) = w;
            }
    }
};
__device__ __forceinline__ void moe_gemm1(Frame& F, int layer) {
    moe_tile_starts(F, layer);
    const pg8::Gemm g{8, D, D};
    MoeSched<true> S{(const LAS int*)(F.lds + LDSCTL_OFF + LC_TSTART), F.G, (int)blockIdx.x, (const char*)(F.ws + WS_HL2), (const char*)(F.ws + WS_W13), 0, (size_t)1024 * 1024, (size_t)256 * D, (const int*)(F.ws + WS_SRCROW)};
    EpiSwiglu E{F.ws + WS_HDN};
    pg8::gemm_phase<EpiSwiglu, MoeSched<true>, true>(F.lds, g, S, E, F.wave);
}
__device__ __forceinline__ void moe_gemm2(Frame& F, int layer) {
    moe_tile_starts(F, layer);
    const pg8::Gemm g{4, EFF, EFF};
    MoeSched<false> S{(const LAS int*)(F.lds + LDSCTL_OFF + LC_TSTART), F.G, (int)blockIdx.x, (const char*)(F.ws + WS_HDN), (const char*)(F.ws + WS_W2), (size_t)256 * EFF, (size_t)1024 * 512, (size_t)256 * EFF, nullptr};
    EpiF8 E{F.ws + WS_XS, D};
    pg8::gemm_phase<EpiF8, MoeSched<false>, true>(F.lds, g, S, E, F.wave);
}
template <int MODE>
__device__ __forceinline__ void moe_combine(Frame& F, int layer, int nrows) {
    moe_tile_starts(F, layer);
    const LAS int* ts = (const LAS int*)(F.lds + LDSCTL_OFF + LC_TSTART);
    const int gw = F.vcu * NWAVES + F.wave, NGW = F.G * NWAVES;
    const RouteRec* ROUTE = (const RouteRec*)(F.ws + WS_ROUTE); const unsigned char* YS = F.ws + WS_XS;
    bf16* HL = (bf16*)(F.ws + WS_A);
    for (int r0 = gw * 2; r0 < nrows; r0 += NGW * 2) {
        RouteRec rr[2]; f32x4 v[2][4]; unsigned ya[2][4], yb[2][4];
#pragma unroll
        for (int q = 0; q < 2; ++q) { rr[q] = ROUTE[r0 + q]; load_row_bf16((const bf16*)(F.ws + WS_XL) + (size_t)(r0 + q) * D, F.lane, v[q]); }
#pragma unroll
        for (int q = 0; q < 2; ++q) { const int p0 = rr[q].p0 + ts[rr[q].e0] * 256, p1 = rr[q].p1 + ts[rr[q].e1] * 256;
#pragma unroll
            for (int j = 0; j < 4; ++j) { ya[q][j] = ((const unsigned*)(YS + (size_t)p0 * D))[64 * j + F.lane]; yb[q][j] = ((const unsigned*)(YS + (size_t)p1 * D))[64 * j + F.lane]; } }
#pragma unroll
        for (int q = 0; q < 2; ++q) { const int r = r0 + q;
            bf16* xp = (bf16*)(F.ws + WS_XL) + (size_t)r * D;
            const int mr = row_mod(r); const float* gt = modp(F, layer, mr, 5);
#pragma unroll
            for (int j = 0; j < 4; ++j) { const f32x2 a0 = __builtin_amdgcn_cvt_pk_f32_fp8((int)ya[q][j], false), a1 = __builtin_amdgcn_cvt_pk_f32_fp8((int)ya[q][j], true);
                const f32x2 b0 = __builtin_amdgcn_cvt_pk_f32_fp8((int)yb[q][j], false), b1 = __builtin_amdgcn_cvt_pk_f32_fp8((int)yb[q][j], true);
                const f32x4 fa = (f32x4){a0.x, a0.y, a1.x, a1.y}, fb = (f32x4){b0.x, b0.y, b1.x, b1.y};
                v[q][j] = v[q][j] + ((const f32x4*)gt)[64 * j + F.lane] * (fa * rr[q].w0 + fb * rr[q].w1); }
            if (MODE == 0) {
                store_row_bf16(xp, F.lane, v[q]);
                norm_mod(v[q], F.lane, F.in[I_NORMG] + 2 * D, modp(F, 1, mr, 0), modp(F, 1, mr, 1));
                store_row_bf16(HL + (size_t)r * D, F.lane, v[q]);
            } else {
                const float rstd = row_rstd(v[q]);
#pragma unroll
                for (int j = 0; j < 4; ++j) v[q][j] = (v[q][j] * rstd) * ((const f32x4*)F.in[I_FINALG])[64 * j + F.lane];
                store_row_f32(F.out + (size_t)r * D, F.lane, v[q]);
            }
            asm volatile("" ::: "memory");
        }
    }
}

__global__ void __launch_bounds__(NTHREADS, 2) fwd_kernel(Args args) {
    extern __shared__ __attribute__((aligned(16))) unsigned char lds[];
    Frame F;
    F.lds = (LAS unsigned char*)lds;
    F.tid = threadIdx.x; F.lane = F.tid & 63; F.wave = __builtin_amdgcn_readfirstlane(F.tid >> 6);
    F.G = gridDim.x; { const int bx = blockIdx.x; F.vcu = (F.G % 8 == 0) ? (bx % 8) * (F.G / 8) + bx / 8 : bx; }
    F.in = (const float* const __attribute__((address_space(4)))*)__builtin_amdgcn_kernarg_segment_ptr(); F.out = args.out; F.ws = args.ws;
    static_assert(offsetof(Args, in) == 0 && offsetof(Args, out) == N_IN * 8 && offsetof(Args, ws) == N_IN * 8 + 8, "kernarg table: inputs, out, ws");
    unsigned* ctl = (unsigned*)(F.ws + WS_CTL);
    for (int u = F.tid; u < (LDS_BYTES - LDSCTL_OFF) / 4; u += NTHREADS) ((LAS unsigned*)(F.lds + LDSCTL_OFF))[u] = 0u;
    __syncthreads();
    XcdBarrier bar = xcd_barrier_post(ctl + CW_BAR, (volatile LAS unsigned*)(F.lds + LDSCTL_OFF + 64));
    const int lo = args.ph_lo, hi = args.ph_hi;
#define PH_BEGIN(k) { constexpr int k_ = (k); { asm volatile("" : "+s"(F.in));  F.out = (float*)F.in[N_IN]; F.ws = (unsigned char*)F.in[N_IN + 1]; if (lo <= k_ && k_ < hi)
#define PH_END } if (lo <= k_ && k_ + 1 < hi) xcd_barrier(bar); }

    PH_BEGIN(0) { p0_mod(F); __syncthreads(); p0_small_weights(F); conv_moe_weights(F, 0, MOE_CONV_SIDE0 + F.vcu * NWAVES + F.wave, F.G * NWAVES, MOE_CONV_TAIL0); }
    PH_END
    PH_BEGIN(1) { p1_norm0(F); }
    PH_END
    PH_BEGIN(2) {
        const pg8::Gemm g{16, 2 * D, 2 * D};
        if ((int)blockIdx.x < GEMM_G) {
        { DenseSched S{136, 8, GEMM_G, (int)blockIdx.x, (const char*)(F.ws + WS_A), (const char*)(F.ws + WS_WQK), (size_t)256 * D * 2, (size_t)256 * D * 2};
          EpiBf16<0> E{(bf16*)(F.ws + WS_B), 2048, F.in[I_BQKV], 4, 0.125f * LOG2E};
          pg8::gemm_phase(F.lds, g, S, E, F.wave); }
        { DenseSched S{4, 136, GEMM_G, GEMM_G - 1 - (int)blockIdx.x, (const char*)(F.ws + WS_WV), (const char*)(F.ws + WS_A), (size_t)256 * D * 2, (size_t)256 * D * 2};
          EpiBf16RowBias E{(bf16*)(F.ws + WS_C), MT, F.in[I_BQKV] + 2 * D};
          pg8::gemm_phase(F.lds, g, S, E, F.wave); }
        } else conv_moe_weights(F, 0, ((int)blockIdx.x - GEMM_G) * NWAVES + F.wave, (F.G - GEMM_G) * NWAVES, MOE_CONV_SIDE0);
    }
    PH_END
    PH_BEGIN(3) { attn_phase(F); }
    PH_END
    PH_BEGIN(4) {
        const pg8::Gemm g{8, D, D};
        DenseSched S{136, 4, F.G, (int)blockIdx.x, (const char*)(F.ws + WS_A), (const char*)(F.ws + WS_WO), (size_t)256 * D, (size_t)256 * D};
        EpiResid<false> E{F.in[I_X], F.in[I_CTX], (bf16*)(F.ws + WS_XL), F.in[I_NABO], modp(F, 0, 0, 2)};
        pg8::gemm_phase<EpiResid<false>, DenseSched, true>(F.lds, g, S, E, F.wave);
        if ((int)blockIdx.x >= 32)
            conv_moe_weights(F, 0, MOE_CONV_TAIL0 + ((int)blockIdx.x - 32) * NWAVES + F.wave, (F.G - 32) * NWAVES, MOE_CONV_ITEMS);
    }
    PH_END
    PH_BEGIN(5) { norm2_router(F, 0, MT); }
    PH_END
    PH_BEGIN(6) { moe_gemm1(F, 0); }
    PH_END
    PH_BEGIN(7) { moe_gemm2(F, 0); }
    PH_END
    PH_BEGIN(8) { moe_combine<0>(F, 0, MT); conv_moe_weights(F, 1, MOE_CONV_SIDE1 + F.vcu * NWAVES + F.wave, F.G * NWAVES, MOE_CONV_TAIL1); }
    PH_END
    PH_BEGIN(9) {
        const pg8::Gemm g{16, 2 * D, 2 * D};
        if ((int)blockIdx.x < GEMM_G) {
        { DenseSched S{128, 4, GEMM_G, (int)blockIdx.x, (const char*)(F.ws + WS_A), (const char*)(F.ws + WS_WIN), (size_t)256 * D * 2, (size_t)256 * D * 2};
          EpiBf16<1> E{(bf16*)(F.ws + WS_G), D, F.in[I_LBIN], 0, 1.f};
          pg8::gemm_phase(F.lds, g, S, E, F.wave); }
        { DenseSched S{136, 4, GEMM_G, GEMM_G - 1 - (int)blockIdx.x, (const char*)(F.ws + WS_A), (const char*)(F.ws + WS_WIN) + (size_t)D * D * 2, (size_t)256 * D * 2, (size_t)256 * D * 2};
          EpiBf16<0> E{(bf16*)(F.ws + WS_UPRE), D, F.in[I_LBIN] + D, 0, 1.f};
          pg8::gemm_phase(F.lds, g, S, E, F.wave); }
          if ((int)blockIdx.x >= 32 && (int)blockIdx.x < 176)
              conv_moe_weights(F, 1, MOE_CONV_TAIL1 + ((int)blockIdx.x - 32) * NWAVES + F.wave, 144 * NWAVES, MOE_CONV_ITEMS);
        } else conv_moe_weights(F, 1, ((int)blockIdx.x - GEMM_G) * NWAVES + F.wave, (F.G - GEMM_G) * NWAVES, MOE_CONV_SIDE1);
    }
    PH_END
    PH_BEGIN(10) { conv_phase(F); }
    PH_END
    PH_BEGIN(11) { scan_sweep<0>(F); asm volatile("s_waitcnt vmcnt(0)" ::: "memory"); __syncthreads(); scan_sweep<1>(F); }
    PH_END
    PH_BEGIN(12) {
        const pg8::Gemm g{16, 2 * D, 2 * D};
        DenseSched S{128, 4, F.G, (int)blockIdx.x, (const char*)(F.ws + WS_GH), (const char*)(F.ws + WS_WLO), (size_t)256 * D * 2, (size_t)256 * D * 2};
        EpiResid<true> E{nullptr, nullptr, (bf16*)(F.ws + WS_XL), F.in[I_LBO], modp(F, 1, 0, 2)};
        pg8::gemm_phase(F.lds, g, S, E, F.wave);
    }
    PH_END
    PH_BEGIN(13) { norm2_router(F, 1, NL); }
    PH_END
    PH_BEGIN(14) { moe_gemm1(F, 1); }
    PH_END
    PH_BEGIN(15) { moe_gemm2(F, 1); }
    PH_END
    PH_BEGIN(16) { moe_combine<1>(F, 1, NL); }
    PH_END
#undef PH_BEGIN
#undef PH_END
}

__global__ void diag_fill(float* out, float v, int n) { for (int i = blockIdx.x * blockDim.x + threadIdx.x; i < n; i += gridDim.x * blockDim.x) out[i] = v; }
extern "C" void kernel_launch(void* const* d_in, const int* in_sizes, int n_in, void* d_out, int out_size, void* d_ws, size_t ws_size, hipStream_t stream) {
    static int grid = 0; static float diag = 0.f;
    if (grid == 0) {
        if (n_in != N_IN || out_size != NL * D || ws_size < WS_END) { fprintf(stderr, "kernel_launch: unexpected shapes: n_in %d out %d ws %zu (need %zu)\n", n_in, out_size, ws_size, (size_t)WS_END); grid = -1; diag = 2.f; }
        else {
        int dev = 0, cus = 0, per_cu = 0;
        if (hipGetDevice(&dev) != hipSuccess || hipDeviceGetAttribute(&cus, hipDeviceAttributeMultiprocessorCount, dev) != hipSuccess) { grid = -1; diag = 3.f; }
        else if (hipFuncSetAttribute((const void*)fwd_kernel, hipFuncAttributeMaxDynamicSharedMemorySize, LDS_BYTES) != hipSuccess) { fprintf(stderr, "kernel_launch: hipFuncSetAttribute failed\n"); grid = -1; diag = 4.f; }
        else if (hipOccupancyMaxActiveBlocksPerMultiprocessor(&per_cu, (const void*)fwd_kernel, NTHREADS, LDS_BYTES) != hipSuccess || per_cu < 1) { fprintf(stderr, "kernel_launch: occupancy query says %d blocks/CU\n", per_cu); (void)hipGetLastError(); grid = -1; diag = 5.f; }
        else if (cus != 256) { fprintf(stderr, "kernel_launch: built for 256 CUs, device has %d\n", cus); grid = -1; diag = 7.f; }
        else grid = cus;
        }
    }
    if (grid < 0) { diag_fill<<<256, 256, 0, stream>>>((float*)d_out, diag, out_size); return; }
    if (hipMemsetAsync((char*)d_ws + WS_CTL, 0, CTL_ZERO_BYTES, stream) != hipSuccess) { fprintf(stderr, "kernel_launch: memset failed\n"); return; }
    Args a{};
    for (int i = 0; i < N_IN; ++i) a.in[i] = (const float*)d_in[i];
    a.out = (float*)d_out; a.ws = (unsigned char*)d_ws; a.ph_lo = 0; a.ph_hi = 1000;
    void* kargs[] = {&a};
    hipError_t e = hipLaunchCooperativeKernel((const void*)fwd_kernel, dim3(grid), dim3(NTHREADS), kargs, LDS_BYTES, stream);
    if (e != hipSuccess) { fprintf(stderr, "kernel_launch: cooperative launch failed: %s (grid %d)\n", hipGetErrorString(e), grid); (void)hipGetLastError(); diag_fill<<<256, 256, 0, stream>>>((float*)d_out, 6.f, out_size); }
}
```

```cpp
#include <hip/hip_runtime.h>
#include <cstdio>
#include <cstdint>
#include <cstddef>

#define GAS __attribute__((address_space(1)))
#define LAS __attribute__((address_space(3)))
typedef unsigned short bf16;
typedef unsigned v4u __attribute__((ext_vector_type(4)));
typedef unsigned v2u __attribute__((ext_vector_type(2)));
typedef float f32x4 __attribute__((ext_vector_type(4)));
typedef float f32x2 __attribute__((ext_vector_type(2)));
typedef short bf16x8 __attribute__((ext_vector_type(8)));

constexpr int D = 1024, BATCH = 8, SEQ = 4096, CTXL = 256, GRIDW = 64;
constexpr int NL = BATCH * SEQ;
constexpr int NC = BATCH * CTXL;
constexpr int MT = NL + NC;
constexpr int NMOD = 6, NHEAD = 16, HD = 64;
constexpr int NEXP = 32, EFF = 512;
constexpr float EPS = 1e-6f;
constexpr int NWAVES = 8, NTHREADS = 512;

enum { I_X = 0, I_C, I_CTX, I_CCTX, I_ADAW, I_ADAB, I_NORMG, I_WQKV, I_BQKV, I_RPB, I_NAWO, I_NABO, I_LWIN, I_LBIN, I_CONVW, I_CONVB, I_WGATE, I_BGATE,
       I_LAMBDA, I_LWO, I_LBO, I_MWG, I_MBG, I_MWE, I_MBE, I_MW1, I_MW3, I_MW2, I_FINALG, N_IN };

constexpr size_t MiB = 1u << 20;
constexpr size_t WS_CTL = 0, CTL_ZERO_BYTES = 1 * MiB;
constexpr size_t WS_MOD = 1 * MiB;
constexpr size_t WS_WQK = 2 * MiB;
constexpr size_t WS_WV = 6 * MiB;
constexpr size_t WS_WO = 8 * MiB;
constexpr size_t WS_WIN = 10 * MiB;
constexpr size_t WS_WG = 14 * MiB;
constexpr size_t WS_WLO = 16 * MiB;
constexpr size_t WS_SRCROW = 18 * MiB;
constexpr size_t WS_W13 = 32 * MiB;
constexpr size_t WS_W2 = 112 * MiB;
constexpr size_t WS_XL = 428 * MiB;
constexpr size_t WS_ROUTE = 136 * MiB;
constexpr size_t WS_A = 140 * MiB;
constexpr size_t WS_B = 208 * MiB;
constexpr size_t WS_C = 344 * MiB;
constexpr size_t WS_HL2 = 208 * MiB;
constexpr size_t WS_XS = 276 * MiB;
constexpr size_t WS_HDN = 64 * MiB;
constexpr size_t WS_END = 504 * MiB;
constexpr int CW_BAR = 4096;
constexpr int CW_ECNT = 16384;

constexpr int RING_BYTES = 131072;
constexpr int RTAB_BYTES = 36 * 1024 * 4;
constexpr int LDSCTL_OFF = RTAB_BYTES;
constexpr int LDS_BYTES = 163840;

#define RLX_AGENT __ATOMIC_RELAXED, __HIP_MEMORY_SCOPE_AGENT
#define LDS_WAIT() asm volatile("s_waitcnt lgkmcnt(0)" ::: "memory")
#define VM_WAIT() asm volatile("s_waitcnt vmcnt(0)" ::: "memory")
__device__ __forceinline__ unsigned f2bf(float f) { unsigned u = __builtin_bit_cast(unsigned, f); return (u + 0x7fffu + ((u >> 16) & 1u)) >> 16; }
__device__ __forceinline__ unsigned pk2(float lo, float hi) { return f2bf(lo) | (f2bf(hi) << 16); }
__device__ __forceinline__ float bf2f(unsigned short h) { return __builtin_bit_cast(float, (unsigned)h << 16); }
__device__ __forceinline__ float bflo(unsigned w) { return __builtin_bit_cast(float, w << 16); }
__device__ __forceinline__ float bfhi(unsigned w) { return __builtin_bit_cast(float, w & 0xffff0000u); }
__device__ __forceinline__ float wave_sum(float v) {
#define WS_DPP(x, ctrl, rmask) __builtin_bit_cast(float, __builtin_amdgcn_update_dpp(0, __builtin_bit_cast(int, x), ctrl, rmask, 0xF, false))
    v += WS_DPP(v, 0xB1, 0xF); v += WS_DPP(v, 0x4E, 0xF); v += WS_DPP(v, 0x124, 0xF); v += WS_DPP(v, 0x128, 0xF);
    v += WS_DPP(v, 0x142, 0xA); v += WS_DPP(v, 0x143, 0xC);
#undef WS_DPP
    return __builtin_bit_cast(float, __builtin_amdgcn_readlane(__builtin_bit_cast(int, v), 63));
}

#define XB_TMO      128
#define XB_XCNT(j)  (256  + 64 * (j))
#define XB_XSUB(j)  (1280 + 64 * (j))
#define XB_XGEN(j)  (2304 + 64 * (j))
#define XB_TOP      3328
#define XB_TOPGEN   3392
#define XCD_BAR_WORDS 3456
#define XB_SPIN_CAP (1u << 20)
__device__ __forceinline__ unsigned xb_ld(unsigned* p)              { return __hip_atomic_load(p, __ATOMIC_RELAXED, __HIP_MEMORY_SCOPE_AGENT); }
__device__ __forceinline__ unsigned xb_add(unsigned* p, unsigned v) { return __hip_atomic_fetch_add(p, v, __ATOMIC_RELAXED, __HIP_MEMORY_SCOPE_AGENT); }
__device__ __forceinline__ unsigned xb_xcc_id() { return (unsigned)__builtin_amdgcn_s_getreg((3 << 11) | 20) & 0xFu; }
#define XB_SPIN(cond, bar) do { unsigned _sp = 0; while (cond) { __builtin_amdgcn_s_sleep(1); \
    if ((++_sp & 255u) == 0u) { if (xb_ld(&(bar)[XB_TMO])) break; if (_sp > XB_SPIN_CAP) { atomicAdd(&(bar)[XB_TMO], 1u); break; } } } } while (0)
struct XcdBarrier { unsigned* bar; unsigned x; volatile LAS unsigned* st; };
__device__ __forceinline__ XcdBarrier xcd_barrier_post(unsigned* bar, volatile LAS unsigned* st) {
    XcdBarrier b; b.bar = bar; b.x = xb_xcc_id(); b.st = st;
    if (threadIdx.x == 0) (void)xb_add(&bar[XB_XCNT(b.x)], 1u);
    return b;
}
__device__ __forceinline__ void xcd_barrier_complete(unsigned* bar, unsigned x, unsigned& nloc, unsigned& nx) {
    const unsigned G = gridDim.x * gridDim.y * gridDim.z;
    unsigned sum, cnt, mine, sp = 0u;
    for (;;) {
        sum = 0u; cnt = 0u; mine = 0u;
#pragma unroll
        for (unsigned j = 0; j < 16; ++j) { const unsigned c = xb_ld(&bar[XB_XCNT(j)]); sum += c; cnt += (c > 0u) ? 1u : 0u; mine = (j == x) ? c : mine; }
        if (sum == G) break;
        __builtin_amdgcn_s_sleep(1);
        if ((++sp & 255u) == 0u) { if (xb_ld(&bar[XB_TMO])) break; if (sp > XB_SPIN_CAP) { atomicAdd(&bar[XB_TMO], 1u); break; } }
    }
    nloc = mine > 0u ? mine : 1u; nx = cnt > 0u ? cnt : 1u;
}
__device__ __forceinline__ void xcd_barrier(const XcdBarrier& b) {
    asm volatile("s_waitcnt vmcnt(0)" ::: "memory");
    __syncthreads();
    if (threadIdx.x == 0) {
        unsigned* bar = b.bar;
        __builtin_amdgcn_s_waitcnt(0);
        unsigned nloc = b.st[0], nx = b.st[1];
        if (nloc == 0u) { xcd_barrier_complete(bar, b.x, nloc, nx); b.st[0] = nloc; b.st[1] = nx; }
        const unsigned old = xb_add(&bar[XB_XSUB(b.x)], 1u);
        const unsigned gen = old / nloc;
        if (old + 1u == (gen + 1u) * nloc) {
            __builtin_amdgcn_fence(__ATOMIC_RELEASE, "agent");
            asm volatile("s_waitcnt vmcnt(0)" ::: "memory");
            const unsigned og = xb_add(&bar[XB_TOP], 1u);
            const unsigned tg = og / nx;
            if (og + 1u == (tg + 1u) * nx) xb_add(&bar[XB_TOPGEN], 1u);
            else XB_SPIN(xb_ld(&bar[XB_TOPGEN]) == tg, bar);
            __builtin_amdgcn_fence(__ATOMIC_ACQUIRE, "agent");
            xb_add(&bar[XB_XGEN(b.x)], 1u);
            asm volatile("s_waitcnt vmcnt(0)" ::: "memory");
        } else {
            XB_SPIN(xb_ld(&bar[XB_XGEN(b.x)]) == gen, bar);
            __builtin_amdgcn_fence(__ATOMIC_ACQUIRE, "agent");
            asm volatile("s_waitcnt vmcnt(0)" ::: "memory");
        }
    }
    __syncthreads();
}

struct Args { const float* in[N_IN]; float* out; unsigned char* ws; int ph_lo, ph_hi; };
struct Frame {
    LAS unsigned char* lds;
    int tid, lane, wave, vcu, G;
    const float* const __attribute__((address_space(4)))* in;
    float* out; unsigned char* ws;
};
__device__ __forceinline__ const float* row_x_in(const Frame& F, int r) {
    return r < NL ? F.in[I_X] + (size_t)r * D : F.in[I_CTX] + (size_t)(r - NL) * D;
}
__device__ __forceinline__ int row_mod(int r) { return r < NL ? (r >> 12) : 8; }
__device__ __forceinline__ const float* modp(const Frame& F, int layer, int mrow, int which) {
    return (const float*)(F.ws + WS_MOD) + ((size_t)(layer * 9 + mrow) * NMOD + which) * D;
}

__device__ __forceinline__ float silu_f(float v) { return v * __builtin_amdgcn_rcpf(1.f + __expf(-v)); }
__device__ __forceinline__ void p0_mod(Frame& F) {
    LAS float* S = (LAS float*)F.lds;
    LAS float* P = (LAS float*)(F.lds + 9 * 1024 * 4);
    for (int it = blockIdx.x; it < 192; it += F.G) {
        const int layer = it / 96, n0 = (it % 96) * 64;
        { float sv[18];
#pragma unroll
          for (int q = 0; q < 18; ++q) { const int e = F.tid + NTHREADS * q; const int m = e >> 10, k = e & 1023; sv[q] = m < 8 ? F.in[I_C][m * D + k] : F.in[I_CCTX][k]; }
#pragma unroll
          for (int q = 0; q < 18; ++q) S[F.tid + NTHREADS * q] = silu_f(sv[q]); }
        __syncthreads();
        const float* W = F.in[I_ADAW] + (size_t)layer * D * (NMOD * D) + n0 + F.lane;
        float acc[9];
#pragma unroll
        for (int m = 0; m < 9; ++m) acc[m] = 0.f;
        const int kb = F.wave * 128;
#pragma unroll 16
        for (int k = 0; k < 128; ++k) { const float w = W[(size_t)(kb + k) * (NMOD * D)];
#pragma unroll
            for (int m = 0; m < 9; ++m) acc[m] += S[m * 1024 + kb + k] * w; }
#pragma unroll
        for (int m = 0; m < 9; ++m) P[(F.wave * 9 + m) * 64 + F.lane] = acc[m];
        __syncthreads();
        for (int e = F.tid; e < 9 * 64; e += NTHREADS) { const int m = e >> 6, n = e & 63; float s = F.in[I_ADAB][layer * (NMOD * D) + n0 + n];
#pragma unroll
            for (int w = 0; w < 8; ++w) s += P[(w * 9 + m) * 64 + n];
            ((float*)(F.ws + WS_MOD))[(size_t)(layer * 9 + m) * (NMOD * D) + n0 + n] = s; }
        __syncthreads();
    }
}
__device__ __forceinline__ void transpose_item(const float* W, int ldw, int k0, int n0, bf16* dst, int dld, int drow0, LAS float* scr, int lane) {
    const int lq = lane >> 4, ln = 4 * (lane & 15);
    f32x4 v[16];
#pragma unroll
    for (int i = 0; i < 16; ++i) v[i] = *(const f32x4*)(W + (size_t)(k0 + lq + 4 * i) * ldw + n0 + ln);
#pragma unroll
    for (int i = 0; i < 16; ++i) { LAS float* q = scr + (lq + 4 * i) * 65 + ln; q[0] = v[i].x; q[1] = v[i].y; q[2] = v[i].z; q[3] = v[i].w; }
    LDS_WAIT(); asm volatile("" ::: "memory");
    const int c = lane & 7;
#pragma unroll
    for (int j = 0; j < 8; ++j) { const int n = (lane >> 3) + 8 * j; const LAS float* q = scr + (8 * c) * 65 + n;
        v4u o; o.x = pk2(q[0 * 65], q[1 * 65]); o.y = pk2(q[2 * 65], q[3 * 65]); o.z = pk2(q[4 * 65], q[5 * 65]); o.w = pk2(q[6 * 65], q[7 * 65]);
        *(v4u*)(dst + (size_t)(drow0 + n) * dld + k0 + 8 * c) = o; }
    LDS_WAIT(); asm volatile("" ::: "memory");
}
constexpr int TR_SCR = 64 * 65 * 4;
__device__ __forceinline__ unsigned pk4_fp8(float a, float b, float c, float d) { int w = __builtin_amdgcn_cvt_pk_fp8_f32(a, b, 0, false); w = __builtin_amdgcn_cvt_pk_fp8_f32(c, d, w, true); return (unsigned)w; }
__device__ __forceinline__ void transpose_item_f8(const float* W, int ldw, int k0, int n0, unsigned char* dst, int dld, int drow0, LAS float* scr, int lane, float wsc = 64.f) {
    const int lq = lane >> 4, ln = 4 * (lane & 15);
    f32x4 v[16];
#pragma unroll
    for (int i = 0; i < 16; ++i) v[i] = *(const f32x4*)(W + (size_t)(k0 + lq + 4 * i) * ldw + n0 + ln);
#pragma unroll
    for (int i = 0; i < 16; ++i) { LAS float* q = scr + (lq + 4 * i) * 65 + ln; q[0] = v[i].x; q[1] = v[i].y; q[2] = v[i].z; q[3] = v[i].w; }
    LDS_WAIT(); asm volatile("" ::: "memory");
    const int c = lane & 3;
#pragma unroll
    for (int j = 0; j < 4; ++j) { const int n = (lane >> 2) + 16 * j; const LAS float* q = scr + (16 * c) * 65 + n;
        v4u o;
        o.x = pk4_fp8(wsc * q[0 * 65], wsc * q[1 * 65], wsc * q[2 * 65], wsc * q[3 * 65]); o.y = pk4_fp8(wsc * q[4 * 65], wsc * q[5 * 65], wsc * q[6 * 65], wsc * q[7 * 65]);
        o.z = pk4_fp8(wsc * q[8 * 65], wsc * q[9 * 65], wsc * q[10 * 65], wsc * q[11 * 65]); o.w = pk4_fp8(wsc * q[12 * 65], wsc * q[13 * 65], wsc * q[14 * 65], wsc * q[15 * 65]);
        *(v4u*)(dst + (size_t)(drow0 + n) * dld + k0 + 16 * c) = o; }
    LDS_WAIT(); asm volatile("" ::: "memory");
}
__device__ __forceinline__ void p0_small_weights(Frame& F) {
    LAS float* scr = (LAS float*)(F.lds + F.wave * TR_SCR);
    const int gw = F.vcu * NWAVES + F.wave, NGW = F.G * NWAVES;
    constexpr int I_QK = 16 * 32, I_V = 16 * 16, I_O = 16 * 16, I_IN = 16 * 32, I_G = 16 * 16, I_LO = 16 * 16;
    constexpr int NIT = I_QK + I_V + I_O + I_IN + I_G + I_LO;
    for (int it = gw; it < NIT; it += NGW) {
        int r = it;
        if (r < I_QK) { transpose_item(F.in[I_WQKV], 3 * D, (r / 32) * 64, (r % 32) * 64, (bf16*)(F.ws + WS_WQK), D, (r % 32) * 64, scr, F.lane); continue; } r -= I_QK;
        if (r < I_V) { transpose_item(F.in[I_WQKV], 3 * D, (r / 16) * 64, 2 * D + (r % 16) * 64, (bf16*)(F.ws + WS_WV), D, (r % 16) * 64, scr, F.lane); continue; } r -= I_V;
        if (r < I_O) { transpose_item_f8(F.in[I_NAWO], D, (r / 16) * 64, (r % 16) * 64, F.ws + WS_WO, D, (r % 16) * 64, scr, F.lane); continue; } r -= I_O;
        if (r < I_IN) { transpose_item(F.in[I_LWIN], 2 * D, (r / 32) * 64, (r % 32) * 64, (bf16*)(F.ws + WS_WIN), D, (r % 32) * 64, scr, F.lane); continue; } r -= I_IN;
        if (r < I_G) { const int mat = r / 16, q = r % 16; transpose_item_f8(F.in[I_WGATE] + (size_t)mat * 65536, 256, (q / 4) * 64, (q % 4) * 64, F.ws + WS_WG + (size_t)mat * 65536, 256, (q % 4) * 64, scr, F.lane, 16.f); continue; } r -= I_G;
        transpose_item(F.in[I_LWO], D, (r / 16) * 64, (r % 16) * 64, (bf16*)(F.ws + WS_WLO), D, (r % 16) * 64, scr, F.lane);
    }
}
constexpr int MOE_CONV_ITEMS = 3 * NEXP * 128;
constexpr int MOE_CONV_SIDE0 = 4096, MOE_CONV_SIDE1 = 3072, GEMM_G = 240;
constexpr int MOE_CONV_TAIL0 = 12288 - 224 * 16, MOE_CONV_TAIL1 = 12288 - 144 * 16;
struct ConvItem { const float* W; int ldw, k0, n0; unsigned char* dst; int dld, drow0; };
__device__ __forceinline__ ConvItem moe_conv_item(Frame& F, int layer, int it) {
    constexpr int I_1 = NEXP * 16 * 8;
    ConvItem c; int r = it;
    if (r < 2 * I_1) { const int which = r / I_1; r %= I_1; const int e = r / 128, q = r % 128, kb = q / 8, nb = q % 8, n0 = nb * 64;
        c.W = F.in[which ? I_MW3 : I_MW1] + ((size_t)layer * NEXP + e) * (size_t)(D * EFF); c.ldw = EFF; c.k0 = kb * 64; c.n0 = n0;
        c.dst = F.ws + WS_W13 + (size_t)e * (1024 * 1024); c.dld = D; c.drow0 = (n0 / 128) * 256 + which * 128 + (n0 % 128); }
    else { r -= 2 * I_1; const int e = r / 128, q = r % 128, kb = q / 16, nb = q % 16;
        c.W = F.in[I_MW2] + ((size_t)layer * NEXP + e) * (size_t)(EFF * D); c.ldw = D; c.k0 = kb * 64; c.n0 = nb * 64;
        c.dst = F.ws + WS_W2 + (size_t)e * (1024 * 512); c.dld = EFF; c.drow0 = nb * 64; }
    return c;
}
__device__ __forceinline__ void conv_load(const ConvItem& c, int lane, f32x4 (&v)[16]) {
    const int lq = lane >> 4, ln = 4 * (lane & 15);
#pragma unroll
    for (int i = 0; i < 16; ++i) v[i] = *(const f32x4*)(c.W + (size_t)(c.k0 + lq + 4 * i) * c.ldw + c.n0 + ln);
}
__device__ __forceinline__ void conv_moe_weights(Frame& F, int layer, int first, int stride, int end) {
    LAS float* scr = (LAS float*)(F.lds + F.wave * TR_SCR);
    const int lane = F.lane, lq = lane >> 4, ln = 4 * (lane & 15), c4 = lane & 3;
    if (first >= end) return;
    ConvItem cur = moe_conv_item(F, layer, first); f32x4 v[16]; conv_load(cur, lane, v);
    for (int it = first; it < end; it += stride) {
#pragma unroll
        for (int i = 0; i < 16; ++i) { LAS float* q = scr + (lq + 4 * i) * 65 + ln; q[0] = v[i].x; q[1] = v[i].y; q[2] = v[i].z; q[3] = v[i].w; }
        const ConvItem me = cur;
        if (it + stride < end) { cur = moe_conv_item(F, layer, it + stride); conv_load(cur, lane, v); }
        LDS_WAIT(); asm volatile("" ::: "memory");
#pragma unroll
        for (int j = 0; j < 4; ++j) { const int n = (lane >> 2) + 16 * j; const LAS float* q = scr + (16 * c4) * 65 + n;
            v4u o;
            o.x = pk4_fp8(64.f * q[0 * 65], 64.f * q[1 * 65], 64.f * q[2 * 65], 64.f * q[3 * 65]); o.y = pk4_fp8(64.f * q[4 * 65], 64.f * q[5 * 65], 64.f * q[6 * 65], 64.f * q[7 * 65]);
            o.z = pk4_fp8(64.f * q[8 * 65], 64.f * q[9 * 65], 64.f * q[10 * 65], 64.f * q[11 * 65]); o.w = pk4_fp8(64.f * q[12 * 65], 64.f * q[13 * 65], 64.f * q[14 * 65], 64.f * q[15 * 65]);
            *(v4u*)(me.dst + (size_t)(me.drow0 + n) * me.dld + me.k0 + 16 * c4) = o; }
        LDS_WAIT(); asm volatile("" ::: "memory");
    }
}

__device__ __forceinline__ void load_row(const float* p, int lane, f32x4 (&v)[4]) {
#pragma unroll
    for (int j = 0; j < 4; ++j) v[j] = ((const f32x4*)p)[64 * j + lane];
}
__device__ __forceinline__ void load_row_bf16(const bf16* p, int lane, f32x4 (&v)[4]) {
#pragma unroll
    for (int j = 0; j < 4; ++j) { const v2u w = ((const v2u*)p)[64 * j + lane]; v[j] = (f32x4){bflo(w.x), bfhi(w.x), bflo(w.y), bfhi(w.y)}; }
}
__device__ __forceinline__ float row_rstd(const f32x4 (&v)[4]) {
    float s = 0.f;
#pragma unroll
    for (int j = 0; j < 4; ++j) s += (v[j].x * v[j].x + v[j].y * v[j].y) + (v[j].z * v[j].z + v[j].w * v[j].w);
    return __builtin_amdgcn_rsqf(wave_sum(s) * (1.f / D) + EPS);
}
__device__ __forceinline__ void norm_mod(f32x4 (&v)[4], int lane, const float* g, const float* sh, const float* sc) {
    const float rstd = row_rstd(v);
#pragma unroll
    for (int j = 0; j < 4; ++j) { const f32x4 gg = ((const f32x4*)g)[64 * j + lane], s1 = ((const f32x4*)sc)[64 * j + lane], s0 = ((const f32x4*)sh)[64 * j + lane];
        v[j] = (v[j] * rstd) * gg * (s1 + 1.0f) + s0; }
}
__device__ __forceinline__ void store_row_bf16(bf16* o, int lane, const f32x4 (&v)[4]) {
#pragma unroll
    for (int j = 0; j < 4; ++j) { v2u w; w.x = pk2(v[j].x, v[j].y); w.y = pk2(v[j].z, v[j].w); ((v2u*)o)[64 * j + lane] = w; }
}
__device__ __forceinline__ void store_row_f32(float* o, int lane, const f32x4 (&v)[4]) {
#pragma unroll
    for (int j = 0; j < 4; ++j) ((f32x4*)o)[64 * j + lane] = v[j];
}

__device__ __forceinline__ void p1_norm0(Frame& F) {
    const int gw = F.vcu * NWAVES + F.wave, NGW = F.G * NWAVES;
    bf16* HL = (bf16*)(F.ws + WS_A);
    for (int r0 = gw * 4; r0 < MT; r0 += NGW * 4) {
        f32x4 v[4][4];
#pragma unroll
        for (int q = 0; q < 4; ++q) load_row(row_x_in(F, r0 + q), F.lane, v[q]);
#pragma unroll
        for (int q = 0; q < 4; ++q) { const int mr = row_mod(r0 + q);
            norm_mod(v[q], F.lane, F.in[I_NORMG] + 0 * D, modp(F, 0, mr, 0), modp(F, 0, mr, 1));
            store_row_bf16(HL + (size_t)(r0 + q) * D, F.lane, v[q]); asm volatile("" ::: "memory"); }
    }
}

namespace pg8 {
constexpr int FP8_SCALE = 0x7C7C7C7C;
constexpr int BM = 256, BK = 64, HALF = 128, HTB = HALF * BK * 2, STAGE_BYTES = 8 * HTB, NXCD = 8, WGM = 8;
__host__ __device__ __forceinline__ int lds_byte(int r, int c) { const int st = (r >> 4) * 2 + (c >> 5), rr = r & 15, cc = c & 31, ob = rr * 64 + cc * 2; return st * 1024 + (ob ^ (((ob >> 9) & 1) << 5)); }
__host__ __device__ __forceinline__ void stage_rc(int b, int& R, int& C) { const int st = b / 1024, sb = b % 1024, swz = sb ^ (((sb >> 9) & 1) << 5); R = (st >> 1) * 16 + swz / 64; C = (st & 1) * 32 + (swz % 64) / 2; }
__host__ __device__ __forceinline__ int perm32(int rho) { const int n = rho >> 4, i = rho & 15; return 8 * (i >> 2) + 4 * n + (i & 3); }
constexpr int GROW_OFF = 131072;
struct Unit { int pm, pn; const char* a; const char* b; int aux; };
struct Gemm { int nt, lda, ldb; };
__host__ __device__ __forceinline__ bool order_next(int nM, int nN, int G, int c, int i, int& pm, int& pn) {
    const int nwg = nM * nN; const long L = (long)i * G + c; if (L >= nwg) return false;
    int wgid = (int)L; { const int q = nwg / NXCD, r = nwg % NXCD, xcd = wgid % NXCD, off = wgid / NXCD; wgid = (xcd < r ? xcd * (q + 1) : r * (q + 1) + (xcd - r) * q) + off; }
    const int nig = WGM * nN, gid = wgid / nig, fm = gid * WGM, gsz = (nM - fm) < WGM ? (nM - fm) : WGM;
    pm = fm + ((wgid % nig) % gsz); pn = (wgid % nig) / gsz; return true;
}
typedef int v8i __attribute__((ext_vector_type(8)));
typedef int v4i __attribute__((ext_vector_type(4)));
__host__ __device__ __forceinline__ int f8swz(int r) { return ((r >> 1) & 1) | (((r >> 3) & 1) << 2); }
__device__ __forceinline__ unsigned cvt_pk_bf16(float lo, float hi) { unsigned r; asm volatile("v_cvt_pk_bf16_f32 %0, %1, %2" : "=v"(r) : "v"(lo), "v"(hi)); return r; }

template <bool F8> struct Frag;
template <> struct Frag<false> { bf16x8 k[2]; };
template <> struct Frag<true> { v8i v; };
template <class Epi, class Sched, bool FP8 = false, bool ALIGN_EPI = true, bool SP2 = true>
__device__ __forceinline__ void gemm_phase(LAS unsigned char* lds, const Gemm g, const Sched& S, const Epi& E, int wave_id) {
    const int wid = wave_id, lane = (int)__builtin_amdgcn_mbcnt_hi(~0u, __builtin_amdgcn_mbcnt_lo(~0u, 0u)), tid = wid * 64 + lane, wr = wid >> 2, wc = wid & 3, fr = lane & 15, fq = lane >> 4;
    const int nt = g.nt;
    unsigned voffB[2]; int RA[2], CA_[2];
#pragma unroll
    for (int i = 0; i < 2; ++i) { int R, C; const int b_ = tid * 16 + i * 8192;
        if (FP8) { R = b_ >> 7; C = (((b_ >> 4) & 7) ^ f8swz(R)) * 16; } else { stage_rc(b_, R, C); C *= 2; }
        const int Rb = Epi::PERM ? ((R & ~31) + perm32(R & 31)) : R;
        RA[i] = R; CA_[i] = C; voffB[i] = (unsigned)(Rb * g.ldb + C); }
    const size_t kstep = (size_t)(BK * 2);
    const size_t hstepB = (size_t)HALF * g.ldb;
    unsigned vA[2][2], nvA[2][2];
    const unsigned ldsw = (unsigned)wid * 1024u;
    const int aoff = FP8 ? (wr * 64 + fr) * 128 + (((2 * fq) ^ f8swz(fr)) << 4) : lds_byte(wr * 64 + fr, fq * 8);
    const int boff = FP8 ? (wc * 32 + fr) * 128 + (((2 * fq) ^ f8swz(fr)) << 4) : lds_byte(wc * 32 + fr, fq * 8);
#define PG8_SA(b, h) (((b) * 2 + (h)) * HTB)
#define PG8_SB(b, h) ((4 + (b) * 2 + (h)) * HTB)
#define PG8_STAGE(bufoff, gbase, voff) do { _Pragma("unroll") for (int _i = 0; _i < 2; ++_i) \
        __builtin_amdgcn_global_load_lds((const unsigned*)((const char*)(gbase) + (voff)[_i]), (LAS unsigned*)(lds + (bufoff) + ldsw + _i * 8192), 16, 0, 0); } while (0)
#define PG8_LD1(dstf, base_, off_, i_) do { if constexpr (FP8) { dstf.v.lo = *(const LAS v4i*)(lds + (base_) + (off_) + (i_) * 2048); dstf.v.hi = *(const LAS v4i*)(lds + (base_) + ((off_) ^ 16) + (i_) * 2048); } \
        else { dstf.k[0] = *(const LAS bf16x8*)(lds + (base_) + (off_) + (i_) * 2048); dstf.k[1] = *(const LAS bf16x8*)(lds + (base_) + (off_) + (i_) * 2048 + 1024); } } while (0)
#define PG8_LDA(dst, b, h) do { _Pragma("unroll") for (int m = 0; m < 4; ++m) PG8_LD1(dst[m], PG8_SA(b, h), aoff, m); } while (0)
#define PG8_LDB(dst, b, h) do { _Pragma("unroll") for (int n = 0; n < 2; ++n) PG8_LD1(dst[n], PG8_SB(b, h), boff, n); } while (0)
#define PG8_MMA(ai, bj, At, Bt) do { if constexpr (FP8) __builtin_amdgcn_sched_barrier(0); __builtin_amdgcn_s_setprio(1); _Pragma("unroll") for (int m = 0; m < 4; ++m) _Pragma("unroll") for (int n = 0; n < 2; ++n) { \
        if constexpr (FP8) asm volatile("v_mfma_scale_f32_16x16x128_f8f6f4 %0, %1, %2, %0, %3, %4 op_sel_hi:[0,0,0]" : "+v"(acc[ai][bj][m][n]) : "v"(Bt[n].v), "v"(At[m].v), "v"(f8s), "v"(f8s)); \
        else { _Pragma("unroll") for (int k = 0; k < 2; ++k) acc[ai][bj][m][n] = __builtin_amdgcn_mfma_f32_16x16x32_bf16(Bt[n].k[k], At[m].k[k], acc[ai][bj][m][n], 0, 0, 0); } } \
        __builtin_amdgcn_s_setprio(0); if constexpr (FP8) __builtin_amdgcn_sched_barrier(0); } while (0)
#define PG8_NVA(h) ((Sched::GATHER && last) ? nvA[h] : vA[h])
#define PG8_WAIT_V(n) asm volatile("s_waitcnt vmcnt(" #n ")" ::: "memory")
#define PG8_WAIT_L(n) asm volatile("s_waitcnt lgkmcnt(" #n ")" ::: "memory")
#define PG8_BAR __builtin_amdgcn_s_barrier()
#define PG8_SCHED __builtin_amdgcn_sched_barrier(0)
    Unit cur, nxt; int ui = 0;
    if (!S.next(0, cur)) return;
    f32x4 acc[2][2][4][2];
#pragma unroll
    for (int a = 0; a < 2; ++a)
#pragma unroll
        for (int b = 0; b < 2; ++b)
#pragma unroll
            for (int m = 0; m < 4; ++m)
#pragma unroll
                for (int n = 0; n < 2; ++n) acc[a][b][m][n] = (f32x4){0.f, 0.f, 0.f, 0.f};
    Frag<FP8> At[4], B0[2], B1[2];
    int f8s = FP8_SCALE;
    asm volatile("" : "+v"(f8s));
    const char* cA = cur.a; const char* cB = cur.b;
    S.a_offsets(cur, g, RA, CA_, vA);
    if constexpr (SP2) {
        PG8_STAGE(PG8_SB(0, 0), cB, voffB); PG8_STAGE(PG8_SB(0, 1), cB + hstepB, voffB); PG8_STAGE(PG8_SA(0, 0), cA, vA[0]); PG8_STAGE(PG8_SA(0, 1), cA, vA[1]);
        if (wr == 1) PG8_BAR;
        PG8_WAIT_V(2); PG8_BAR;
        PG8_STAGE(PG8_SB(1, 0), cB + kstep, voffB); PG8_STAGE(PG8_SA(1, 0), cA + kstep, vA[0]); PG8_STAGE(PG8_SB(1, 1), cB + hstepB + kstep, voffB);
        PG8_WAIT_V(6); PG8_BAR;
    } else {
        PG8_STAGE(PG8_SB(0, 0), cB, voffB); PG8_STAGE(PG8_SA(0, 0), cA, vA[0]); PG8_STAGE(PG8_SB(0, 1), cB + hstepB, voffB); PG8_STAGE(PG8_SA(0, 1), cA, vA[1]);
        if (wr == 1) PG8_BAR;
        PG8_WAIT_V(4); PG8_BAR;
        PG8_STAGE(PG8_SB(1, 0), cB + kstep, voffB); PG8_STAGE(PG8_SA(1, 0), cA + kstep, vA[0]); PG8_STAGE(PG8_SB(1, 1), cB + hstepB + kstep, voffB);
        PG8_WAIT_V(6); PG8_BAR;
    }
    for (;;) {
        const bool has_next = S.next(ui + 1, nxt);
        const char* nA = has_next ? nxt.a : cA; const char* nB = has_next ? nxt.b : cB;
        if constexpr (Sched::GATHER) {
#pragma unroll
            for (int h = 0; h < 2; ++h)
#pragma unroll
                for (int i = 0; i < 2; ++i) nvA[h][i] = vA[h][i];
        }
        for (int t = 0; t < nt; t += 2) {
            const bool last = (t == nt - 2);
            if constexpr (Sched::GATHER) {
                if (last && has_next) {
#pragma unroll
                    for (int h = 0; h < 2; ++h)
#pragma unroll
                        for (int i = 0; i < 2; ++i) nvA[h][i] = (unsigned)(*(const LAS int*)(lds + GROW_OFF + (h * 128 + RA[i]) * 4) * g.lda + CA_[i]);
                }
                if (t == 0 && has_next && wr == 0) __builtin_amdgcn_global_load_lds((const unsigned*)S.row_ptr(nxt, tid), (LAS unsigned*)(lds + GROW_OFF + wid * 256), 4, 0, 0);
            }
            const char* a1 = cA + (size_t)(t + 1) * kstep;
            const char* a2 = last ? nA : cA + (size_t)(t + 2) * kstep; const char* b2 = last ? nB : cB + (size_t)(t + 2) * kstep;
            const char* a3 = a2 + kstep; const char* b3 = b2 + kstep;
            if constexpr (SP2) {
            PG8_LDB(B0, 0, 0); PG8_LDB(B1, 0, 1); PG8_SCHED; PG8_LDA(At, 0, 0); PG8_STAGE(PG8_SA(1, 1), a1, vA[1]);
            PG8_WAIT_V(8); PG8_WAIT_L(0); PG8_BAR; PG8_MMA(0, 0, At, B0); PG8_MMA(0, 1, At, B1); PG8_BAR; PG8_SCHED;
            PG8_LDA(At, 0, 1); PG8_STAGE(PG8_SB(0, 0), b2, voffB); PG8_STAGE(PG8_SB(0, 1), b2 + hstepB, voffB); PG8_STAGE(PG8_SA(0, 0), a2, PG8_NVA(0));
            PG8_WAIT_V(8); PG8_WAIT_L(0); PG8_BAR; PG8_MMA(1, 0, At, B0); PG8_MMA(1, 1, At, B1); PG8_BAR; PG8_SCHED;
            PG8_LDB(B0, 1, 0); PG8_LDB(B1, 1, 1); PG8_SCHED; PG8_LDA(At, 1, 0); PG8_STAGE(PG8_SA(0, 1), a2, PG8_NVA(1));
            PG8_WAIT_V(8); PG8_WAIT_L(0); PG8_BAR; PG8_MMA(0, 0, At, B0); PG8_MMA(0, 1, At, B1); PG8_BAR; PG8_SCHED;
            PG8_LDA(At, 1, 1); PG8_STAGE(PG8_SB(1, 0), b3, voffB); PG8_STAGE(PG8_SB(1, 1), b3 + hstepB, voffB); PG8_STAGE(PG8_SA(1, 0), a3, PG8_NVA(0));
            PG8_WAIT_V(8); PG8_WAIT_L(0); PG8_BAR; PG8_MMA(1, 0, At, B0); PG8_MMA(1, 1, At, B1); PG8_BAR; PG8_SCHED;
            } else {
            PG8_LDB(B0, 0, 0); PG8_SCHED; PG8_LDA(At, 0, 0); PG8_STAGE(PG8_SA(1, 1), a1, vA[1]);
            PG8_WAIT_L(8); PG8_BAR; PG8_WAIT_L(0); PG8_MMA(0, 0, At, B0); PG8_BAR; PG8_SCHED;
            PG8_LDB(B1, 0, 1); PG8_STAGE(PG8_SB(0, 0), b2, voffB);
            PG8_BAR; PG8_WAIT_L(0); PG8_MMA(0, 1, At, B1); PG8_BAR;
            PG8_LDA(At, 0, 1); PG8_STAGE(PG8_SA(0, 0), a2, PG8_NVA(0));
            PG8_BAR; PG8_WAIT_L(0); PG8_MMA(1, 0, At, B0); PG8_BAR; PG8_SCHED;
            PG8_STAGE(PG8_SB(0, 1), b2 + hstepB, voffB);
            PG8_WAIT_V(6); PG8_BAR; PG8_MMA(1, 1, At, B1); PG8_BAR;
            PG8_LDB(B0, 1, 0); PG8_SCHED; PG8_LDA(At, 1, 0); PG8_STAGE(PG8_SA(0, 1), a2, PG8_NVA(1));
            PG8_WAIT_L(8); PG8_BAR; PG8_WAIT_L(0); PG8_MMA(0, 0, At, B0); PG8_BAR; PG8_SCHED;
            PG8_LDB(B1, 1, 1); PG8_STAGE(PG8_SB(1, 0), b3, voffB);
            PG8_BAR; PG8_WAIT_L(0); PG8_MMA(0, 1, At, B1); PG8_BAR;
            PG8_LDA(At, 1, 1); PG8_STAGE(PG8_SA(1, 0), a3, PG8_NVA(0));
            PG8_BAR; PG8_WAIT_L(0); PG8_MMA(1, 0, At, B0); PG8_BAR; PG8_SCHED;
            PG8_STAGE(PG8_SB(1, 1), b3 + hstepB, voffB);
            PG8_WAIT_V(6); PG8_BAR; PG8_MMA(1, 1, At, B1); PG8_BAR;
            }
        }
        if constexpr (ALIGN_EPI) { if (wr == 0) PG8_BAR; }
        if constexpr (FP8) asm volatile("s_nop 15\n\ts_nop 15" ::: "memory");
        E(acc, cur, wr, wc, fr, fq);
        if (!has_next) break;
#pragma unroll
        for (int a = 0; a < 2; ++a)
#pragma unroll
            for (int b = 0; b < 2; ++b)
#pragma unroll
                for (int m = 0; m < 4; ++m)
#pragma unroll
                    for (int n = 0; n < 2; ++n) acc[a][b][m][n] = (f32x4){0.f, 0.f, 0.f, 0.f};
        cur = nxt; cA = nA; cB = nB; ++ui;
        if constexpr (Sched::GATHER) {
#pragma unroll
            for (int h = 0; h < 2; ++h)
#pragma unroll
                for (int i = 0; i < 2; ++i) vA[h][i] = nvA[h][i];
        }
        if constexpr (ALIGN_EPI) { if (wr == 1) PG8_BAR; }
    }
    PG8_WAIT_V(0);
    if constexpr (!ALIGN_EPI) { if (wr == 0) PG8_BAR; }
    PG8_BAR;
#undef PG8_SA
#undef PG8_SB
#undef PG8_STAGE
#undef PG8_LDA
#undef PG8_LDB
#undef PG8_MMA
#undef PG8_NVA
#undef PG8_LD1
#undef PG8_WAIT_V
#undef PG8_WAIT_L
#undef PG8_BAR
#undef PG8_SCHED
}
}

struct DenseSched {
    static constexpr bool GATHER = false;
    int nM, nN, G, c; const char* A; const char* B; size_t strideA, strideB;
    __device__ __forceinline__ bool next(int i, pg8::Unit& u) const {
        if (!pg8::order_next(nM, nN, G, c, i, u.pm, u.pn)) return false;
        u.a = A + (size_t)u.pm * strideA; u.b = B + (size_t)u.pn * strideB; u.aux = 0; return true;
    }
    __device__ __forceinline__ void a_offsets(const pg8::Unit&, const pg8::Gemm& g, const int (&R)[2], const int (&C)[2], unsigned (&v)[2][2]) const {
#pragma unroll
        for (int h = 0; h < 2; ++h)
#pragma unroll
            for (int i = 0; i < 2; ++i) v[h][i] = (unsigned)((h * 128 + R[i]) * g.lda + C[i]);
    }
};


__device__ __forceinline__ float gelu_tanh(float v) { const float z = 1.5957691216057308f * (v + 0.044715f * v * v * v); return v * __builtin_amdgcn_rcpf(1.f + __expf(-z)); }
__device__ __forceinline__ float sigmoid_f(float v) { return __builtin_amdgcn_rcpf(1.f + __expf(-v)); }
template <int ACT> struct EpiBf16 {
    static constexpr bool PERM = true;
    bf16* O; int ldc; const float* bias; int nscale; float scale;
    __device__ __forceinline__ void operator()(const f32x4 (&acc)[2][2][4][2], const pg8::Unit& u, int wr, int wc, int fr, int fq) const {
        const int row0 = u.pm * 256 + wr * 64 + fr, col0 = u.pn * 256 + wc * 32 + 8 * fq;
        const float sc = u.pn < nscale ? scale : 1.f;
#pragma unroll
        for (int bj = 0; bj < 2; ++bj) {
            const f32x4 zz = (f32x4){0.f, 0.f, 0.f, 0.f};
            const f32x4 b0 = bias ? *(const f32x4*)(bias + col0 + bj * 128) : zz, b1 = bias ? *(const f32x4*)(bias + col0 + bj * 128 + 4) : zz;
#pragma unroll
            for (int ai = 0; ai < 2; ++ai)
#pragma unroll
                for (int m = 0; m < 4; ++m) {
                    f32x4 v0 = (acc[ai][bj][m][0] + b0) * sc, v1 = (acc[ai][bj][m][1] + b1) * sc;
                    if (ACT == 1) { v0 = (f32x4){gelu_tanh(v0.x), gelu_tanh(v0.y), gelu_tanh(v0.z), gelu_tanh(v0.w)}; v1 = (f32x4){gelu_tanh(v1.x), gelu_tanh(v1.y), gelu_tanh(v1.z), gelu_tanh(v1.w)}; }
                    v4u w; w.x = pg8::cvt_pk_bf16(v0.x, v0.y); w.y = pg8::cvt_pk_bf16(v0.z, v0.w); w.z = pg8::cvt_pk_bf16(v1.x, v1.y); w.w = pg8::cvt_pk_bf16(v1.z, v1.w);
                    *(v4u*)(O + (size_t)(row0 + ai * 128 + m * 16) * ldc + col0 + bj * 128) = w;
                    if (m == 3) asm volatile("s_waitcnt vmcnt(0)" ::: "memory");
                }
        }
    }
};
struct EpiF8 {
    static constexpr bool PERM = true;
    unsigned char* O; int ldc;
    __device__ __forceinline__ void operator()(const f32x4 (&acc)[2][2][4][2], const pg8::Unit& u, int wr, int wc, int fr, int fq) const {
        const int row0 = u.pm * 256 + wr * 64 + fr, col0 = u.pn * 256 + wc * 32 + 8 * fq;
#pragma unroll
        for (int bj = 0; bj < 2; ++bj)
#pragma unroll
            for (int ai = 0; ai < 2; ++ai)
#pragma unroll
                for (int m = 0; m < 4; ++m) { const f32x4 v0 = acc[ai][bj][m][0], v1 = acc[ai][bj][m][1];
                    v2u w; w.x = pk4_fp8(v0.x, v0.y, v0.z, v0.w); w.y = pk4_fp8(v1.x, v1.y, v1.z, v1.w);
                    *(v2u*)(O + (size_t)(row0 + ai * 128 + m * 16) * ldc + col0 + bj * 128) = w; }
    }
};
struct EpiBf16RowBias {
    static constexpr bool PERM = true;
    bf16* O; int ldc; const float* bias;
    __device__ __forceinline__ void operator()(const f32x4 (&acc)[2][2][4][2], const pg8::Unit& u, int wr, int wc, int fr, int fq) const {
        const int row0 = u.pm * 256 + wr * 64 + fr, col0 = u.pn * 256 + wc * 32 + 8 * fq;
#pragma unroll
        for (int ai = 0; ai < 2; ++ai)
#pragma unroll
            for (int m = 0; m < 4; ++m) { const int row = row0 + ai * 128 + m * 16; const float b = bias[row];
#pragma unroll
                for (int bj = 0; bj < 2; ++bj) { const f32x4 v0 = acc[ai][bj][m][0] + b, v1 = acc[ai][bj][m][1] + b;
                    v4u w; w.x = pg8::cvt_pk_bf16(v0.x, v0.y); w.y = pg8::cvt_pk_bf16(v0.z, v0.w); w.z = pg8::cvt_pk_bf16(v1.x, v1.y); w.w = pg8::cvt_pk_bf16(v1.z, v1.w);
                    *(v4u*)(O + (size_t)row * ldc + col0 + bj * 128) = w; } }
    }
};
template <bool INPLACE>
struct EpiResid {
    static constexpr bool PERM = true;
    const float* baseL; const float* baseC; bf16* XL; const float* bias; const float* gate;
    __device__ __forceinline__ void operator()(const f32x4 (&acc)[2][2][4][2], const pg8::Unit& u, int wr, int wc, int fr, int fq) const {
        const int rowt = u.pm * 256, col0 = u.pn * 256 + wc * 32 + 8 * fq;
        const bool isc = rowt >= NL; const int mrow = isc ? 8 : (rowt >> 12);
        const float* base = isc ? baseC - (size_t)NL * D : baseL;
        const float* gp = gate + (size_t)mrow * (NMOD * D);
#pragma unroll
        for (int bj = 0; bj < 2; ++bj) { const int col = col0 + bj * 128;
            const f32x4 bv0 = *(const f32x4*)(bias + col), bv1 = *(const f32x4*)(bias + col + 4), gv0 = *(const f32x4*)(gp + col), gv1 = *(const f32x4*)(gp + col + 4);
#pragma unroll
            for (int ai = 0; ai < 2; ++ai) {
                f32x4 x0[4], x1[4];
#pragma unroll
                for (int m = 0; m < 4; ++m) { const size_t off = (size_t)(rowt + ai * 128 + wr * 64 + m * 16 + fr) * D + col;
                    if (INPLACE) { const v4u w = *(const v4u*)(XL + off); x0[m] = (f32x4){bflo(w.x), bfhi(w.x), bflo(w.y), bfhi(w.y)}; x1[m] = (f32x4){bflo(w.z), bfhi(w.z), bflo(w.w), bfhi(w.w)}; }
                    else { x0[m] = *(const f32x4*)(base + off); x1[m] = *(const f32x4*)(base + off + 4); } }
#pragma unroll
                for (int m = 0; m < 4; ++m) { const size_t off = (size_t)(rowt + ai * 128 + wr * 64 + m * 16 + fr) * D + col;
                    const f32x4 y0 = x0[m] + gv0 * (acc[ai][bj][m][0] + bv0), y1 = x1[m] + gv1 * (acc[ai][bj][m][1] + bv1);
                    v4u o; o.x = pg8::cvt_pk_bf16(y0.x, y0.y); o.y = pg8::cvt_pk_bf16(y0.z, y0.w); o.z = pg8::cvt_pk_bf16(y1.x, y1.y); o.w = pg8::cvt_pk_bf16(y1.z, y1.w);
                    *(v4u*)(XL + off) = o; } } }
    }
};

constexpr size_t WS_G = 208 * MiB, WS_UPRE = 272 * MiB, WS_GH = 340 * MiB;
constexpr int SCT = 64, NCHUNK = 68, AT_STRIDE = 528;
typedef float f32x4v __attribute__((ext_vector_type(4)));
constexpr size_t WS_UC8 = WS_HDN;
constexpr size_t WS_UC = WS_A;
__device__ __forceinline__ void conv_phase(Frame& F) {
    const bf16* UPRE = (const bf16*)(F.ws + WS_UPRE); bf16* UC = (bf16*)(F.ws + WS_UC); unsigned char* UC8 = F.ws + WS_UC8;
    const int ch8 = F.tid & 127, c0 = 8 * ch8;
    float cw[4][8], cb[8];
#pragma unroll
    for (int k = 0; k < 4; ++k) { const f32x4 a = *(const f32x4*)(F.in[I_CONVW] + k * D + c0), bq = *(const f32x4*)(F.in[I_CONVW] + k * D + c0 + 4);
        cw[k][0] = a.x; cw[k][1] = a.y; cw[k][2] = a.z; cw[k][3] = a.w; cw[k][4] = bq.x; cw[k][5] = bq.y; cw[k][6] = bq.z; cw[k][7] = bq.w; }
    { const f32x4 a = *(const f32x4*)(F.in[I_CONVB] + c0), bq = *(const f32x4*)(F.in[I_CONVB] + c0 + 4); cb[0] = a.x; cb[1] = a.y; cb[2] = a.z; cb[3] = a.w; cb[4] = bq.x; cb[5] = bq.y; cb[6] = bq.z; cb[7] = bq.w; }
    const int ng = MT / 4;
    for (int gi = F.vcu * 4 + (F.tid >> 7); gi < ng; gi += F.G * 4) {
        const int r0 = gi * 4;
        int s0, len; if (r0 < NL) { s0 = r0 & ~(SEQ - 1); len = SEQ; } else { s0 = NL + ((r0 - NL) & ~(CTXL - 1)); len = CTXL; }
        float x[7][8];
#pragma unroll
        for (int i = 0; i < 7; ++i) { const int r = r0 - 2 + i;
            v4u raw = (v4u){0u, 0u, 0u, 0u};
            if (r >= s0 && r < s0 + len) raw = *(const v4u*)(UPRE + (size_t)r * D + c0);
            x[i][0] = bflo(raw.x); x[i][1] = bfhi(raw.x); x[i][2] = bflo(raw.y); x[i][3] = bfhi(raw.y); x[i][4] = bflo(raw.z); x[i][5] = bfhi(raw.z); x[i][6] = bflo(raw.w); x[i][7] = bfhi(raw.w); }
#pragma unroll
        for (int tt = 0; tt < 4; ++tt) { float o[8];
#pragma unroll
            for (int c = 0; c < 8; ++c) o[c] = cb[c] + x[tt][c] * cw[0][c] + x[tt + 1][c] * cw[1][c] + x[tt + 2][c] * cw[2][c] + x[tt + 3][c] * cw[3][c];
            v4u wv; wv.x = pk2(o[0], o[1]); wv.y = pk2(o[2], o[3]); wv.z = pk2(o[4], o[5]); wv.w = pk2(o[6], o[7]);
            *(v4u*)(UC + (size_t)(r0 + tt) * D + c0) = wv;
            v2u w8; w8.x = pk4_fp8(o[0], o[1], o[2], o[3]); w8.y = pk4_fp8(o[4], o[5], o[6], o[7]); *(v2u*)(UC8 + (size_t)(r0 + tt) * D + c0) = w8; }
    }
}
constexpr int SW_AGG = 16384, SW_A = 20480, SW_ATILE = 32 * 256, SW_U = SW_A + 8 * SW_ATILE, SW_G = SW_U + 8 * 2560;
constexpr int SW_MTN = 2, SW_T = 16 * SW_MTN;
constexpr int SW_NCTX = CTXL / SW_T, SW_NCH = (CTXL + SEQ) / SW_T, SW_STEPS = (SW_NCH + 7) / 8;
constexpr int SW_F8SCALE = 0x7D7D7D7D;
static_assert(SW_MTN == 2 && SW_G + 8 * 2560 <= RTAB_BYTES, "sweep LDS map");
__device__ __forceinline__ void rows4(float x, float (&r)[4]) {
    typedef unsigned u32x2 __attribute__((ext_vector_type(2)));
    const unsigned xi = __builtin_bit_cast(unsigned, x);
    const u32x2 p16 = __builtin_amdgcn_permlane16_swap(xi, xi, false, false);
    const u32x2 pa = __builtin_amdgcn_permlane32_swap(p16.x, p16.x, false, false);
    const u32x2 pb = __builtin_amdgcn_permlane32_swap(p16.y, p16.y, false, false);
    r[0] = __uint_as_float(pa[0]); r[1] = __uint_as_float(pb[0]); r[2] = __uint_as_float(pa[1]); r[3] = __uint_as_float(pb[1]);
}
template <int DIR>
__device__ __forceinline__ void scan_sweep(Frame& F) {
    constexpr int MTN = SW_MTN;
    const int lane = F.lane, w = F.wave, g = lane >> 4, lc = lane & 15;
    const int c = F.vcu, b = c >> 5, nb = (c >> 3) & 3, cg = c & 7;
    const bf16* UC = (const bf16*)(F.ws + WS_UC); const unsigned char* UC8 = F.ws + WS_UC8; const unsigned char* WG8 = F.ws + WS_WG;
    const bf16* Gp = (const bf16*)(F.ws + WS_G); bf16* GH = (bf16*)(F.ws + WS_GH);
#pragma unroll
    for (int i = 0; i < 2; ++i) { const int pid = F.tid + 512 * i, n = pid >> 4, pp = pid & 15; const int nt = n >> 4, j = n & 15, ct = nt >> 1, gate = nt & 1;
        const v4u v = *(const v4u*)(WG8 + ((size_t)(((DIR * 2 + gate) * 4 + nb) * 256 + 32 * cg + 16 * ct + j)) * 256 + pp * 16);
        *(LAS v4u*)(F.lds + n * 256 + ((pp ^ (n & 15)) << 4)) = v; }
    float br[2], bi[2], lam8[2], hprev[2];
#pragma unroll
    for (int ct = 0; ct < 2; ++ct) { const int ch = nb * 256 + 32 * cg + 16 * ct + lc;
        br[ct] = F.in[I_BGATE][(DIR * 2 + 0) * D + ch]; bi[ct] = F.in[I_BGATE][(DIR * 2 + 1) * D + ch];
        lam8[ct] = -8.f * log1pf(__expf(-F.in[I_LAMBDA][DIR * D + ch])); hprev[ct] = 0.f; }
    LAS f32x2* AGG = (LAS f32x2*)(F.lds + SW_AGG);
    LAS unsigned char* AT = F.lds + SW_A + w * SW_ATILE;
    LAS unsigned char* UT = F.lds + SW_U + w * 2560;
    LAS unsigned char* GS = F.lds + SW_G + w * 2560;
    int f8s = SW_F8SCALE; asm volatile("" : "+v"(f8s));
#define SW_CI(idx_) (DIR == 0 ? (idx_) : ((idx_) < SW_NCTX ? SW_NCTX - 1 - (idx_) : SW_NCH + SW_NCTX - 1 - (idx_)))
#define SW_ROW0(ci_) ((ci_) < SW_NCTX ? NL + b * CTXL + (ci_) * SW_T : b * SEQ + ((ci_) - SW_NCTX) * SW_T)
#define SW_LOADA(row0_) do { const unsigned char* ap_ = UC8 + (size_t)((row0_) + (lane >> 4)) * D + nb * 256 + 16 * (lane & 15); \
        _Pragma("unroll") for (int i = 0; i < 8; ++i) areg[i] = *(const v4u*)(ap_ + (size_t)(4 * i) * D); \
        _Pragma("unroll") for (int i = 0; i < 2; ++i) { const int pp_ = lane + 64 * i; ureg[i] = *(const v4u*)(UC + (size_t)((row0_) + (pp_ >> 2)) * D + nb * 256 + 32 * cg + 8 * (pp_ & 3)); } } while (0)
    v4u areg[8], ureg[2];
    { const int ci0 = SW_CI(w); SW_LOADA(SW_ROW0(ci0)); }
    __syncthreads();
    for (int s = 0; s < SW_STEPS; ++s) {
        const int idx = 8 * s + w; const bool active = idx < SW_NCH;
        const int ci = SW_CI(idx); const bool isctx = ci < SW_NCTX; const int row0 = SW_ROW0(ci);
        float Pc[2][MTN][4], Hc[2][MTN][4], CA[2], CB[2]; v4u hfr[MTN], gr[MTN];
        CA[0] = 1.f; CB[0] = 0.f; CA[1] = 1.f; CB[1] = 0.f;
        if (active) {
            f32x4 acc[MTN][4]; float uu[2][MTN][4];
#pragma unroll
            for (int mt = 0; mt < MTN; ++mt)
#pragma unroll
                for (int nt = 0; nt < 4; ++nt) acc[mt][nt] = (f32x4){0.f, 0.f, 0.f, 0.f};
#pragma unroll
            for (int i = 0; i < 8; ++i) { const int r = 4 * i + (lane >> 4); *(LAS v4u*)(AT + r * 256 + (((lane & 15) ^ (r & 15)) << 4)) = areg[i]; }
#pragma unroll
            for (int i = 0; i < 2; ++i) { const int pp = lane + 64 * i; *(LAS v4u*)(UT + (pp >> 2) * 80 + 16 * (pp & 3)) = ureg[i]; }
            asm volatile("s_waitcnt lgkmcnt(0)" ::: "memory");
#pragma unroll
            for (int ct = 0; ct < 2; ++ct)
#pragma unroll
                for (int mt = 0; mt < MTN; ++mt)
#pragma unroll
                    for (int r = 0; r < 4; ++r) uu[ct][mt][r] = bf2f(*(const LAS unsigned short*)(UT + (16 * mt + 4 * g + r) * 80 + (16 * ct + lc) * 2));
#pragma unroll
            for (int kb = 0; kb < 2; ++kb) {
                pg8::v8i bfr[4], afr[MTN];
#pragma unroll
                for (int nt = 0; nt < 4; ++nt) { const LAS unsigned char* rp = F.lds + (16 * nt + lc) * 256;
                    bfr[nt].lo = *(const LAS pg8::v4i*)(rp + (((2 * g + 8 * kb) ^ lc) << 4)); bfr[nt].hi = *(const LAS pg8::v4i*)(rp + (((2 * g + 1 + 8 * kb) ^ lc) << 4)); }
#pragma unroll
                for (int mt = 0; mt < MTN; ++mt) { const LAS unsigned char* rp = AT + (16 * mt + lc) * 256;
                    afr[mt].lo = *(const LAS pg8::v4i*)(rp + (((2 * g + 8 * kb) ^ lc) << 4)); afr[mt].hi = *(const LAS pg8::v4i*)(rp + (((2 * g + 1 + 8 * kb) ^ lc) << 4)); }
#pragma unroll
                for (int mt = 0; mt < MTN; ++mt)
#pragma unroll
                    for (int nt = 0; nt < 4; ++nt)
                        asm volatile("v_mfma_scale_f32_16x16x128_f8f6f4 %0, %1, %2, %0, %3, %3 op_sel_hi:[0,0,0]" : "+v"(acc[mt][nt]) : "v"(afr[mt]), "v"(bfr[nt]), "v"(f8s));
            }
            asm volatile("s_nop 15\n\ts_nop 15\n\ts_waitcnt lgkmcnt(0)" ::: "memory");
            if (idx + 8 < SW_NCH) { const int nci = SW_CI(idx + 8); SW_LOADA(SW_ROW0(nci)); }
            if (DIR == 1 && !isctx) {
#pragma unroll
                for (int i = 0; i < MTN; ++i) { const int pp = lane + 64 * i; const size_t off = (size_t)(row0 + (pp >> 2)) * D + nb * 256 + 32 * cg + 8 * (pp & 3);
                    hfr[i] = *(const v4u*)(GH + off); gr[i] = *(const v4u*)(Gp + off); }
            }
#pragma unroll
            for (int ct = 0; ct < 2; ++ct) {
                float a[MTN][4], bc[MTN][4];
#pragma unroll
                for (int mt = 0; mt < MTN; ++mt)
#pragma unroll
                    for (int r = 0; r < 4; ++r) {
                        const float rg = __builtin_amdgcn_rcpf(1.f + __expf(-(acc[mt][ct * 2 + 0][r] + br[ct]))), ig = __builtin_amdgcn_rcpf(1.f + __expf(-(acc[mt][ct * 2 + 1][r] + bi[ct])));
                        const float av = __expf(lam8[ct] * rg); a[mt][r] = av; bc[mt][r] = __builtin_amdgcn_sqrtf(fmaxf(1.f - av * av, 0.f)) * (ig * uu[ct][mt][r]); }
                float ca = 1.f, cbv = 0.f;
#pragma unroll
                for (int q4 = 0; q4 < MTN; ++q4) { const int mt = DIR == 0 ? q4 : MTN - 1 - q4;
                    float A = 1.f, B = 0.f;
#pragma unroll
                    for (int rr = 0; rr < 4; ++rr) { const int r = DIR == 0 ? rr : 3 - rr; A = A * a[mt][r]; B = a[mt][r] * B + bc[mt][r]; }
                    float ta = 1.f, tb = 0.f, ea = 1.f, eb = 0.f, Ar[4], Br[4];
                    rows4(A, Ar); rows4(B, Br);
#pragma unroll
                    for (int q = 0; q < 4; ++q) { const int gg = DIR == 0 ? q : 3 - q;
                        const float Ag = Ar[gg], Bg = Br[gg];
                        if (gg == g) { ea = ta; eb = tb; }
                        tb = Ag * tb + Bg; ta = ta * Ag; }
                    float pa = ea * ca, pb = ea * cbv + eb;
#pragma unroll
                    for (int rr = 0; rr < 4; ++rr) { const int r = DIR == 0 ? rr : 3 - rr; pb = a[mt][r] * pb + bc[mt][r]; pa = pa * a[mt][r]; Pc[ct][mt][r] = pa; Hc[ct][mt][r] = pb; }
                    cbv = ta * cbv + tb; ca = ca * ta; }
                CA[ct] = ca; CB[ct] = cbv;
            }
        }
        if (g == 0) { AGG[(((s & 1) * 8 + w) * 2 + 0) * 16 + lc] = (f32x2){CA[0], CB[0]}; AGG[(((s & 1) * 8 + w) * 2 + 1) * 16 + lc] = (f32x2){CA[1], CB[1]}; }
        __syncthreads();
        float hin[2];
#pragma unroll
        for (int ct = 0; ct < 2; ++ct) { float h = hprev[ct]; hin[ct] = h;
#pragma unroll
            for (int ww = 0; ww < 8; ++ww) { const f32x2 ab = AGG[(((s & 1) * 8 + ww) * 2 + ct) * 16 + lc]; if (ww == w) hin[ct] = h; h = ab.x * h + ab.y; }
            hprev[ct] = h; }
        if (active && !isctx) {
            LAS unsigned char* US = AT;
            if (DIR == 1) {
#pragma unroll
                for (int i = 0; i < MTN; ++i) { const int pp = lane + 64 * i; *(LAS v4u*)(US + (pp >> 2) * 80 + 16 * (pp & 3)) = hfr[i]; *(LAS v4u*)(GS + (pp >> 2) * 80 + 16 * (pp & 3)) = gr[i]; }
                asm volatile("s_waitcnt lgkmcnt(0)" ::: "memory");
            }
#pragma unroll
            for (int ct = 0; ct < 2; ++ct)
#pragma unroll
                for (int mt = 0; mt < MTN; ++mt)
#pragma unroll
                    for (int r = 0; r < 4; ++r) { const float h = Pc[ct][mt][r] * hin[ct] + Hc[ct][mt][r];
                        const int so = (16 * mt + 4 * g + r) * 80 + (16 * ct + lc) * 2;
                        float o = h;
                        if (DIR == 1) o = (bf2f(*(const LAS unsigned short*)(US + so)) + h) * bf2f(*(const LAS unsigned short*)(GS + so));
                        *(LAS unsigned short*)(US + so) = (unsigned short)f2bf(o); }
            asm volatile("s_waitcnt lgkmcnt(0)" ::: "memory");
#pragma unroll
            for (int i = 0; i < MTN; ++i) { const int pp = lane + 64 * i; const size_t off = (size_t)(row0 + (pp >> 2)) * D + nb * 256 + 32 * cg + 8 * (pp & 3);
                *(v4u*)(GH + off) = *(const LAS v4u*)(US + (pp >> 2) * 80 + 16 * (pp & 3)); }
            asm volatile("s_waitcnt lgkmcnt(0)" ::: "memory");
        }
    }
#undef SW_CI
#undef SW_ROW0
#undef SW_LOADA
    __syncthreads();
}

constexpr float LOG2E = 1.4426950408889634f;
__device__ __forceinline__ bf16x8 pack8(const f32x4 a, const f32x4 b) {
    v4u w; w.x = pg8::cvt_pk_bf16(a.x, a.y); w.y = pg8::cvt_pk_bf16(a.z, a.w); w.z = pg8::cvt_pk_bf16(b.x, b.y); w.w = pg8::cvt_pk_bf16(b.z, b.w);
    return __builtin_bit_cast(bf16x8, w);
}
constexpr int AK_C = 0, AV_C = 32768, AK_W = 67584, AV_W = 67584, A_RPB = 143360;
__device__ __forceinline__ int kswz(int k) { return ((k >> 1) & 1) | (((k >> 3) & 3) << 1); }
__device__ __forceinline__ void attn_stage_ctx(Frame& F, const bf16* QK, const bf16* VT, int b, int h) {
    v4u kr[4], vr[4]; int tid_ = F.tid; asm volatile("" : "+v"(tid_));
#pragma unroll
    for (int i = 0; i < 4; ++i) { const int pid = tid_ + 512 * i; { const int key = pid >> 3, c = pid & 7; kr[i] = *(const v4u*)(QK + (size_t)(NL + b * CTXL + key) * 2048 + 1024 + h * 64 + c * 8); }
        { const int dim = pid >> 5, c = pid & 31; vr[i] = *(const v4u*)(VT + (size_t)(h * 64 + dim) * MT + NL + b * CTXL + c * 8); } }
#pragma unroll
    for (int i = 0; i < 4; ++i) { const int pid = tid_ + 512 * i; { const int key = pid >> 3, c = pid & 7; *(LAS v4u*)(F.lds + AK_C + key * 128 + ((c ^ kswz(key & 31)) << 4)) = kr[i]; }
        { const int dim = pid >> 5, c = pid & 31; *(LAS v4u*)(F.lds + AV_C + dim * 544 + c * 16) = vr[i]; } }
    __syncthreads();
}
__device__ __forceinline__ void attn_load_kw(const bf16* QK, int b, int h, int rb, int tid, v4u (&kr)[9]) {
    asm volatile("" : "+v"(tid));
#pragma unroll
    for (int i = 0; i < 9; ++i) { const int pid = tid + 512 * i, key = pid >> 3, c = pid & 7; int row = rb + (key >> 6); row = row > 63 ? 63 : row;
        kr[i] = *(const v4u*)(QK + (size_t)(b * SEQ + row * 64 + (key & 63)) * 2048 + 1024 + h * 64 + c * 8); }
}
__device__ __forceinline__ void attn_store_kw(LAS unsigned char* lds, int tid, const v4u (&kr)[9]) {
    asm volatile("" : "+v"(tid));
#pragma unroll
    for (int i = 0; i < 9; ++i) { const int pid = tid + 512 * i, key = pid >> 3, c = pid & 7; *(LAS v4u*)(lds + AK_W + key * 128 + ((c ^ kswz(key & 31)) << 4)) = kr[i]; }
}
__device__ __forceinline__ void attn_load_vw(const bf16* VT, int b, int h, int rb, int tid, v4u (&vr)[9]) {
    asm volatile("" : "+v"(tid));
#pragma unroll
    for (int i = 0; i < 9; ++i) { const int pid = tid + 512 * i, dim = pid / 72, c = pid % 72; int row = rb + (c >> 3); row = row > 63 ? 63 : row;
        vr[i] = *(const v4u*)(VT + (size_t)(h * 64 + dim) * MT + b * SEQ + row * 64 + (c & 7) * 8); }
}
__device__ __forceinline__ void attn_store_vw(LAS unsigned char* lds, int tid, const v4u (&vr)[9]) {
    asm volatile("" : "+v"(tid));
#pragma unroll
    for (int i = 0; i < 9; ++i) { const int pid = tid + 512 * i, dim = pid / 72, c = pid % 72; *(LAS v4u*)(lds + AV_W + dim * 1184 + c * 16) = vr[i]; }
}
constexpr int AV_T = LDSCTL_OFF + 1024;
__device__ __forceinline__ void attn_dma_vw(LAS unsigned char* lds, const bf16* VT, int b, int h, int rb, int w, int lane) {
    unsigned voff = (unsigned)lane * 16u; asm volatile("" : "+v"(voff));
#pragma unroll
    for (int j = 0; j < 8; ++j) { const int dim = 8 * w + j;
        const char* src = (const char*)(VT + (size_t)(h * 64 + dim) * MT + b * SEQ + rb * 64);
        __builtin_amdgcn_global_load_lds((const unsigned*)(src + voff), (LAS unsigned*)(lds + AV_W + dim * 1184), 16, 0, 0); }
    { const char* src = (const char*)(VT + (size_t)(h * 64 + 8 * w) * MT + b * SEQ + (rb + 8) * 64);
      __builtin_amdgcn_global_load_lds((const unsigned*)(src + (size_t)(voff >> 7) * (MT * 2) + (voff & 127u)), (LAS unsigned*)(lds + AV_T + w * 1024), 16, 0, 0); }
}
__device__ __forceinline__ float xrow_max(float x) {
    auto s = __builtin_amdgcn_permlane16_swap(__float_as_uint(x), __float_as_uint(x), false, false); x = fmaxf(__uint_as_float(s[0]), __uint_as_float(s[1]));
    auto t = __builtin_amdgcn_permlane32_swap(__float_as_uint(x), __float_as_uint(x), false, false); return fmaxf(__uint_as_float(t[0]), __uint_as_float(t[1]));
}
__device__ __forceinline__ float xrow_sum(float x) {
    auto s = __builtin_amdgcn_permlane16_swap(__float_as_uint(x), __float_as_uint(x), false, false); x = __uint_as_float(s[0]) + __uint_as_float(s[1]);
    auto t = __builtin_amdgcn_permlane32_swap(__float_as_uint(x), __float_as_uint(x), false, false); return __uint_as_float(t[0]) + __uint_as_float(t[1]);
}
template <bool LAT>
__device__ __forceinline__ void attn_unit(Frame& F, const bf16* QK, const bf16* VT, bf16* O, int b, int h, int rp_or_half, v4u (&kr)[9], bool has_next, int nrb) {
    int lane_ = F.lane; asm volatile("" : "+v"(lane_));
    const int lane = lane_, g = lane >> 4, lc = lane & 15, w = F.wave;
    const f32x4 zero4 = (f32x4){0.f, 0.f, 0.f, 0.f};
    int r = 0, qt = 0, tokq0, span0 = 0, rs = 0, rb = 0, wro = 0;
    if (LAT) { r = 2 * rp_or_half + (w >> 2); qt = w & 3; tokq0 = b * SEQ + r * 64 + 16 * qt; span0 = qt == 0 ? 0 : (qt == 1 ? 8 : (qt == 2 ? 24 : 32));
        rs = r - 4 < 0 ? 0 : (r - 4 > 56 ? 56 : r - 4); const int r0 = 2 * rp_or_half; rb = r0 - 4 < 0 ? 0 : (r0 - 4 > 56 ? 56 : r0 - 4); wro = rs - rb; }
    else { tokq0 = NL + b * CTXL + rp_or_half * 128 + 16 * w; }
    const bf16* qp = QK + (size_t)(tokq0 + lc) * 2048 + h * 64 + 8 * g;
    const bf16x8 qf0 = *(const bf16x8*)qp, qf1 = *(const bf16x8*)(qp + 32);
    if (LAT) { attn_store_kw(F.lds, F.tid, kr); __builtin_amdgcn_sched_barrier(0); }
    const int kk0 = 8 * (lc >> 2) + (lc & 3);
    f32x4 sc[8][2]; bf16x8 pc[8]; f32x4 o[4];
#pragma unroll
    for (int cp = 0; cp < 8; ++cp)
#pragma unroll
        for (int p = 0; p < 2; ++p) { const int key = 32 * cp + kk0 + 4 * p; const int sz = kswz(key & 31);
            const bf16x8 k0 = *(const LAS bf16x8*)(F.lds + AK_C + key * 128 + ((g ^ sz) << 4)), k1 = *(const LAS bf16x8*)(F.lds + AK_C + key * 128 + (((4 + g) ^ sz) << 4));
            f32x4 a = __builtin_amdgcn_mfma_f32_16x16x32_bf16(k0, qf0, zero4, 0, 0, 0);
            sc[cp][p] = __builtin_amdgcn_mfma_f32_16x16x32_bf16(k1, qf1, a, 0, 0, 0); if (p == 1) asm volatile("" ::: "memory"); }
    float l = 0.f, mc = -1e30f;
#define ATT_CMAX() do { _Pragma("unroll") for (int i_ = 0; i_ < 8; ++i_) _Pragma("unroll") for (int p_ = 0; p_ < 2; ++p_) _Pragma("unroll") for (int j_ = 0; j_ < 4; ++j_) mc = fmaxf(mc, sc[i_][p_][j_]); mc = xrow_max(mc); } while (0)
#define ATT_CEXP(cp_) do { f32x4 e_[2]; _Pragma("unroll") for (int p_ = 0; p_ < 2; ++p_) _Pragma("unroll") for (int j_ = 0; j_ < 4; ++j_) { e_[p_][j_] = __builtin_amdgcn_exp2f(sc[cp_][p_][j_] - mc); l += e_[p_][j_]; } \
        pc[cp_] = pack8(e_[0], e_[1]); asm volatile("" : "+v"(l));   } while (0)
#define ATT_PVC(cp_) do { _Pragma("unroll") for (int dt = 0; dt < 4; ++dt) { const bf16x8 vf = *(const LAS bf16x8*)(F.lds + AV_C + (16 * dt + lc) * 544 + (32 * (cp_) + 8 * g) * 2); \
        o[dt] = __builtin_amdgcn_mfma_f32_16x16x32_bf16(vf, pc[cp_], o[dt], 0, 0, 0); } asm volatile("" ::: "memory"); } while (0)
    if (LAT) {
        f32x4 sw[8][2]; bf16x8 pw[8];
        __syncthreads();
#pragma unroll
        for (int i = 0; i < 8; ++i) {
#pragma unroll
            for (int p = 0; p < 2; ++p) { const int key = (wro + i) * 64 + span0 + kk0 + 4 * p; const int sz = kswz(key & 31);
                const bf16x8 k0 = *(const LAS bf16x8*)(F.lds + AK_W + key * 128 + ((g ^ sz) << 4)), k1 = *(const LAS bf16x8*)(F.lds + AK_W + key * 128 + (((4 + g) ^ sz) << 4));
                f32x4 a = __builtin_amdgcn_mfma_f32_16x16x32_bf16(k0, qf0, zero4, 0, 0, 0);
                sw[i][p] = __builtin_amdgcn_mfma_f32_16x16x32_bf16(k1, qf1, a, 0, 0, 0); }
            asm volatile("" ::: "memory");
            if (i == 0) ATT_CMAX(); else ATT_CEXP(i - 1);
            __builtin_amdgcn_sched_barrier(0);
        }
        ATT_CEXP(7);
        __syncthreads();
        attn_dma_vw(F.lds, VT, b, h, rb, w, lane);
        const LAS float* RPB = (const LAS float*)(F.lds + A_RPB);
        const int c = 16 * qt + lc; const int cs = c - 8 < 0 ? 0 : (c - 8 > 48 ? 48 : c - 8);
        const int cb0 = span0 + 8 * g;
        float mw = -1e30f, m2 = mc, alpha = 1.f;
#pragma unroll
        for (int dt = 0; dt < 4; ++dt) o[dt] = zero4;
#define ATT_WBIAS(i_) do { const LAS float* rowb = RPB + (rs + (i_) - r + 7) * 31 + (cb0 - c + 15); float bv[8]; \
        _Pragma("unroll") for (int x = 0; x < 8; ++x) bv[x] = rowb[x]; \
        asm volatile("" : "+v"(bv[0]), "+v"(bv[1]), "+v"(bv[2]), "+v"(bv[3]), "+v"(bv[4]), "+v"(bv[5]), "+v"(bv[6]), "+v"(bv[7]));   \
        _Pragma("unroll") for (int p_ = 0; p_ < 2; ++p_) _Pragma("unroll") for (int j_ = 0; j_ < 4; ++j_) { const bool ok = (unsigned)(cb0 - cs + 4 * p_ + j_) < 16u; \
            const float v_ = ok ? sw[i_][p_][j_] + bv[4 * p_ + j_] : -1e30f; sw[i_][p_][j_] = v_; mw = fmaxf(mw, v_); } } while (0)
#define ATT_WEXP(i_) do { f32x4 e_[2]; _Pragma("unroll") for (int p_ = 0; p_ < 2; ++p_) _Pragma("unroll") for (int j_ = 0; j_ < 4; ++j_) { e_[p_][j_] = __builtin_amdgcn_exp2f(sw[i_][p_][j_] - m2); l += e_[p_][j_]; } \
        pw[i_] = pack8(e_[0], e_[1]); asm volatile("" : "+v"(l)); } while (0)
#pragma unroll
        for (int cp = 0; cp < 8; ++cp) {
            ATT_PVC(cp);
            if (cp < 4) { ATT_WBIAS(2 * cp); ATT_WBIAS(2 * cp + 1); }
            else if (cp == 4) { mw = xrow_max(mw); m2 = fmaxf(mc, mw); alpha = __builtin_amdgcn_exp2f(mc - m2); l *= alpha; }
            else if (cp == 5) { ATT_WEXP(0); ATT_WEXP(1); ATT_WEXP(2); }
            else if (cp == 6) { ATT_WEXP(3); ATT_WEXP(4); ATT_WEXP(5); }
            else { ATT_WEXP(6); ATT_WEXP(7); }
            __builtin_amdgcn_sched_barrier(0);
        }
#pragma unroll
        for (int dt = 0; dt < 4; ++dt) o[dt] = o[dt] * alpha;
        asm volatile("s_waitcnt vmcnt(0)" ::: "memory");
        __syncthreads();
        if (has_next) attn_load_kw(QK, b, h, nrb, F.tid, kr);
#pragma unroll
        for (int i = 0; i < 8; ++i)
#pragma unroll
            for (int dt = 0; dt < 4; ++dt) { const int dim = 16 * dt + lc;
                const int voffs = (i == 7 && wro == 1) ? AV_T + dim * 128 + (span0 + 8 * g) * 2 : AV_W + dim * 1184 + ((wro + i) * 64 + span0 + 8 * g) * 2;
                const bf16x8 vf = *(const LAS bf16x8*)(F.lds + voffs); o[dt] = __builtin_amdgcn_mfma_f32_16x16x32_bf16(vf, pw[i], o[dt], 0, 0, 0); if (dt == 3) asm volatile("" ::: "memory"); }
#undef ATT_WBIAS
#undef ATT_WEXP
    } else {
        ATT_CMAX();
#pragma unroll
        for (int cp = 0; cp < 8; ++cp) ATT_CEXP(cp);
#pragma unroll
        for (int dt = 0; dt < 4; ++dt) o[dt] = zero4;
#pragma unroll
        for (int cp = 0; cp < 8; ++cp) ATT_PVC(cp);
    }
#undef ATT_CMAX
#undef ATT_CEXP
#undef ATT_PVC
    l = xrow_sum(l);
    const float inv = __builtin_amdgcn_rcpf(l);
    unsigned char* op = (unsigned char*)O + (size_t)(tokq0 + lc) * D + h * 64 + 4 * g;
#pragma unroll
    for (int dt = 0; dt < 4; ++dt) *(unsigned*)(op + 16 * dt) = pk4_fp8(o[dt].x * inv, o[dt].y * inv, o[dt].z * inv, o[dt].w * inv);
    if (LAT) __syncthreads();
}
__device__ __forceinline__ void attn_phase(Frame& F) {
    const bf16* QK = (const bf16*)(F.ws + WS_B);
    const bf16* VT = (const bf16*)(F.ws + WS_C);
    bf16* O = (bf16*)(F.ws + WS_A);
    const int NUB = BATCH * NHEAD * 32, per = (NUB + F.G - 1) / F.G;
    int u0 = F.vcu * per, u1 = u0 + per; if (u1 > NUB) u1 = NUB;
    int cb = -1, ch = -1; v4u kr[9];
    for (int u = u0; u < u1; ++u) {
        const int b = u >> 9, h = (u >> 5) & 15, rp = u & 31;
        if (b != cb || h != ch) { __syncthreads(); attn_stage_ctx(F, QK, VT, b, h); if (F.tid < 465) ((LAS float*)(F.lds + A_RPB))[F.tid] = F.in[I_RPB][h * 465 + F.tid] * LOG2E; cb = b; ch = h;
            { const int r0 = 2 * rp; attn_load_kw(QK, b, h, r0 - 4 < 0 ? 0 : (r0 - 4 > 56 ? 56 : r0 - 4), F.tid, kr); } __syncthreads(); }
        const int un = u + 1; const bool hn = un < u1 && (un >> 5) == (u >> 5); const int nr0 = 2 * (un & 31);
        attn_unit<true>(F, QK, VT, O, b, h, rp, kr, hn, nr0 - 4 < 0 ? 0 : (nr0 - 4 > 56 ? 56 : nr0 - 4));
        if (un < u1 && !hn) { cb = -1; }
    }
    for (int u = F.vcu; u < BATCH * NHEAD * 2; u += F.G) {
        const int b = u >> 5, h = (u >> 1) & 15, half = u & 1;
        if (b != cb || h != ch) { __syncthreads(); attn_stage_ctx(F, QK, VT, b, h); cb = b; ch = h; }
        attn_unit<false>(F, QK, VT, O, b, h, half, kr, false, 0);
    }
    __syncthreads();
}
constexpr int LC_CNT = 256, LC_BASE = 384, LC_TSTART = 512, LC_ECNT = 768, LC_REC = 1024;
struct RouteRec { int e0, e1, p0, p1; float w0, w1; int pad0, pad1; };
__device__ __forceinline__ void reduce8(const float (&a)[8], float (&out)[8], int lane) {
#define R8_DPP(x, ctrl) __builtin_bit_cast(float, __builtin_amdgcn_update_dpp(0, __builtin_bit_cast(int, x), ctrl, 0xF, 0xF, false))
    float t[4], u[2];
#pragma unroll
    for (int i = 0; i < 4; ++i) { auto r = __builtin_amdgcn_permlane32_swap(__float_as_uint(a[i]), __float_as_uint(a[i + 4]), false, false); t[i] = __uint_as_float(r[0]) + __uint_as_float(r[1]); }
#pragma unroll
    for (int i = 0; i < 2; ++i) { auto r = __builtin_amdgcn_permlane16_swap(__float_as_uint(t[i]), __float_as_uint(t[i + 2]), false, false); u[i] = __uint_as_float(r[0]) + __uint_as_float(r[1]); }
    const bool hi8 = (lane & 8) != 0;
    float keep = hi8 ? u[1] : u[0]; const float send = hi8 ? u[0] : u[1];
    keep += R8_DPP(send, 0x128);
    keep += R8_DPP(keep, 0x141); keep += R8_DPP(keep, 0xB1); keep += R8_DPP(keep, 0x4E);
#pragma unroll
    for (int k = 0; k < 8; ++k) out[k] = __builtin_bit_cast(float, __builtin_amdgcn_readlane(__builtin_bit_cast(int, keep), 8 * k));
#undef R8_DPP
}
__device__ __forceinline__ void norm2_router(Frame& F, int layer, int nrows) {
    LAS f32x4* WT = (LAS f32x4*)F.lds;
    LAS int* cnt = (LAS int*)(F.lds + LDSCTL_OFF + LC_CNT); LAS int* base = (LAS int*)(F.lds + LDSCTL_OFF + LC_BASE);
    LAS v4u* rec = (LAS v4u*)(F.lds + LDSCTL_OFF + LC_REC);
    const float* wg = F.in[I_MWG] + (size_t)layer * D * 4; const float* we = F.in[I_MWE] + (size_t)layer * 4 * D * 8;
    { f32x4 wt[18];
#pragma unroll
      for (int q = 0; q < 18; ++q) { const int pid = F.tid + NTHREADS * q; const int plane = pid >> 10, pos = pid & 1023, k = 4 * (pos & 63) + 256 * (pos >> 8) + ((pos >> 6) & 3);
          wt[q] = plane == 0 ? *(const f32x4*)(wg + k * 4) : *(const f32x4*)(we + ((size_t)((plane - 1) >> 1) * 1024 + k) * 8 + ((plane - 1) & 1) * 4); }
#pragma unroll
      for (int q = 0; q < 18; ++q) WT[F.tid + NTHREADS * q] = wt[q]; }
    if (F.tid < 32) cnt[F.tid] = 0;
    __syncthreads();
    const int rpb = nrows / F.G, rbase = blockIdx.x * rpb;
    const float* gam = F.in[I_NORMG] + (layer * 2 + 1) * D;
    unsigned char* HL2 = F.ws + WS_HL2;
    const float* bg = F.in[I_MBG] + layer * 4; const float* be = F.in[I_MBE] + layer * 32;
    typedef float f32x2 __attribute__((ext_vector_type(2)));
    int cur_mr = -1; f32x4 mA[4], mB[4]; v2u raw[2][4];
    const bf16* XLp = (const bf16*)(F.ws + WS_XL);
    if (F.wave < rpb / 2) {
#pragma unroll
        for (int q = 0; q < 2; ++q)
#pragma unroll
            for (int j = 0; j < 4; ++j) raw[q][j] = ((const v2u*)(XLp + (size_t)(rbase + 2 * F.wave + q) * D))[64 * j + F.lane]; }
    for (int pr = F.wave; pr < rpb / 2; pr += NWAVES) {
        f32x4 v[2][4];
#pragma unroll
        for (int q = 0; q < 2; ++q)
#pragma unroll
            for (int j = 0; j < 4; ++j) { const v2u w = raw[q][j]; v[q][j] = (f32x4){bflo(w.x), bfhi(w.x), bflo(w.y), bfhi(w.y)}; }
        if (pr + NWAVES < rpb / 2) {
#pragma unroll
            for (int q = 0; q < 2; ++q)
#pragma unroll
                for (int j = 0; j < 4; ++j) raw[q][j] = ((const v2u*)(XLp + (size_t)(rbase + 2 * (pr + NWAVES) + q) * D))[64 * j + F.lane]; }
#pragma unroll
        for (int q = 0; q < 2; ++q) { const int r = rbase + 2 * pr + q; const int mr = row_mod(r);
            if (mr != cur_mr) { cur_mr = mr; const float* sc = modp(F, layer, mr, 4); const float* sh = modp(F, layer, mr, 3);
#pragma unroll
                for (int j = 0; j < 4; ++j) { mA[j] = ((const f32x4*)gam)[64 * j + F.lane] * (((const f32x4*)sc)[64 * j + F.lane] + 1.0f); mB[j] = ((const f32x4*)sh)[64 * j + F.lane]; } }
            const float rstd = row_rstd(v[q]);
#pragma unroll
            for (int j = 0; j < 4; ++j) v[q][j] = (v[q][j] * rstd) * mA[j] + mB[j];
#pragma unroll
            for (int j = 0; j < 4; ++j) ((unsigned*)(HL2 + (size_t)r * D))[64 * j + F.lane] = pk4_fp8(v[q][j].x, v[q][j].y, v[q][j].z, v[q][j].w); }
        f32x2 ga2[2][2];
#pragma unroll
        for (int q = 0; q < 2; ++q) { ga2[q][0] = (f32x2){0.f, 0.f}; ga2[q][1] = (f32x2){0.f, 0.f}; }
#pragma unroll
        for (int j = 0; j < 4; ++j)
#pragma unroll
            for (int i = 0; i < 4; ++i) { const f32x4 w = WT[(4 * j + i) * 64 + F.lane];
                const f32x2 wlo = (f32x2){w.x, w.y}, whi = (f32x2){w.z, w.w};
#pragma unroll
                for (int q = 0; q < 2; ++q) { const float x = v[q][j][i]; const f32x2 xs = (f32x2){x, x};
                    ga2[q][0] = __builtin_elementwise_fma(xs, wlo, ga2[q][0]); ga2[q][1] = __builtin_elementwise_fma(xs, whi, ga2[q][1]); } }
        float ga[2][4];
#pragma unroll
        for (int q = 0; q < 2; ++q) { ga[q][0] = ga2[q][0].x; ga[q][1] = ga2[q][0].y; ga[q][2] = ga2[q][1].x; ga[q][3] = ga2[q][1].y; }
        float gsum[8];
        { float gin[8];
#pragma unroll
          for (int q = 0; q < 2; ++q)
#pragma unroll
              for (int n = 0; n < 4; ++n) gin[4 * q + n] = ga[q][n];
          reduce8(gin, gsum, F.lane); }
#pragma unroll
        for (int q = 0; q < 2; ++q) {
            float gl[4];
#pragma unroll
            for (int n = 0; n < 4; ++n) gl[n] = gsum[4 * q + n] + bg[n];
            int gs = 0; float gm = gl[0];
#pragma unroll
            for (int n = 1; n < 4; ++n) if (gl[n] > gm) { gm = gl[n]; gs = n; }
            gs = __builtin_amdgcn_readfirstlane(gs);
            float den = 0.f;
#pragma unroll
            for (int n = 0; n < 4; ++n) den += __expf(gl[n] - gm);
            const float gprob = 1.f / den;
            const LAS f32x4* wb = WT + (1 + 2 * gs) * 1024 + F.lane;
            float el[8]; f32x2 el2[4];
#pragma unroll
            for (int x = 0; x < 4; ++x) el2[x] = (f32x2){0.f, 0.f};
#pragma unroll
            for (int j = 0; j < 4; ++j)
#pragma unroll
                for (int i = 0; i < 4; ++i) { const f32x4 w0 = wb[(4 * j + i) * 64], w1 = wb[1024 + (4 * j + i) * 64];
                    const float x_ = v[q][j][i]; const f32x2 xs = (f32x2){x_, x_};
                    el2[0] = __builtin_elementwise_fma(xs, (f32x2){w0.x, w0.y}, el2[0]); el2[1] = __builtin_elementwise_fma(xs, (f32x2){w0.z, w0.w}, el2[1]);
                    el2[2] = __builtin_elementwise_fma(xs, (f32x2){w1.x, w1.y}, el2[2]); el2[3] = __builtin_elementwise_fma(xs, (f32x2){w1.z, w1.w}, el2[3]); }
#pragma unroll
            for (int x = 0; x < 4; ++x) { el[2 * x] = el2[x].x; el[2 * x + 1] = el2[x].y; }
            { float es[8]; reduce8(el, es, F.lane);
#pragma unroll
              for (int x = 0; x < 8; ++x) el[x] = es[x] + be[gs * 8 + x]; }
            int i0 = 0; float v0 = el[0];
#pragma unroll
            for (int x = 1; x < 8; ++x) if (el[x] > v0) { v0 = el[x]; i0 = x; }
            int i1 = -1; float v1 = -3.0e38f;
#pragma unroll
            for (int x = 0; x < 8; ++x) if (x != i0 && el[x] > v1) { v1 = el[x]; i1 = x; }
            const float w0 = 1.f / (1.f + __expf(v1 - v0));
            if (F.lane == 0) { const int e0 = gs * 8 + i0, e1 = gs * 8 + i1;
                const int p0 = __hip_atomic_fetch_add(&cnt[e0], 1, __ATOMIC_RELAXED, __HIP_MEMORY_SCOPE_WORKGROUP), p1 = __hip_atomic_fetch_add(&cnt[e1], 1, __ATOMIC_RELAXED, __HIP_MEMORY_SCOPE_WORKGROUP);
                rec[2 * (2 * pr + q)] = (v4u){(unsigned)e0, (unsigned)e1, (unsigned)p0, (unsigned)p1};
                rec[2 * (2 * pr + q) + 1] = (v4u){__builtin_bit_cast(unsigned, gprob * w0), __builtin_bit_cast(unsigned, gprob * (1.f - w0)), 0u, 0u}; }
        }
    }
    __syncthreads();
    unsigned* gcnt = (unsigned*)(F.ws + WS_CTL) + CW_ECNT + layer * 64;
    if (F.tid < 32) base[F.tid] = (int)__hip_atomic_fetch_add(gcnt + F.tid, (unsigned)cnt[F.tid], RLX_AGENT);
    __syncthreads();
    v4u* ROUTE = (v4u*)(F.ws + WS_ROUTE); int* SRCROW = (int*)(F.ws + WS_SRCROW);
    for (int i = F.tid; i < rpb; i += NTHREADS) { v4u a = rec[2 * i]; const v4u b2 = rec[2 * i + 1]; a.z += (unsigned)base[a.x]; a.w += (unsigned)base[a.y]; ROUTE[2 * (rbase + i)] = a; ROUTE[2 * (rbase + i) + 1] = b2;
        SRCROW[(size_t)a.x * MT + a.z] = rbase + i; SRCROW[(size_t)a.y * MT + a.w] = rbase + i; }
    __syncthreads();
}
__device__ __forceinline__ void moe_tile_starts(Frame& F, int layer) {
    LAS int* ts = (LAS int*)(F.lds + LDSCTL_OFF + LC_TSTART);
    if (F.wave == 0) {
        const unsigned* gcnt = (const unsigned*)(F.ws + WS_CTL) + CW_ECNT + layer * 64; LAS int* ec = (LAS int*)(F.lds + LDSCTL_OFF + LC_ECNT);
        const int lane = F.lane; const int cn = lane < 32 ? (int)__hip_atomic_load(gcnt + lane, RLX_AGENT) : 0; const int tiles = (cn + 255) >> 8;
        int incl = tiles;
#pragma unroll
        for (int d = 1; d < 32; d <<= 1) { const int t = __shfl_up(incl, d); if (lane >= d) incl += t; }
        if (lane < 32) { ec[lane] = cn; ts[lane] = incl - tiles; }
        if (lane == 31) ts[32] = incl; }
    __syncthreads();
}
template <bool GATHER_>
struct MoeSched {
    static constexpr bool GATHER = GATHER_;
    const LAS int* ts; int G, c; const char* A; const char* B; size_t strideA, strideBe, strideBn; const int* srcrow;
    __device__ __forceinline__ bool next(int i, pg8::Unit& u) const {
        if (!pg8::order_next(__builtin_amdgcn_readfirstlane(ts[32]), 4, G, c, i, u.pm, u.pn)) return false;
        const int lane = (int)__builtin_amdgcn_mbcnt_hi(~0u, __builtin_amdgcn_mbcnt_lo(~0u, 0u));
        const int e = __builtin_popcount((unsigned)__builtin_amdgcn_ballot_w64(ts[lane & 31] <= u.pm)) - 1;
        u.a = GATHER ? A : A + (size_t)u.pm * strideA; u.b = B + (size_t)e * strideBe + (size_t)u.pn * strideBn; u.aux = e; return true;
    }
    __device__ __forceinline__ const int* row_ptr(const pg8::Unit& u, int r) const {
        const int e = u.aux; const int p0 = (u.pm - __builtin_amdgcn_readfirstlane(ts[e])) * 256; const int cn = __builtin_amdgcn_readfirstlane(ts[64 + e]);
        const int pos = p0 + r; return srcrow + (size_t)e * MT + (pos < cn ? pos : p0);
    }
    __device__ __forceinline__ int row_of(const pg8::Unit& u, int r) const { return *row_ptr(u, r); }
    __device__ __forceinline__ void a_offsets(const pg8::Unit& u, const pg8::Gemm& g, const int (&R)[2], const int (&C)[2], unsigned (&v)[2][2]) const {
        if (GATHER) {
            int row[2][2];
#pragma unroll
            for (int h = 0; h < 2; ++h)
#pragma unroll
                for (int i = 0; i < 2; ++i) row[h][i] = row_of(u, h * 128 + R[i]);
#pragma unroll
            for (int h = 0; h < 2; ++h)
#pragma unroll
                for (int i = 0; i < 2; ++i) v[h][i] = (unsigned)(row[h][i] * g.lda + C[i]);
        } else {
#pragma unroll
            for (int h = 0; h < 2; ++h)
#pragma unroll
                for (int i = 0; i < 2; ++i) v[h][i] = (unsigned)((h * 128 + R[i]) * g.lda + C[i]);
        }
    }
};
static_assert(LC_ECNT - LC_TSTART == 256, "MoeSched reads the expert counts at ts[64 + e]");
struct EpiSwiglu {
    static constexpr bool PERM = true;
    unsigned char* O;
    __device__ __forceinline__ void operator()(const f32x4 (&acc)[2][2][4][2], const pg8::Unit& u, int wr, int wc, int fr, int fq) const {
        const int row0 = u.pm * 256 + wr * 64 + fr, col0 = u.pn * 128 + wc * 32 + 8 * fq;
#pragma unroll
        for (int ai = 0; ai < 2; ++ai)
#pragma unroll
            for (int m = 0; m < 4; ++m) {
                f32x4 h0, h1;
#pragma unroll
                for (int j = 0; j < 4; ++j) { const float a = acc[ai][0][m][0][j], b = acc[ai][0][m][1][j]; h0[j] = a * __builtin_amdgcn_rcpf(1.f + __expf(-a)) * acc[ai][1][m][0][j]; h1[j] = b * __builtin_amdgcn_rcpf(1.f + __expf(-b)) * acc[ai][1][m][1][j]; }
                v2u w; w.x = pk4_fp8(h0.x, h0.y, h0.z, h0.w); w.y = pk4_fp8(h1.x, h1.y, h1.z, h1.w);
                *(v2u*)(O + (size_t)(row0 + ai * 128 + m * 16) * EFF + col0) = w;
            }
    }
};
__device__ __forceinline__ void moe_gemm1(Frame& F, int layer) {
    moe_tile_starts(F, layer);
    const pg8::Gemm g{8, D, D};
    MoeSched<true> S{(const LAS int*)(F.lds + LDSCTL_OFF + LC_TSTART), F.G, (int)blockIdx.x, (const char*)(F.ws + WS_HL2), (const char*)(F.ws + WS_W13), 0, (size_t)1024 * 1024, (size_t)256 * D, (const int*)(F.ws + WS_SRCROW)};
    EpiSwiglu E{F.ws + WS_HDN};
    pg8::gemm_phase<EpiSwiglu, MoeSched<true>, true>(F.lds, g, S, E, F.wave);
}
__device__ __forceinline__ void moe_gemm2(Frame& F, int layer) {
    moe_tile_starts(F, layer);
    const pg8::Gemm g{4, EFF, EFF};
    MoeSched<false> S{(const LAS int*)(F.lds + LDSCTL_OFF + LC_TSTART), F.G, (int)blockIdx.x, (const char*)(F.ws + WS_HDN), (const char*)(F.ws + WS_W2), (size_t)256 * EFF, (size_t)1024 * 512, (size_t)256 * EFF, nullptr};
    EpiF8 E{F.ws + WS_XS, D};
    pg8::gemm_phase<EpiF8, MoeSched<false>, true>(F.lds, g, S, E, F.wave);
}
template <int MODE>
__device__ __forceinline__ void moe_combine(Frame& F, int layer, int nrows) {
    moe_tile_starts(F, layer);
    const LAS int* ts = (const LAS int*)(F.lds + LDSCTL_OFF + LC_TSTART);
    const int gw = F.vcu * NWAVES + F.wave, NGW = F.G * NWAVES;
    const RouteRec* ROUTE = (const RouteRec*)(F.ws + WS_ROUTE); const unsigned char* YS = F.ws + WS_XS;
    bf16* HL = (bf16*)(F.ws + WS_A);
    for (int r0 = gw * 2; r0 < nrows; r0 += NGW * 2) {
        RouteRec rr[2]; f32x4 v[2][4]; unsigned ya[2][4], yb[2][4];
#pragma unroll
        for (int q = 0; q < 2; ++q) { rr[q] = ROUTE[r0 + q]; load_row_bf16((const bf16*)(F.ws + WS_XL) + (size_t)(r0 + q) * D, F.lane, v[q]); }
#pragma unroll
        for (int q = 0; q < 2; ++q) { const int p0 = rr[q].p0 + ts[rr[q].e0] * 256, p1 = rr[q].p1 + ts[rr[q].e1] * 256;
#pragma unroll
            for (int j = 0; j < 4; ++j) { ya[q][j] = ((const unsigned*)(YS + (size_t)p0 * D))[64 * j + F.lane]; yb[q][j] = ((const unsigned*)(YS + (size_t)p1 * D))[64 * j + F.lane]; } }
#pragma unroll
        for (int q = 0; q < 2; ++q) { const int r = r0 + q;
            bf16* xp = (bf16*)(F.ws + WS_XL) + (size_t)r * D;
            const int mr = row_mod(r); const float* gt = modp(F, layer, mr, 5);
#pragma unroll
            for (int j = 0; j < 4; ++j) { const f32x2 a0 = __builtin_amdgcn_cvt_pk_f32_fp8((int)ya[q][j], false), a1 = __builtin_amdgcn_cvt_pk_f32_fp8((int)ya[q][j], true);
                const f32x2 b0 = __builtin_amdgcn_cvt_pk_f32_fp8((int)yb[q][j], false), b1 = __builtin_amdgcn_cvt_pk_f32_fp8((int)yb[q][j], true);
                const f32x4 fa = (f32x4){a0.x, a0.y, a1.x, a1.y}, fb = (f32x4){b0.x, b0.y, b1.x, b1.y};
                v[q][j] = v[q][j] + ((const f32x4*)gt)[64 * j + F.lane] * (fa * rr[q].w0 + fb * rr[q].w1); }
            if (MODE == 0) {
                store_row_bf16(xp, F.lane, v[q]);
                norm_mod(v[q], F.lane, F.in[I_NORMG] + 2 * D, modp(F, 1, mr, 0), modp(F, 1, mr, 1));
                store_row_bf16(HL + (size_t)r * D, F.lane, v[q]);
            } else {
                const float rstd = row_rstd(v[q]);
#pragma unroll
                for (int j = 0; j < 4; ++j) v[q][j] = (v[q][j] * rstd) * ((const f32x4*)F.in[I_FINALG])[64 * j + F.lane];
                store_row_f32(F.out + (size_t)r * D, F.lane, v[q]);
            }
            asm volatile("" ::: "memory");
        }
    }
}

__global__ void __launch_bounds__(NTHREADS, 2) fwd_kernel(Args args) {
    extern __shared__ __attribute__((aligned(16))) unsigned char lds[];
    Frame F;
    F.lds = (LAS unsigned char*)lds;
    F.tid = threadIdx.x; F.lane = F.tid & 63; F.wave = __builtin_amdgcn_readfirstlane(F.tid >> 6);
    F.G = gridDim.x; { const int bx = blockIdx.x; F.vcu = (F.G % 8 == 0) ? (bx % 8) * (F.G / 8) + bx / 8 : bx; }
    F.in = (const float* const __attribute__((address_space(4)))*)__builtin_amdgcn_kernarg_segment_ptr(); F.out = args.out; F.ws = args.ws;
    static_assert(offsetof(Args, in) == 0 && offsetof(Args, out) == N_IN * 8 && offsetof(Args, ws) == N_IN * 8 + 8, "kernarg table: inputs, out, ws");
    unsigned* ctl = (unsigned*)(F.ws + WS_CTL);
    for (int u = F.tid; u < (LDS_BYTES - LDSCTL_OFF) / 4; u += NTHREADS) ((LAS unsigned*)(F.lds + LDSCTL_OFF))[u] = 0u;
    __syncthreads();
    XcdBarrier bar = xcd_barrier_post(ctl + CW_BAR, (volatile LAS unsigned*)(F.lds + LDSCTL_OFF + 64));
    const int lo = args.ph_lo, hi = args.ph_hi;
#define PH_BEGIN(k) { constexpr int k_ = (k); { asm volatile("" : "+s"(F.in));  F.out = (float*)F.in[N_IN]; F.ws = (unsigned char*)F.in[N_IN + 1]; if (lo <= k_ && k_ < hi)
#define PH_END } if (lo <= k_ && k_ + 1 < hi) xcd_barrier(bar); }

    PH_BEGIN(0) { p0_mod(F); __syncthreads(); p0_small_weights(F); conv_moe_weights(F, 0, MOE_CONV_SIDE0 + F.vcu * NWAVES + F.wave, F.G * NWAVES, MOE_CONV_TAIL0); }
    PH_END
    PH_BEGIN(1) { p1_norm0(F); }
    PH_END
    PH_BEGIN(2) {
        const pg8::Gemm g{16, 2 * D, 2 * D};
        if ((int)blockIdx.x < GEMM_G) {
        { DenseSched S{136, 8, GEMM_G, (int)blockIdx.x, (const char*)(F.ws + WS_A), (const char*)(F.ws + WS_WQK), (size_t)256 * D * 2, (size_t)256 * D * 2};
          EpiBf16<0> E{(bf16*)(F.ws + WS_B), 2048, F.in[I_BQKV], 4, 0.125f * LOG2E};
          pg8::gemm_phase(F.lds, g, S, E, F.wave); }
        { DenseSched S{4, 136, GEMM_G, GEMM_G - 1 - (int)blockIdx.x, (const char*)(F.ws + WS_WV), (const char*)(F.ws + WS_A), (size_t)256 * D * 2, (size_t)256 * D * 2};
          EpiBf16RowBias E{(bf16*)(F.ws + WS_C), MT, F.in[I_BQKV] + 2 * D};
          pg8::gemm_phase(F.lds, g, S, E, F.wave); }
        } else conv_moe_weights(F, 0, ((int)blockIdx.x - GEMM_G) * NWAVES + F.wave, (F.G - GEMM_G) * NWAVES, MOE_CONV_SIDE0);
    }
    PH_END
    PH_BEGIN(3) { attn_phase(F); }
    PH_END
    PH_BEGIN(4) {
        const pg8::Gemm g{8, D, D};
        DenseSched S{136, 4, F.G, (int)blockIdx.x, (const char*)(F.ws + WS_A), (const char*)(F.ws + WS_WO), (size_t)256 * D, (size_t)256 * D};
        EpiResid<false> E{F.in[I_X], F.in[I_CTX], (bf16*)(F.ws + WS_XL), F.in[I_NABO], modp(F, 0, 0, 2)};
        pg8::gemm_phase<EpiResid<false>, DenseSched, true>(F.lds, g, S, E, F.wave);
        if ((int)blockIdx.x >= 32)
            conv_moe_weights(F, 0, MOE_CONV_TAIL0 + ((int)blockIdx.x - 32) * NWAVES + F.wave, (F.G - 32) * NWAVES, MOE_CONV_ITEMS);
    }
    PH_END
    PH_BEGIN(5) { norm2_router(F, 0, MT); }
    PH_END
    PH_BEGIN(6) { moe_gemm1(F, 0); }
    PH_END
    PH_BEGIN(7) { moe_gemm2(F, 0); }
    PH_END
    PH_BEGIN(8) { moe_combine<0>(F, 0, MT); conv_moe_weights(F, 1, MOE_CONV_SIDE1 + F.vcu * NWAVES + F.wave, F.G * NWAVES, MOE_CONV_TAIL1); }
    PH_END
    PH_BEGIN(9) {
        const pg8::Gemm g{16, 2 * D, 2 * D};
        if ((int)blockIdx.x < GEMM_G) {
        { DenseSched S{128, 4, GEMM_G, (int)blockIdx.x, (const char*)(F.ws + WS_A), (const char*)(F.ws + WS_WIN), (size_t)256 * D * 2, (size_t)256 * D * 2};
          EpiBf16<1> E{(bf16*)(F.ws + WS_G), D, F.in[I_LBIN], 0, 1.f};
          pg8::gemm_phase(F.lds, g, S, E, F.wave); }
        { DenseSched S{136, 4, GEMM_G, GEMM_G - 1 - (int)blockIdx.x, (const char*)(F.ws + WS_A), (const char*)(F.ws + WS_WIN) + (size_t)D * D * 2, (size_t)256 * D * 2, (size_t)256 * D * 2};
          EpiBf16<0> E{(bf16*)(F.ws + WS_UPRE), D, F.in[I_LBIN] + D, 0, 1.f};
          pg8::gemm_phase(F.lds, g, S, E, F.wave); }
          if ((int)blockIdx.x >= 32 && (int)blockIdx.x < 176)
              conv_moe_weights(F, 1, MOE_CONV_TAIL1 + ((int)blockIdx.x - 32) * NWAVES + F.wave, 144 * NWAVES, MOE_CONV_ITEMS);
        } else conv_moe_weights(F, 1, ((int)blockIdx.x - GEMM_G) * NWAVES + F.wave, (F.G - GEMM_G) * NWAVES, MOE_CONV_SIDE1);
    }
    PH_END
    PH_BEGIN(10) { conv_phase(F); }
    PH_END
    PH_BEGIN(11) { scan_sweep<0>(F); asm volatile("s_waitcnt vmcnt(0)" ::: "memory"); __syncthreads(); scan_sweep<1>(F); }
    PH_END
    PH_BEGIN(12) {
        const pg8::Gemm g{16, 2 * D, 2 * D};
        DenseSched S{128, 4, F.G, (int)blockIdx.x, (const char*)(F.ws + WS_GH), (const char*)(F.ws + WS_WLO), (size_t)256 * D * 2, (size_t)256 * D * 2};
        EpiResid<true> E{nullptr, nullptr, (bf16*)(F.ws + WS_XL), F.in[I_LBO], modp(F, 1, 0, 2)};
        pg8::gemm_phase(F.lds, g, S, E, F.wave);
    }
    PH_END
    PH_BEGIN(13) { norm2_router(F, 1, NL); }
    PH_END
    PH_BEGIN(14) { moe_gemm1(F, 1); }
    PH_END
    PH_BEGIN(15) { moe_gemm2(F, 1); }
    PH_END
    PH_BEGIN(16) { moe_combine<1>(F, 1, NL); }
    PH_END
#undef PH_BEGIN
#undef PH_END
}

__global__ void diag_fill(float* out, float v, int n) { for (int i = blockIdx.x * blockDim.x + threadIdx.x; i < n; i += gridDim.x * blockDim.x) out[i] = v; }
extern "C" void kernel_launch(void* const* d_in, const int* in_sizes, int n_in, void* d_out, int out_size, void* d_ws, size_t ws_size, hipStream_t stream) {
    static int grid = 0; static float diag = 0.f;
    if (grid == 0) {
        if (n_in != N_IN || out_size != NL * D || ws_size < WS_END) { fprintf(stderr, "kernel_launch: unexpected shapes: n_in %d out %d ws %zu (need %zu)\n", n_in, out_size, ws_size, (size_t)WS_END); grid = -1; diag = 2.f; }
        else {
        int dev = 0, cus = 0, per_cu = 0;
        if (hipGetDevice(&dev) != hipSuccess || hipDeviceGetAttribute(&cus, hipDeviceAttributeMultiprocessorCount, dev) != hipSuccess) { grid = -1; diag = 3.f; }
        else if (hipFuncSetAttribute((const void*)fwd_kernel, hipFuncAttributeMaxDynamicSharedMemorySize, LDS_BYTES) != hipSuccess) { fprintf(stderr, "kernel_launch: hipFuncSetAttribute failed\n"); grid = -1; diag = 4.f; }
        else if (hipOccupancyMaxActiveBlocksPerMultiprocessor(&per_cu, (const void*)fwd_kernel, NTHREADS, LDS_BYTES) != hipSuccess || per_cu < 1) { fprintf(stderr, "kernel_launch: occupancy query says %d blocks/CU\n", per_cu); (void)hipGetLastError(); grid = -1; diag = 5.f; }
        else if (cus != 256) { fprintf(stderr, "kernel_launch: built for 256 CUs, device has %d\n", cus); grid = -1; diag = 7.f; }
        else grid = cus;
        }
    }
    if (grid < 0) { diag_fill<<<256, 256, 0, stream>>>((float*)d_out, diag, out_size); return; }
    if (hipMemsetAsync((char*)d_ws + WS_CTL, 0, CTL_ZERO_BYTES, stream) != hipSuccess) { fprintf(stderr, "kernel_launch: memset failed\n"); return; }
    Args a{};
    for (int i = 0; i < N_IN; ++i) a.in[i] = (const float*)d_in[i];
    a.out = (float*)d_out; a.ws = (unsigned char*)d_ws; a.ph_lo = 0; a.ph_hi = 1000;
    void* kargs[] = {&a};
    hipError_t e = hipLaunchCooperativeKernel((const void*)fwd_kernel, dim3(grid), dim3(NTHREADS), kargs, LDS_BYTES, stream);
    if (e != hipSuccess) { fprintf(stderr, "kernel_launch: cooperative launch failed: %s (grid %d)\n", hipGetErrorString(e), grid); (void)hipGetLastError(); diag_fill<<<256, 256, 0, stream>>>((float*)d_out, 6.f, out_size); }
}
```

```cpp
#include <hip/hip_runtime.h>
#include <cstdio>
#include <cstdint>
#include <cstddef>

#define GAS __attribute__((address_space(1)))
#define LAS __attribute__((address_space(3)))
typedef unsigned short bf16;
typedef unsigned v4u __attribute__((ext_vector_type(4)));
typedef unsigned v2u __attribute__((ext_vector_type(2)));
typedef float f32x4 __attribute__((ext_vector_type(4)));
typedef float f32x2 __attribute__((ext_vector_type(2)));
typedef short bf16x8 __attribute__((ext_vector_type(8)));

constexpr int D = 1024, BATCH = 8, SEQ = 4096, CTXL = 256, GRIDW = 64;
constexpr int NL = BATCH * SEQ;
constexpr int NC = BATCH * CTXL;
constexpr int MT = NL + NC;
constexpr int NMOD = 6, NHEAD = 16, HD = 64;
constexpr int NEXP = 32, EFF = 512;
constexpr float EPS = 1e-6f;
constexpr int NWAVES = 8, NTHREADS = 512;

enum { I_X = 0, I_C, I_CTX, I_CCTX, I_ADAW, I_ADAB, I_NORMG, I_WQKV, I_BQKV, I_RPB, I_NAWO, I_NABO, I_LWIN, I_LBIN, I_CONVW, I_CONVB, I_WGATE, I_BGATE,
       I_LAMBDA, I_LWO, I_LBO, I_MWG, I_MBG, I_MWE, I_MBE, I_MW1, I_MW3, I_MW2, I_FINALG, N_IN };

constexpr size_t MiB = 1u << 20;
constexpr size_t WS_CTL = 0, CTL_ZERO_BYTES = 1 * MiB;
constexpr size_t WS_MOD = 1 * MiB;
constexpr size_t WS_WQK = 2 * MiB;
constexpr size_t WS_WV = 6 * MiB;
constexpr size_t WS_WO = 8 * MiB;
constexpr size_t WS_WIN = 10 * MiB;
constexpr size_t WS_WG = 14 * MiB;
constexpr size_t WS_WLO = 16 * MiB;
constexpr size_t WS_SRCROW = 18 * MiB;
constexpr size_t WS_W13 = 32 * MiB;
constexpr size_t WS_W2 = 112 * MiB;
constexpr size_t WS_XL = 428 * MiB;
constexpr size_t WS_ROUTE = 136 * MiB;
constexpr size_t WS_A = 140 * MiB;
constexpr size_t WS_B = 208 * MiB;
constexpr size_t WS_C = 344 * MiB;
constexpr size_t WS_HL2 = 208 * MiB;
constexpr size_t WS_XS = 276 * MiB;
constexpr size_t WS_HDN = 64 * MiB;
constexpr size_t WS_END = 504 * MiB;
constexpr int CW_BAR = 4096;
constexpr int CW_ECNT = 16384;

constexpr int RING_BYTES = 131072;
constexpr int RTAB_BYTES = 36 * 1024 * 4;
constexpr int LDSCTL_OFF = RTAB_BYTES;
constexpr int LDS_BYTES = 163840;

#define RLX_AGENT __ATOMIC_RELAXED, __HIP_MEMORY_SCOPE_AGENT
#define LDS_WAIT() asm volatile("s_waitcnt lgkmcnt(0)" ::: "memory")
#define VM_WAIT() asm volatile("s_waitcnt vmcnt(0)" ::: "memory")
__device__ __forceinline__ unsigned f2bf(float f) { unsigned u = __builtin_bit_cast(unsigned, f); return (u + 0x7fffu + ((u >> 16) & 1u)) >> 16; }
__device__ __forceinline__ unsigned pk2(float lo, float hi) { return f2bf(lo) | (f2bf(hi) << 16); }
__device__ __forceinline__ float bf2f(unsigned short h) { return __builtin_bit_cast(float, (unsigned)h << 16); }
__device__ __forceinline__ float bflo(unsigned w) { return __builtin_bit_cast(float, w << 16); }
__device__ __forceinline__ float bfhi(unsigned w) { return __builtin_bit_cast(float, w & 0xffff0000u); }
__device__ __forceinline__ float wave_sum(float v) {
#define WS_DPP(x, ctrl, rmask) __builtin_bit_cast(float, __builtin_amdgcn_update_dpp(0, __builtin_bit_cast(int, x), ctrl, rmask, 0xF, false))
    v += WS_DPP(v, 0xB1, 0xF); v += WS_DPP(v, 0x4E, 0xF); v += WS_DPP(v, 0x124, 0xF); v += WS_DPP(v, 0x128, 0xF);
    v += WS_DPP(v, 0x142, 0xA); v += WS_DPP(v, 0x143, 0xC);
#undef WS_DPP
    return __builtin_bit_cast(float, __builtin_amdgcn_readlane(__builtin_bit_cast(int, v), 63));
}

#define XB_TMO      128
#define XB_XCNT(j)  (256  + 64 * (j))
#define XB_XSUB(j)  (1280 + 64 * (j))
#define XB_XGEN(j)  (2304 + 64 * (j))
#define XB_TOP      3328
#define XB_TOPGEN   3392
#define XCD_BAR_WORDS 3456
#define XB_SPIN_CAP (1u << 20)
__device__ __forceinline__ unsigned xb_ld(unsigned* p)              { return __hip_atomic_load(p, __ATOMIC_RELAXED, __HIP_MEMORY_SCOPE_AGENT); }
__device__ __forceinline__ unsigned xb_add(unsigned* p, unsigned v) { return __hip_atomic_fetch_add(p, v, __ATOMIC_RELAXED, __HIP_MEMORY_SCOPE_AGENT); }
__device__ __forceinline__ unsigned xb_xcc_id() { return (unsigned)__builtin_amdgcn_s_getreg((3 << 11) | 20) & 0xFu; }
#define XB_SPIN(cond, bar) do { unsigned _sp = 0; while (cond) { __builtin_amdgcn_s_sleep(1); \
    if ((++_sp & 255u) == 0u) { if (xb_ld(&(bar)[XB_TMO])) break; if (_sp > XB_SPIN_CAP) { atomicAdd(&(bar)[XB_TMO], 1u); break; } } } } while (0)
struct XcdBarrier { unsigned* bar; unsigned x; volatile LAS unsigned* st; };
__device__ __forceinline__ XcdBarrier xcd_barrier_post(unsigned* bar, volatile LAS unsigned* st) {
    XcdBarrier b; b.bar = bar; b.x = xb_xcc_id(); b.st = st;
    if (threadIdx.x == 0) (void)xb_add(&bar[XB_XCNT(b.x)], 1u);
    return b;
}
__device__ __forceinline__ void xcd_barrier_complete(unsigned* bar, unsigned x, unsigned& nloc, unsigned& nx) {
    const unsigned G = gridDim.x * gridDim.y * gridDim.z;
    unsigned sum, cnt, mine, sp = 0u;
    for (;;) {
        sum = 0u; cnt = 0u; mine = 0u;
#pragma unroll
        for (unsigned j = 0; j < 16; ++j) { const unsigned c = xb_ld(&bar[XB_XCNT(j)]); sum += c; cnt += (c > 0u) ? 1u : 0u; mine = (j == x) ? c : mine; }
        if (sum == G) break;
        __builtin_amdgcn_s_sleep(1);
        if ((++sp & 255u) == 0u) { if (xb_ld(&bar[XB_TMO])) break; if (sp > XB_SPIN_CAP) { atomicAdd(&bar[XB_TMO], 1u); break; } }
    }
    nloc = mine > 0u ? mine : 1u; nx = cnt > 0u ? cnt : 1u;
}
__device__ __forceinline__ void xcd_barrier(const XcdBarrier& b) {
    asm volatile("s_waitcnt vmcnt(0)" ::: "memory");
    __syncthreads();
    if (threadIdx.x == 0) {
        unsigned* bar = b.bar;
        __builtin_amdgcn_s_waitcnt(0);
        unsigned nloc = b.st[0], nx = b.st[1];
        if (nloc == 0u) { xcd_barrier_complete(bar, b.x, nloc, nx); b.st[0] = nloc; b.st[1] = nx; }
        const unsigned old = xb_add(&bar[XB_XSUB(b.x)], 1u);
        const unsigned gen = old / nloc;
        if (old + 1u == (gen + 1u) * nloc) {
            __builtin_amdgcn_fence(__ATOMIC_RELEASE, "agent");
            asm volatile("s_waitcnt vmcnt(0)" ::: "memory");
            const unsigned og = xb_add(&bar[XB_TOP], 1u);
            const unsigned tg = og / nx;
            if (og + 1u == (tg + 1u) * nx) xb_add(&bar[XB_TOPGEN], 1u);
            else XB_SPIN(xb_ld(&bar[XB_TOPGEN]) == tg, bar);
            __builtin_amdgcn_fence(__ATOMIC_ACQUIRE, "agent");
            xb_add(&bar[XB_XGEN(b.x)], 1u);
            asm volatile("s_waitcnt vmcnt(0)" ::: "memory");
        } else {
            XB_SPIN(xb_ld(&bar[XB_XGEN(b.x)]) == gen, bar);
            __builtin_amdgcn_fence(__ATOMIC_ACQUIRE, "agent");
            asm volatile("s_waitcnt vmcnt(0)" ::: "memory");
        }
    }
    __syncthreads();
}

struct Args { const float* in[N_IN]; float* out; unsigned char* ws; int ph_lo, ph_hi; };
struct Frame {
    LAS unsigned char* lds;
    int tid, lane, wave, vcu, G;
    const float* const __attribute__((address_space(4)))* in;
    float* out; unsigned char* ws;
};
__device__ __forceinline__ const float* row_x_in(const Frame& F, int r) {
    return r < NL ? F.in[I_X] + (size_t)r * D : F.in[I_CTX] + (size_t)(r - NL) * D;
}
__device__ __forceinline__ int row_mod(int r) { return r < NL ? (r >> 12) : 8; }
__device__ __forceinline__ const float* modp(const Frame& F, int layer, int mrow, int which) {
    return (const float*)(F.ws + WS_MOD) + ((size_t)(layer * 9 + mrow) * NMOD + which) * D;
}

__device__ __forceinline__ float silu_f(float v) { return v * __builtin_amdgcn_rcpf(1.f + __expf(-v)); }
__device__ __forceinline__ void p0_mod(Frame& F) {
    LAS float* S = (LAS float*)F.lds;
    LAS float* P = (LAS float*)(F.lds + 9 * 1024 * 4);
    for (int it = blockIdx.x; it < 192; it += F.G) {
        const int layer = it / 96, n0 = (it % 96) * 64;
        { float sv[18];
#pragma unroll
          for (int q = 0; q < 18; ++q) { const int e = F.tid + NTHREADS * q; const int m = e >> 10, k = e & 1023; sv[q] = m < 8 ? F.in[I_C][m * D + k] : F.in[I_CCTX][k]; }
#pragma unroll
          for (int q = 0; q < 18; ++q) S[F.tid + NTHREADS * q] = silu_f(sv[q]); }
        __syncthreads();
        const float* W = F.in[I_ADAW] + (size_t)layer * D * (NMOD * D) + n0 + F.lane;
        float acc[9];
#pragma unroll
        for (int m = 0; m < 9; ++m) acc[m] = 0.f;
        const int kb = F.wave * 128;
#pragma unroll 16
        for (int k = 0; k < 128; ++k) { const float w = W[(size_t)(kb + k) * (NMOD * D)];
#pragma unroll
            for (int m = 0; m < 9; ++m) acc[m] += S[m * 1024 + kb + k] * w; }
#pragma unroll
        for (int m = 0; m < 9; ++m) P[(F.wave * 9 + m) * 64 + F.lane] = acc[m];
        __syncthreads();
        for (int e = F.tid; e < 9 * 64; e += NTHREADS) { const int m = e >> 6, n = e & 63; float s = F.in[I_ADAB][layer * (NMOD * D) + n0 + n];
#pragma unroll
            for (int w = 0; w < 8; ++w) s += P[(w * 9 + m) * 64 + n];
            ((float*)(F.ws + WS_MOD))[(size_t)(layer * 9 + m) * (NMOD * D) + n0 + n] = s; }
        __syncthreads();
    }
}
__device__ __forceinline__ void transpose_item(const float* W, int ldw, int k0, int n0, bf16* dst, int dld, int drow0, LAS float* scr, int lane) {
    const int lq = lane >> 4, ln = 4 * (lane & 15);
    f32x4 v[16];
#pragma unroll
    for (int i = 0; i < 16; ++i) v[i] = *(const f32x4*)(W + (size_t)(k0 + lq + 4 * i) * ldw + n0 + ln);
#pragma unroll
    for (int i = 0; i < 16; ++i) { LAS float* q = scr + (lq + 4 * i) * 65 + ln; q[0] = v[i].x; q[1] = v[i].y; q[2] = v[i].z; q[3] = v[i].w; }
    LDS_WAIT(); asm volatile("" ::: "memory");
    const int c = lane & 7;
#pragma unroll
    for (int j = 0; j < 8; ++j) { const int n = (lane >> 3) + 8 * j; const LAS float* q = scr + (8 * c) * 65 + n;
        v4u o; o.x = pk2(q[0 * 65], q[1 * 65]); o.y = pk2(q[2 * 65], q[3 * 65]); o.z = pk2(q[4 * 65], q[5 * 65]); o.w = pk2(q[6 * 65], q[7 * 65]);
        *(v4u*)(dst + (size_t)(drow0 + n) * dld + k0 + 8 * c) = o; }
    LDS_WAIT(); asm volatile("" ::: "memory");
}
constexpr int TR_SCR = 64 * 65 * 4;
__device__ __forceinline__ unsigned pk4_fp8(float a, float b, float c, float d) { int w = __builtin_amdgcn_cvt_pk_fp8_f32(a, b, 0, false); w = __builtin_amdgcn_cvt_pk_fp8_f32(c, d, w, true); return (unsigned)w; }
__device__ __forceinline__ void transpose_item_f8(const float* W, int ldw, int k0, int n0, unsigned char* dst, int dld, int drow0, LAS float* scr, int lane, float wsc = 64.f) {
    const int lq = lane >> 4, ln = 4 * (lane & 15);
    f32x4 v[16];
#pragma unroll
    for (int i = 0; i < 16; ++i) v[i] = *(const f32x4*)(W + (size_t)(k0 + lq + 4 * i) * ldw + n0 + ln);
#pragma unroll
    for (int i = 0; i < 16; ++i) { LAS float* q = scr + (lq + 4 * i) * 65 + ln; q[0] = v[i].x; q[1] = v[i].y; q[2] = v[i].z; q[3] = v[i].w; }
    LDS_WAIT(); asm volatile("" ::: "memory");
    const int c = lane & 3;
#pragma unroll
    for (int j = 0; j < 4; ++j) { const int n = (lane >> 2) + 16 * j; const LAS float* q = scr + (16 * c) * 65 + n;
        v4u o;
        o.x = pk4_fp8(wsc * q[0 * 65], wsc * q[1 * 65], wsc * q[2 * 65], wsc * q[3 * 65]); o.y = pk4_fp8(wsc * q[4 * 65], wsc * q[5 * 65], wsc * q[6 * 65], wsc * q[7 * 65]);
        o.z = pk4_fp8(wsc * q[8 * 65], wsc * q[9 * 65], wsc * q[10 * 65], wsc * q[11 * 65]); o.w = pk4_fp8(wsc * q[12 * 65], wsc * q[13 * 65], wsc * q[14 * 65], wsc * q[15 * 65]);
        *(v4u*)(dst + (size_t)(drow0 + n) * dld + k0 + 16 * c) = o; }
    LDS_WAIT(); asm volatile("" ::: "memory");
}
__device__ __forceinline__ void p0_small_weights(Frame& F) {
    LAS float* scr = (LAS float*)(F.lds + F.wave * TR_SCR);
    const int gw = F.vcu * NWAVES + F.wave, NGW = F.G * NWAVES;
    constexpr int I_QK = 16 * 32, I_V = 16 * 16, I_O = 16 * 16, I_IN = 16 * 32, I_G = 16 * 16, I_LO = 16 * 16;
    constexpr int NIT = I_QK + I_V + I_O + I_IN + I_G + I_LO;
    for (int it = gw; it < NIT; it += NGW) {
        int r = it;
        if (r < I_QK) { transpose_item(F.in[I_WQKV], 3 * D, (r / 32) * 64, (r % 32) * 64, (bf16*)(F.ws + WS_WQK), D, (r % 32) * 64, scr, F.lane); continue; } r -= I_QK;
        if (r < I_V) { transpose_item(F.in[I_WQKV], 3 * D, (r / 16) * 64, 2 * D + (r % 16) * 64, (bf16*)(F.ws + WS_WV), D, (r % 16) * 64, scr, F.lane); continue; } r -= I_V;
        if (r < I_O) { transpose_item_f8(F.in[I_NAWO], D, (r / 16) * 64, (r % 16) * 64, F.ws + WS_WO, D, (r % 16) * 64, scr, F.lane); continue; } r -= I_O;
        if (r < I_IN) { transpose_item(F.in[I_LWIN], 2 * D, (r / 32) * 64, (r % 32) * 64, (bf16*)(F.ws + WS_WIN), D, (r % 32) * 64, scr, F.lane); continue; } r -= I_IN;
        if (r < I_G) { const int mat = r / 16, q = r % 16; transpose_item_f8(F.in[I_WGATE] + (size_t)mat * 65536, 256, (q / 4) * 64, (q % 4) * 64, F.ws + WS_WG + (size_t)mat * 65536, 256, (q % 4) * 64, scr, F.lane, 16.f); continue; } r -= I_G;
        transpose_item(F.in[I_LWO], D, (r / 16) * 64, (r % 16) * 64, (bf16*)(F.ws + WS_WLO), D, (r % 16) * 64, scr, F.lane);
    }
}
constexpr int MOE_CONV_ITEMS = 3 * NEXP * 128;
constexpr int MOE_CONV_SIDE0 = 4096, MOE_CONV_SIDE1 = 3072, GEMM_G = 240;
constexpr int MOE_CONV_TAIL0 = 12288 - 224 * 24, MOE_CONV_TAIL1 = 12288 - 144 * 24;
struct ConvItem { const float* W; int ldw, k0, n0; unsigned char* dst; int dld, drow0; };
__device__ __forceinline__ ConvItem moe_conv_item(Frame& F, int layer, int it) {
    constexpr int I_1 = NEXP * 16 * 8;
    ConvItem c; int r = it;
    if (r < 2 * I_1) { const int which = r / I_1; r %= I_1; const int e = r / 128, q = r % 128, kb = q / 8, nb = q % 8, n0 = nb * 64;
        c.W = F.in[which ? I_MW3 : I_MW1] + ((size_t)layer * NEXP + e) * (size_t)(D * EFF); c.ldw = EFF; c.k0 = kb * 64; c.n0 = n0;
        c.dst = F.ws + WS_W13 + (size_t)e * (1024 * 1024); c.dld = D; c.drow0 = (n0 / 128) * 256 + which * 128 + (n0 % 128); }
    else { r -= 2 * I_1; const int e = r / 128, q = r % 128, kb = q / 16, nb = q % 16;
        c.W = F.in[I_MW2] + ((size_t)layer * NEXP + e) * (size_t)(EFF * D); c.ldw = D; c.k0 = kb * 64; c.n0 = nb * 64;
        c.dst = F.ws + WS_W2 + (size_t)e * (1024 * 512); c.dld = EFF; c.drow0 = nb * 64; }
    return c;
}
__device__ __forceinline__ void conv_load(const ConvItem& c, int lane, f32x4 (&v)[16]) {
    const int lq = lane >> 4, ln = 4 * (lane & 15);
#pragma unroll
    for (int i = 0; i < 16; ++i) v[i] = *(const f32x4*)(c.W + (size_t)(c.k0 + lq + 4 * i) * c.ldw + c.n0 + ln);
}
__device__ __forceinline__ void conv_moe_weights(Frame& F, int layer, int first, int stride, int end) {
    LAS float* scr = (LAS float*)(F.lds + F.wave * TR_SCR);
    const int lane = F.lane, lq = lane >> 4, ln = 4 * (lane & 15), c4 = lane & 3;
    if (first >= end) return;
    ConvItem cur = moe_conv_item(F, layer, first); f32x4 v[16]; conv_load(cur, lane, v);
    for (int it = first; it < end; it += stride) {
#pragma unroll
        for (int i = 0; i < 16; ++i) { LAS float* q = scr + (lq + 4 * i) * 65 + ln; q[0] = v[i].x; q[1] = v[i].y; q[2] = v[i].z; q[3] = v[i].w; }
        const ConvItem me = cur;
        if (it + stride < end) { cur = moe_conv_item(F, layer, it + stride); conv_load(cur, lane, v); }
        LDS_WAIT(); asm volatile("" ::: "memory");
#pragma unroll
        for (int j = 0; j < 4; ++j) { const int n = (lane >> 2) + 16 * j; const LAS float* q = scr + (16 * c4) * 65 + n;
            v4u o;
            o.x = pk4_fp8(64.f * q[0 * 65], 64.f * q[1 * 65], 64.f * q[2 * 65], 64.f * q[3 * 65]); o.y = pk4_fp8(64.f * q[4 * 65], 64.f * q[5 * 65], 64.f * q[6 * 65], 64.f * q[7 * 65]);
            o.z = pk4_fp8(64.f * q[8 * 65], 64.f * q[9 * 65], 64.f * q[10 * 65], 64.f * q[11 * 65]); o.w = pk4_fp8(64.f * q[12 * 65], 64.f * q[13 * 65], 64.f * q[14 * 65], 64.f * q[15 * 65]);
            *(v4u*)(me.dst + (size_t)(me.drow0 + n) * me.dld + me.k0 + 16 * c4) = o; }
        LDS_WAIT(); asm volatile("" ::: "memory");
    }
}

__device__ __forceinline__ void load_row(const float* p, int lane, f32x4 (&v)[4]) {
#pragma unroll
    for (int j = 0; j < 4; ++j) v[j] = ((const f32x4*)p)[64 * j + lane];
}
__device__ __forceinline__ void load_row_bf16(const bf16* p, int lane, f32x4 (&v)[4]) {
#pragma unroll
    for (int j = 0; j < 4; ++j) { const v2u w = ((const v2u*)p)[64 * j + lane]; v[j] = (f32x4){bflo(w.x), bfhi(w.x), bflo(w.y), bfhi(w.y)}; }
}
__device__ __forceinline__ float row_rstd(const f32x4 (&v)[4]) {
    float s = 0.f;
#pragma unroll
    for (int j = 0; j < 4; ++j) s += (v[j].x * v[j].x + v[j].y * v[j].y) + (v[j].z * v[j].z + v[j].w * v[j].w);
    return __builtin_amdgcn_rsqf(wave_sum(s) * (1.f / D) + EPS);
}
__device__ __forceinline__ void norm_mod(f32x4 (&v)[4], int lane, const float* g, const float* sh, const float* sc) {
    const float rstd = row_rstd(v);
#pragma unroll
    for (int j = 0; j < 4; ++j) { const f32x4 gg = ((const f32x4*)g)[64 * j + lane], s1 = ((const f32x4*)sc)[64 * j + lane], s0 = ((const f32x4*)sh)[64 * j + lane];
        v[j] = (v[j] * rstd) * gg * (s1 + 1.0f) + s0; }
}
__device__ __forceinline__ void store_row_bf16(bf16* o, int lane, const f32x4 (&v)[4]) {
#pragma unroll
    for (int j = 0; j < 4; ++j) { v2u w; w.x = pk2(v[j].x, v[j].y); w.y = pk2(v[j].z, v[j].w); ((v2u*)o)[64 * j + lane] = w; }
}
__device__ __forceinline__ void store_row_f32(float* o, int lane, const f32x4 (&v)[4]) {
#pragma unroll
    for (int j = 0; j < 4; ++j) ((f32x4*)o)[64 * j + lane] = v[j];
}

__device__ __forceinline__ void p1_norm0(Frame& F) {
    const int gw = F.vcu * NWAVES + F.wave, NGW = F.G * NWAVES;
    bf16* HL = (bf16*)(F.ws + WS_A);
    const int rpw = MT / NGW, rbeg = gw * rpw, rend = rbeg + rpw;
    int cur_mr = -1; f32x4 mA[4], mB[4];
    f32x4 x0[4], x1[4], x2[4], x3[4];
#define N0_LOAD(r_, x_) do { const float* p_ = row_x_in(F, (r_)); _Pragma("unroll") for (int j = 0; j < 4; ++j) x_[j] = ((const f32x4*)p_)[64 * j + F.lane]; } while (0)
#define N0_ROW(r_, x_) do { const int row_ = (r_); const int mr = row_mod(row_); \
        if (mr != cur_mr) { cur_mr = mr; const float* sc = modp(F, 0, mr, 1); const float* sh = modp(F, 0, mr, 0); const float* gg = F.in[I_NORMG]; \
            _Pragma("unroll") for (int j = 0; j < 4; ++j) { mA[j] = ((const f32x4*)gg)[64 * j + F.lane] * (((const f32x4*)sc)[64 * j + F.lane] + 1.0f); mB[j] = ((const f32x4*)sh)[64 * j + F.lane]; } } \
        const float rstd = row_rstd(x_); f32x4 v[4]; \
        _Pragma("unroll") for (int j = 0; j < 4; ++j) v[j] = (x_[j] * rstd) * mA[j] + mB[j]; \
        store_row_bf16(HL + (size_t)row_ * D, F.lane, v); } while (0)
#define N0_STEP(k_, xc_, xf_) \
        if (r + (k_) >= rend) break; \
        if (r + (k_) + 3 < rend) N0_LOAD(r + (k_) + 3, xf_); \
        N0_ROW(r + (k_), xc_);
    N0_LOAD(rbeg, x0);
    if (rbeg + 1 < rend) N0_LOAD(rbeg + 1, x1);
    if (rbeg + 2 < rend) N0_LOAD(rbeg + 2, x2);
    for (int r = rbeg; r < rend; r += 4) {
        N0_STEP(0, x0, x3)
        N0_STEP(1, x1, x0)
        N0_STEP(2, x2, x1)
        N0_STEP(3, x3, x2)
    }
#undef N0_STEP
#undef N0_LOAD
#undef N0_ROW
}

namespace pg8 {
constexpr int FP8_SCALE = 0x7C7C7C7C;
constexpr int BM = 256, BK = 64, HALF = 128, HTB = HALF * BK * 2, STAGE_BYTES = 8 * HTB, NXCD = 8, WGM = 8;
__host__ __device__ __forceinline__ int lds_byte(int r, int c) { const int st = (r >> 4) * 2 + (c >> 5), rr = r & 15, cc = c & 31, ob = rr * 64 + cc * 2; return st * 1024 + (ob ^ (((ob >> 9) & 1) << 5)); }
__host__ __device__ __forceinline__ void stage_rc(int b, int& R, int& C) { const int st = b / 1024, sb = b % 1024, swz = sb ^ (((sb >> 9) & 1) << 5); R = (st >> 1) * 16 + swz / 64; C = (st & 1) * 32 + (swz % 64) / 2; }
__host__ __device__ __forceinline__ int perm32(int rho) { const int n = rho >> 4, i = rho & 15; return 8 * (i >> 2) + 4 * n + (i & 3); }
constexpr int GROW_OFF = 131072;
struct Unit { int pm, pn; const char* a; const char* b; int aux; };
struct Gemm { int nt, lda, ldb; };
__host__ __device__ __forceinline__ bool order_next(int nM, int nN, int G, int c, int i, int& pm, int& pn) {
    const int nwg = nM * nN; const long L = (long)i * G + c; if (L >= nwg) return false;
    int wgid = (int)L; { const int q = nwg / NXCD, r = nwg % NXCD, xcd = wgid % NXCD, off = wgid / NXCD; wgid = (xcd < r ? xcd * (q + 1) : r * (q + 1) + (xcd - r) * q) + off; }
    const int nig = WGM * nN, gid = wgid / nig, fm = gid * WGM, gsz = (nM - fm) < WGM ? (nM - fm) : WGM;
    pm = fm + ((wgid % nig) % gsz); pn = (wgid % nig) / gsz; return true;
}
typedef int v8i __attribute__((ext_vector_type(8)));
typedef int v4i __attribute__((ext_vector_type(4)));
__host__ __device__ __forceinline__ int f8swz(int r) { return ((r >> 1) & 1) | (((r >> 3) & 1) << 2); }
__device__ __forceinline__ unsigned cvt_pk_bf16(float lo, float hi) { unsigned r; asm volatile("v_cvt_pk_bf16_f32 %0, %1, %2" : "=v"(r) : "v"(lo), "v"(hi)); return r; }

template <bool F8> struct Frag;
template <> struct Frag<false> { bf16x8 k[2]; };
template <> struct Frag<true> { v8i v; };
template <class Epi, class Sched, bool FP8 = false, bool ALIGN_EPI = true, bool SP2 = true>
__device__ __forceinline__ void gemm_phase(LAS unsigned char* lds, const Gemm g, const Sched& S, const Epi& E, int wave_id) {
    const int wid = wave_id, lane = (int)__builtin_amdgcn_mbcnt_hi(~0u, __builtin_amdgcn_mbcnt_lo(~0u, 0u)), tid = wid * 64 + lane, wr = wid >> 2, wc = wid & 3, fr = lane & 15, fq = lane >> 4;
    const int nt = g.nt;
    unsigned voffB[2]; int RA[2], CA_[2];
#pragma unroll
    for (int i = 0; i < 2; ++i) { int R, C; const int b_ = tid * 16 + i * 8192;
        if (FP8) { R = b_ >> 7; C = (((b_ >> 4) & 7) ^ f8swz(R)) * 16; } else { stage_rc(b_, R, C); C *= 2; }
        const int Rb = Epi::COLMAP ? (64 * (R >> 5) + 16 * ((R & 15) >> 2) + 4 * ((R >> 4) & 1) + (R & 3)) : (Epi::PERM ? ((R & ~31) + perm32(R & 31)) : R);
        RA[i] = R; CA_[i] = C; voffB[i] = (unsigned)(Rb * g.ldb + C); }
    const size_t kstep = (size_t)(BK * 2);
    const size_t hstepB = (size_t)(Epi::COLMAP ? 8 : HALF) * g.ldb;
    unsigned vA[2][2], nvA[2][2];
    const unsigned ldsw = (unsigned)wid * 1024u;
    const int aoff = FP8 ? (wr * 64 + fr) * 128 + (((2 * fq) ^ f8swz(fr)) << 4) : lds_byte(wr * 64 + fr, fq * 8);
    const int boff = FP8 ? (wc * 32 + fr) * 128 + (((2 * fq) ^ f8swz(fr)) << 4) : lds_byte(wc * 32 + fr, fq * 8);
#define PG8_SA(b, h) (((b) * 2 + (h)) * HTB)
#define PG8_SB(b, h) ((4 + (b) * 2 + (h)) * HTB)
#define PG8_STAGE(bufoff, gbase, voff) do { _Pragma("unroll") for (int _i = 0; _i < 2; ++_i) \
        __builtin_amdgcn_global_load_lds((const unsigned*)((const char*)(gbase) + (voff)[_i]), (LAS unsigned*)(lds + (bufoff) + ldsw + _i * 8192), 16, 0, 0); } while (0)
#define PG8_LD1(dstf, base_, off_, i_) do { if constexpr (FP8) { dstf.v.lo = *(const LAS v4i*)(lds + (base_) + (off_) + (i_) * 2048); dstf.v.hi = *(const LAS v4i*)(lds + (base_) + ((off_) ^ 16) + (i_) * 2048); } \
        else { dstf.k[0] = *(const LAS bf16x8*)(lds + (base_) + (off_) + (i_) * 2048); dstf.k[1] = *(const LAS bf16x8*)(lds + (base_) + (off_) + (i_) * 2048 + 1024); } } while (0)
#define PG8_LDA(dst, b, h) do { _Pragma("unroll") for (int m = 0; m < 4; ++m) PG8_LD1(dst[m], PG8_SA(b, h), aoff, m); } while (0)
#define PG8_LDB(dst, b, h) do { _Pragma("unroll") for (int n = 0; n < 2; ++n) PG8_LD1(dst[n], PG8_SB(b, h), boff, n); } while (0)
#define PG8_MMA(ai, bj, At, Bt) do { if constexpr (FP8) __builtin_amdgcn_sched_barrier(0); __builtin_amdgcn_s_setprio(1); _Pragma("unroll") for (int m = 0; m < 4; ++m) _Pragma("unroll") for (int n = 0; n < 2; ++n) { \
        if constexpr (FP8) asm volatile("v_mfma_scale_f32_16x16x128_f8f6f4 %0, %1, %2, %0, %3, %4 op_sel_hi:[0,0,0]" : "+v"(acc[ai][bj][m][n]) : "v"(Bt[n].v), "v"(At[m].v), "v"(f8s), "v"(f8s)); \
        else { _Pragma("unroll") for (int k = 0; k < 2; ++k) acc[ai][bj][m][n] = __builtin_amdgcn_mfma_f32_16x16x32_bf16(Bt[n].k[k], At[m].k[k], acc[ai][bj][m][n], 0, 0, 0); } } \
        __builtin_amdgcn_s_setprio(0); if constexpr (FP8) __builtin_amdgcn_sched_barrier(0); } while (0)
#define PG8_NVA(h) ((Sched::GATHER && last) ? nvA[h] : vA[h])
#define PG8_WAIT_V(n) asm volatile("s_waitcnt vmcnt(" #n ")" ::: "memory")
#define PG8_WAIT_L(n) asm volatile("s_waitcnt lgkmcnt(" #n ")" ::: "memory")
#define PG8_BAR __builtin_amdgcn_s_barrier()
#define PG8_SCHED __builtin_amdgcn_sched_barrier(0)
    Unit cur, nxt; int ui = 0;
    if (!S.next(0, cur)) return;
    f32x4 acc[2][2][4][2];
#pragma unroll
    for (int a = 0; a < 2; ++a)
#pragma unroll
        for (int b = 0; b < 2; ++b)
#pragma unroll
            for (int m = 0; m < 4; ++m)
#pragma unroll
                for (int n = 0; n < 2; ++n) acc[a][b][m][n] = (f32x4){0.f, 0.f, 0.f, 0.f};
    Frag<FP8> At[4], B0[2], B1[2];
    int f8s = FP8_SCALE;
    asm volatile("" : "+v"(f8s));
    const char* cA = cur.a; const char* cB = cur.b;
    S.a_offsets(cur, g, RA, CA_, vA);
    if constexpr (SP2) {
        PG8_STAGE(PG8_SB(0, 0), cB, voffB); PG8_STAGE(PG8_SB(0, 1), cB + hstepB, voffB); PG8_STAGE(PG8_SA(0, 0), cA, vA[0]); PG8_STAGE(PG8_SA(0, 1), cA, vA[1]);
        if (wr == 1) PG8_BAR;
        PG8_WAIT_V(2); PG8_BAR;
        PG8_STAGE(PG8_SB(1, 0), cB + kstep, voffB); PG8_STAGE(PG8_SA(1, 0), cA + kstep, vA[0]); PG8_STAGE(PG8_SB(1, 1), cB + hstepB + kstep, voffB);
        PG8_WAIT_V(6); PG8_BAR;
    } else {
        PG8_STAGE(PG8_SB(0, 0), cB, voffB); PG8_STAGE(PG8_SA(0, 0), cA, vA[0]); PG8_STAGE(PG8_SB(0, 1), cB + hstepB, voffB); PG8_STAGE(PG8_SA(0, 1), cA, vA[1]);
        if (wr == 1) PG8_BAR;
        PG8_WAIT_V(4); PG8_BAR;
        PG8_STAGE(PG8_SB(1, 0), cB + kstep, voffB); PG8_STAGE(PG8_SA(1, 0), cA + kstep, vA[0]); PG8_STAGE(PG8_SB(1, 1), cB + hstepB + kstep, voffB);
        PG8_WAIT_V(6); PG8_BAR;
    }
    for (;;) {
        const bool has_next = S.next(ui + 1, nxt);
        const char* nA = has_next ? nxt.a : cA; const char* nB = has_next ? nxt.b : cB;
        if constexpr (Sched::GATHER) {
#pragma unroll
            for (int h = 0; h < 2; ++h)
#pragma unroll
                for (int i = 0; i < 2; ++i) nvA[h][i] = vA[h][i];
        }
        for (int t = 0; t < nt; t += 2) {
            const bool last = (t == nt - 2);
            if constexpr (Sched::GATHER) {
                if (last && has_next) {
#pragma unroll
                    for (int h = 0; h < 2; ++h)
#pragma unroll
                        for (int i = 0; i < 2; ++i) nvA[h][i] = (unsigned)(*(const LAS int*)(lds + GROW_OFF + (h * 128 + RA[i]) * 4) * g.lda + CA_[i]);
                }
                if (t == 0 && has_next && wr == 0) __builtin_amdgcn_global_load_lds((const unsigned*)S.row_ptr(nxt, tid), (LAS unsigned*)(lds + GROW_OFF + wid * 256), 4, 0, 0);
            }
            const char* a1 = cA + (size_t)(t + 1) * kstep;
            const char* a2 = last ? nA : cA + (size_t)(t + 2) * kstep; const char* b2 = last ? nB : cB + (size_t)(t + 2) * kstep;
            const char* a3 = a2 + kstep; const char* b3 = b2 + kstep;
            if constexpr (SP2) {
            PG8_LDB(B0, 0, 0); PG8_LDB(B1, 0, 1); PG8_SCHED; PG8_LDA(At, 0, 0); PG8_STAGE(PG8_SA(1, 1), a1, vA[1]);
            PG8_WAIT_V(8); PG8_WAIT_L(0); PG8_BAR; PG8_MMA(0, 0, At, B0); PG8_MMA(0, 1, At, B1); PG8_BAR; PG8_SCHED;
            PG8_LDA(At, 0, 1); PG8_STAGE(PG8_SB(0, 0), b2, voffB); PG8_STAGE(PG8_SB(0, 1), b2 + hstepB, voffB); PG8_STAGE(PG8_SA(0, 0), a2, PG8_NVA(0));
            PG8_WAIT_V(8); PG8_WAIT_L(0); PG8_BAR; PG8_MMA(1, 0, At, B0); PG8_MMA(1, 1, At, B1); PG8_BAR; PG8_SCHED;
            PG8_LDB(B0, 1, 0); PG8_LDB(B1, 1, 1); PG8_SCHED; PG8_LDA(At, 1, 0); PG8_STAGE(PG8_SA(0, 1), a2, PG8_NVA(1));
            PG8_WAIT_V(8); PG8_WAIT_L(0); PG8_BAR; PG8_MMA(0, 0, At, B0); PG8_MMA(0, 1, At, B1); PG8_BAR; PG8_SCHED;
            PG8_LDA(At, 1, 1); PG8_STAGE(PG8_SB(1, 0), b3, voffB); PG8_STAGE(PG8_SB(1, 1), b3 + hstepB, voffB); PG8_STAGE(PG8_SA(1, 0), a3, PG8_NVA(0));
            PG8_WAIT_V(8); PG8_WAIT_L(0); PG8_BAR; PG8_MMA(1, 0, At, B0); PG8_MMA(1, 1, At, B1); PG8_BAR; PG8_SCHED;
            } else {
            PG8_LDB(B0, 0, 0); PG8_SCHED; PG8_LDA(At, 0, 0); PG8_STAGE(PG8_SA(1, 1), a1, vA[1]);
            PG8_WAIT_L(8); PG8_BAR; PG8_WAIT_L(0); PG8_MMA(0, 0, At, B0); PG8_BAR; PG8_SCHED;
            PG8_LDB(B1, 0, 1); PG8_STAGE(PG8_SB(0, 0), b2, voffB);
            PG8_BAR; PG8_WAIT_L(0); PG8_MMA(0, 1, At, B1); PG8_BAR;
            PG8_LDA(At, 0, 1); PG8_STAGE(PG8_SA(0, 0), a2, PG8_NVA(0));
            PG8_BAR; PG8_WAIT_L(0); PG8_MMA(1, 0, At, B0); PG8_BAR; PG8_SCHED;
            PG8_STAGE(PG8_SB(0, 1), b2 + hstepB, voffB);
            PG8_WAIT_V(6); PG8_BAR; PG8_MMA(1, 1, At, B1); PG8_BAR;
            PG8_LDB(B0, 1, 0); PG8_SCHED; PG8_LDA(At, 1, 0); PG8_STAGE(PG8_SA(0, 1), a2, PG8_NVA(1));
            PG8_WAIT_L(8); PG8_BAR; PG8_WAIT_L(0); PG8_MMA(0, 0, At, B0); PG8_BAR; PG8_SCHED;
            PG8_LDB(B1, 1, 1); PG8_STAGE(PG8_SB(1, 0), b3, voffB);
            PG8_BAR; PG8_WAIT_L(0); PG8_MMA(0, 1, At, B1); PG8_BAR;
            PG8_LDA(At, 1, 1); PG8_STAGE(PG8_SA(1, 0), a3, PG8_NVA(0));
            PG8_BAR; PG8_WAIT_L(0); PG8_MMA(1, 0, At, B0); PG8_BAR; PG8_SCHED;
            PG8_STAGE(PG8_SB(1, 1), b3 + hstepB, voffB);
            PG8_WAIT_V(6); PG8_BAR; PG8_MMA(1, 1, At, B1); PG8_BAR;
            }
        }
        if constexpr (ALIGN_EPI) { if (wr == 0) PG8_BAR; }
        if constexpr (FP8) asm volatile("s_nop 15\n\ts_nop 15" ::: "memory");
        E(acc, cur, wr, wc, fr, fq);
        if (!has_next) break;
#pragma unroll
        for (int a = 0; a < 2; ++a)
#pragma unroll
            for (int b = 0; b < 2; ++b)
#pragma unroll
                for (int m = 0; m < 4; ++m)
#pragma unroll
                    for (int n = 0; n < 2; ++n) acc[a][b][m][n] = (f32x4){0.f, 0.f, 0.f, 0.f};
        cur = nxt; cA = nA; cB = nB; ++ui;
        if constexpr (Sched::GATHER) {
#pragma unroll
            for (int h = 0; h < 2; ++h)
#pragma unroll
                for (int i = 0; i < 2; ++i) vA[h][i] = nvA[h][i];
        }
        if constexpr (ALIGN_EPI) { if (wr == 1) PG8_BAR; }
    }
    PG8_WAIT_V(0);
    if constexpr (!ALIGN_EPI) { if (wr == 0) PG8_BAR; }
    PG8_BAR;
#undef PG8_SA
#undef PG8_SB
#undef PG8_STAGE
#undef PG8_LDA
#undef PG8_LDB
#undef PG8_MMA
#undef PG8_NVA
#undef PG8_LD1
#undef PG8_WAIT_V
#undef PG8_WAIT_L
#undef PG8_BAR
#undef PG8_SCHED
}
}

struct DenseSched {
    static constexpr bool GATHER = false;
    int nM, nN, G, c; const char* A; const char* B; size_t strideA, strideB;
    __device__ __forceinline__ bool next(int i, pg8::Unit& u) const {
        if (!pg8::order_next(nM, nN, G, c, i, u.pm, u.pn)) return false;
        u.a = A + (size_t)u.pm * strideA; u.b = B + (size_t)u.pn * strideB; u.aux = 0; return true;
    }
    __device__ __forceinline__ void a_offsets(const pg8::Unit&, const pg8::Gemm& g, const int (&R)[2], const int (&C)[2], unsigned (&v)[2][2]) const {
#pragma unroll
        for (int h = 0; h < 2; ++h)
#pragma unroll
            for (int i = 0; i < 2; ++i) v[h][i] = (unsigned)((h * 128 + R[i]) * g.lda + C[i]);
    }
};


__device__ __forceinline__ float gelu_tanh(float v) {
    constexpr float C1 = -1.5957691216057308f * 1.4426950408889634f, C2 = C1 * 0.044715f;
    return v * __builtin_amdgcn_rcpf(1.f + __builtin_amdgcn_exp2f(v * __builtin_fmaf(v * v, C2, C1))); }
__device__ __forceinline__ float sigmoid_f(float v) { return __builtin_amdgcn_rcpf(1.f + __expf(-v)); }
template <int ACT> struct EpiBf16 {
    static constexpr bool PERM = true; static constexpr int COLMAP = 0;
    bf16* O; int ldc; const float* bias; int nscale; float scale;
    __device__ __forceinline__ void operator()(const f32x4 (&acc)[2][2][4][2], const pg8::Unit& u, int wr, int wc, int fr, int fq) const {
        const int row0 = u.pm * 256 + wr * 64 + fr, col0 = u.pn * 256 + wc * 32 + 8 * fq;
        const float sc = u.pn < nscale ? scale : 1.f;
#pragma unroll
        for (int bj = 0; bj < 2; ++bj) {
            const f32x4 zz = (f32x4){0.f, 0.f, 0.f, 0.f};
            const f32x4 b0 = bias ? *(const f32x4*)(bias + col0 + bj * 128) : zz, b1 = bias ? *(const f32x4*)(bias + col0 + bj * 128 + 4) : zz;
#pragma unroll
            for (int ai = 0; ai < 2; ++ai)
#pragma unroll
                for (int m = 0; m < 4; ++m) {
                    f32x4 v0 = (acc[ai][bj][m][0] + b0) * sc, v1 = (acc[ai][bj][m][1] + b1) * sc;
                    if (ACT == 1) { v0 = (f32x4){gelu_tanh(v0.x), gelu_tanh(v0.y), gelu_tanh(v0.z), gelu_tanh(v0.w)}; v1 = (f32x4){gelu_tanh(v1.x), gelu_tanh(v1.y), gelu_tanh(v1.z), gelu_tanh(v1.w)}; }
                    v4u w; w.x = pg8::cvt_pk_bf16(v0.x, v0.y); w.y = pg8::cvt_pk_bf16(v0.z, v0.w); w.z = pg8::cvt_pk_bf16(v1.x, v1.y); w.w = pg8::cvt_pk_bf16(v1.z, v1.w);
                    *(v4u*)(O + (size_t)(row0 + ai * 128 + m * 16) * ldc + col0 + bj * 128) = w;
                    if (m == 3) asm volatile("s_waitcnt vmcnt(0)" ::: "memory");
                }
        }
    }
};
struct EpiF8 {
    static constexpr bool PERM = true; static constexpr int COLMAP = 1;
    unsigned char* O; int ldc;
    __device__ __forceinline__ void operator()(const f32x4 (&acc)[2][2][4][2], const pg8::Unit& u, int wr, int wc, int fr, int fq) const {
        const int row0 = u.pm * 256 + wr * 64 + fr, col0 = u.pn * 256 + wc * 64 + 16 * fq;
#pragma unroll
        for (int ai = 0; ai < 2; ++ai)
#pragma unroll
            for (int m = 0; m < 4; ++m) { v4u w;
                w.x = pk4_fp8(acc[ai][0][m][0].x, acc[ai][0][m][0].y, acc[ai][0][m][0].z, acc[ai][0][m][0].w); w.y = pk4_fp8(acc[ai][0][m][1].x, acc[ai][0][m][1].y, acc[ai][0][m][1].z, acc[ai][0][m][1].w);
                w.z = pk4_fp8(acc[ai][1][m][0].x, acc[ai][1][m][0].y, acc[ai][1][m][0].z, acc[ai][1][m][0].w); w.w = pk4_fp8(acc[ai][1][m][1].x, acc[ai][1][m][1].y, acc[ai][1][m][1].z, acc[ai][1][m][1].w);
                *(v4u*)(O + (size_t)(row0 + ai * 128 + m * 16) * ldc + col0) = w; }
    }
};
struct EpiBf16RowBias {
    static constexpr bool PERM = true; static constexpr int COLMAP = 0;
    bf16* O; int ldc; const float* bias;
    __device__ __forceinline__ void operator()(const f32x4 (&acc)[2][2][4][2], const pg8::Unit& u, int wr, int wc, int fr, int fq) const {
        const int row0 = u.pm * 256 + wr * 64 + fr, col0 = u.pn * 256 + wc * 32 + 8 * fq;
        float bb[8];
#pragma unroll
        for (int q = 0; q < 8; ++q) bb[q] = bias[row0 + (q >> 2) * 128 + (q & 3) * 16];
        asm volatile("" : "+v"(bb[0]), "+v"(bb[1]), "+v"(bb[2]), "+v"(bb[3]), "+v"(bb[4]), "+v"(bb[5]), "+v"(bb[6]), "+v"(bb[7]));
#pragma unroll
        for (int ai = 0; ai < 2; ++ai)
#pragma unroll
            for (int m = 0; m < 4; ++m) { const int row = row0 + ai * 128 + m * 16; const float b = bb[ai * 4 + m];
#pragma unroll
                for (int bj = 0; bj < 2; ++bj) { const f32x4 v0 = acc[ai][bj][m][0] + b, v1 = acc[ai][bj][m][1] + b;
                    v4u w; w.x = pg8::cvt_pk_bf16(v0.x, v0.y); w.y = pg8::cvt_pk_bf16(v0.z, v0.w); w.z = pg8::cvt_pk_bf16(v1.x, v1.y); w.w = pg8::cvt_pk_bf16(v1.z, v1.w);
                    *(v4u*)(O + (size_t)row * ldc + col0 + bj * 128) = w; }
                if (m & 1) asm volatile("s_waitcnt vmcnt(0)" ::: "memory"); }
    }
};
template <bool INPLACE>
struct EpiResid {
    static constexpr bool PERM = true; static constexpr int COLMAP = 0;
    const float* baseL; const float* baseC; bf16* XL; const float* bias; const float* gate;
    __device__ __forceinline__ void operator()(const f32x4 (&acc)[2][2][4][2], const pg8::Unit& u, int wr, int wc, int fr, int fq) const {
        const int rowt = u.pm * 256, col0 = u.pn * 256 + wc * 32 + 8 * fq;
        const bool isc = rowt >= NL; const int mrow = isc ? 8 : (rowt >> 12);
        const float* base = isc ? baseC - (size_t)NL * D : baseL;
        const float* gp = gate + (size_t)mrow * (NMOD * D);
#pragma unroll
        for (int bj = 0; bj < 2; ++bj) { const int col = col0 + bj * 128;
            const f32x4 bv0 = *(const f32x4*)(bias + col), bv1 = *(const f32x4*)(bias + col + 4), gv0 = *(const f32x4*)(gp + col), gv1 = *(const f32x4*)(gp + col + 4);
#pragma unroll
            for (int ai = 0; ai < 2; ++ai) {
                f32x4 x0[4], x1[4];
#pragma unroll
                for (int m = 0; m < 4; ++m) { const size_t off = (size_t)(rowt + ai * 128 + wr * 64 + m * 16 + fr) * D + col;
                    if (INPLACE) { const v4u w = *(const v4u*)(XL + off); x0[m] = (f32x4){bflo(w.x), bfhi(w.x), bflo(w.y), bfhi(w.y)}; x1[m] = (f32x4){bflo(w.z), bfhi(w.z), bflo(w.w), bfhi(w.w)}; }
                    else { x0[m] = *(const f32x4*)(base + off); x1[m] = *(const f32x4*)(base + off + 4); } }
#pragma unroll
                for (int m = 0; m < 4; ++m) { const size_t off = (size_t)(rowt + ai * 128 + wr * 64 + m * 16 + fr) * D + col;
                    const f32x4 y0 = x0[m] + gv0 * (acc[ai][bj][m][0] + bv0), y1 = x1[m] + gv1 * (acc[ai][bj][m][1] + bv1);
                    v4u o; o.x = pg8::cvt_pk_bf16(y0.x, y0.y); o.y = pg8::cvt_pk_bf16(y0.z, y0.w); o.z = pg8::cvt_pk_bf16(y1.x, y1.y); o.w = pg8::cvt_pk_bf16(y1.z, y1.w);
                    *(v4u*)(XL + off) = o; } } }
    }
};

constexpr size_t WS_G = 208 * MiB, WS_UPRE = 272 * MiB, WS_GH = 340 * MiB;
constexpr int SCT = 64, NCHUNK = 68, AT_STRIDE = 528;
typedef float f32x4v __attribute__((ext_vector_type(4)));
constexpr size_t WS_UC8 = WS_HDN;
constexpr size_t WS_UC = WS_A;
__device__ __forceinline__ void conv_phase(Frame& F) {
    const bf16* UPRE = (const bf16*)(F.ws + WS_UPRE); bf16* UC = (bf16*)(F.ws + WS_UC); unsigned char* UC8 = F.ws + WS_UC8;
    const int ch8 = F.tid & 127, c0 = 8 * ch8;
    float cw[4][8], cb[8];
#pragma unroll
    for (int k = 0; k < 4; ++k) { const f32x4 a = *(const f32x4*)(F.in[I_CONVW] + k * D + c0), bq = *(const f32x4*)(F.in[I_CONVW] + k * D + c0 + 4);
        cw[k][0] = a.x; cw[k][1] = a.y; cw[k][2] = a.z; cw[k][3] = a.w; cw[k][4] = bq.x; cw[k][5] = bq.y; cw[k][6] = bq.z; cw[k][7] = bq.w; }
    { const f32x4 a = *(const f32x4*)(F.in[I_CONVB] + c0), bq = *(const f32x4*)(F.in[I_CONVB] + c0 + 4); cb[0] = a.x; cb[1] = a.y; cb[2] = a.z; cb[3] = a.w; cb[4] = bq.x; cb[5] = bq.y; cb[6] = bq.z; cb[7] = bq.w; }
    const int ng = MT / 8, step = F.G * 4;
#define CV_LOAD(gi_, raw_) do { const int r0_ = (gi_) * 8; int s0_, len_; if (r0_ < NL) { s0_ = r0_ & ~(SEQ - 1); len_ = SEQ; } else { s0_ = NL + ((r0_ - NL) & ~(CTXL - 1)); len_ = CTXL; } \
        _Pragma("unroll") for (int i = 0; i < 11; ++i) { const int r_ = r0_ - 2 + i; raw_[i] = (v4u){0u, 0u, 0u, 0u}; if (r_ >= s0_ && r_ < s0_ + len_) raw_[i] = *(const v4u*)(UPRE + (size_t)r_ * D + c0); } } while (0)
#define CV_UNPACK(dst_, w_) do { dst_[0] = bflo(w_.x); dst_[1] = bfhi(w_.x); dst_[2] = bflo(w_.y); dst_[3] = bfhi(w_.y); dst_[4] = bflo(w_.z); dst_[5] = bfhi(w_.z); dst_[6] = bflo(w_.w); dst_[7] = bfhi(w_.w); } while (0)
#define CV_COMPUTE(gi_, raw_) do { const int r0_ = (gi_) * 8; float xr[4][8]; CV_UNPACK(xr[0], raw_[0]); CV_UNPACK(xr[1], raw_[1]); CV_UNPACK(xr[2], raw_[2]); \
        _Pragma("unroll") for (int tt = 0; tt < 8; ++tt) { CV_UNPACK(xr[(tt + 3) & 3], raw_[tt + 3]); float o[8]; \
            _Pragma("unroll") for (int c = 0; c < 8; ++c) o[c] = cb[c] + xr[tt & 3][c] * cw[0][c] + xr[(tt + 1) & 3][c] * cw[1][c] + xr[(tt + 2) & 3][c] * cw[2][c] + xr[(tt + 3) & 3][c] * cw[3][c]; \
            v4u wv; wv.x = pk2(o[0], o[1]); wv.y = pk2(o[2], o[3]); wv.z = pk2(o[4], o[5]); wv.w = pk2(o[6], o[7]); \
            *(v4u*)(UC + (size_t)(r0_ + tt) * D + c0) = wv; \
            v2u w8; w8.x = pk4_fp8(o[0], o[1], o[2], o[3]); w8.y = pk4_fp8(o[4], o[5], o[6], o[7]); *(v2u*)(UC8 + (size_t)(r0_ + tt) * D + c0) = w8; } } while (0)
    v4u ra[11], rb[11];
    const int g0 = F.vcu * 4 + (F.tid >> 7);
    if (g0 < ng) CV_LOAD(g0, ra);
    for (int gi = g0; gi < ng; gi += 2 * step) {
        if (gi + step < ng) CV_LOAD(gi + step, rb);
        CV_COMPUTE(gi, ra);
        if (gi + step >= ng) break;
        if (gi + 2 * step < ng) CV_LOAD(gi + 2 * step, ra);
        CV_COMPUTE(gi + step, rb);
    }
#undef CV_LOAD
#undef CV_UNPACK
#undef CV_COMPUTE
}
constexpr int SW_AGG = 16384, SW_A = 20480, SW_ATILE = 32 * 256, SW_U = SW_A + 8 * SW_ATILE, SW_G = SW_U + 8 * 2560;
constexpr int SW_MTN = 2, SW_T = 16 * SW_MTN;
constexpr int SW_NCTX = CTXL / SW_T, SW_NCH = (CTXL + SEQ) / SW_T, SW_STEPS = (SW_NCH + 7) / 8;
constexpr int SW_F8SCALE = 0x7D7D7D7D;
static_assert(SW_MTN == 2 && SW_G + 8 * 2560 <= RTAB_BYTES, "sweep LDS map");
__device__ __forceinline__ void rows4(float x, float (&r)[4]) {
    typedef unsigned u32x2 __attribute__((ext_vector_type(2)));
    const unsigned xi = __builtin_bit_cast(unsigned, x);
    const u32x2 p16 = __builtin_amdgcn_permlane16_swap(xi, xi, false, false);
    const u32x2 pa = __builtin_amdgcn_permlane32_swap(p16.x, p16.x, false, false);
    const u32x2 pb = __builtin_amdgcn_permlane32_swap(p16.y, p16.y, false, false);
    r[0] = __uint_as_float(pa[0]); r[1] = __uint_as_float(pb[0]); r[2] = __uint_as_float(pa[1]); r[3] = __uint_as_float(pb[1]);
}
constexpr float SW_LOG2E = 1.4426950408889634f;
template <int DIR>
__device__ __forceinline__ void scan_sweep(Frame& F) {
    constexpr int MTN = SW_MTN;
    const int lane = F.lane, w = F.wave, g = lane >> 4, lc = lane & 15;
    const int c = F.vcu, b = c >> 5, nb = (c >> 3) & 3, cg = c & 7;
    const bf16* UC = (const bf16*)(F.ws + WS_UC); const unsigned char* UC8 = F.ws + WS_UC8; const unsigned char* WG8 = F.ws + WS_WG;
    const bf16* Gp = (const bf16*)(F.ws + WS_G); bf16* GH = (bf16*)(F.ws + WS_GH);
#pragma unroll
    for (int i = 0; i < 2; ++i) { const int pid = F.tid + 512 * i, n = pid >> 4, pp = pid & 15; const int nt = n >> 4, j = n & 15, ct = nt >> 1, gate = nt & 1;
        const v4u v = *(const v4u*)(WG8 + ((size_t)(((DIR * 2 + gate) * 4 + nb) * 256 + 32 * cg + 16 * ct + j)) * 256 + pp * 16);
        *(LAS v4u*)(F.lds + n * 256 + ((pp ^ (n & 15)) << 4)) = v; }
    float br[2], bi[2], lam8[2], hprev[2];
#pragma unroll
    for (int ct = 0; ct < 2; ++ct) { const int ch = nb * 256 + 32 * cg + 16 * ct + lc;
        br[ct] = -SW_LOG2E * F.in[I_BGATE][(DIR * 2 + 0) * D + ch]; bi[ct] = -SW_LOG2E * F.in[I_BGATE][(DIR * 2 + 1) * D + ch];
        lam8[ct] = (-8.f * SW_LOG2E) * log1pf(__expf(-F.in[I_LAMBDA][DIR * D + ch])); hprev[ct] = 0.f; }
    LAS f32x2* AGG = (LAS f32x2*)(F.lds + SW_AGG);
    LAS unsigned char* AT = F.lds + SW_A + w * SW_ATILE;
    LAS unsigned char* UT = F.lds + SW_U + w * 2560;
    LAS unsigned char* GS = F.lds + SW_G + w * 2560;
    int f8s = SW_F8SCALE; asm volatile("" : "+v"(f8s));
#define SW_CI(idx_) (DIR == 0 ? (idx_) : ((idx_) < SW_NCTX ? SW_NCTX - 1 - (idx_) : SW_NCH + SW_NCTX - 1 - (idx_)))
#define SW_ROW0(ci_) ((ci_) < SW_NCTX ? NL + b * CTXL + (ci_) * SW_T : b * SEQ + ((ci_) - SW_NCTX) * SW_T)
#define SW_LOADA(row0_) do { const unsigned char* ap_ = UC8 + (size_t)((row0_) + (lane >> 4)) * D + nb * 256 + 16 * (lane & 15); \
        _Pragma("unroll") for (int i = 0; i < 8; ++i) areg[i] = *(const v4u*)(ap_ + (size_t)(4 * i) * D); \
        _Pragma("unroll") for (int i = 0; i < 2; ++i) { const int pp_ = lane + 64 * i; ureg[i] = *(const v4u*)(UC + (size_t)((row0_) + (pp_ >> 2)) * D + nb * 256 + 32 * cg + 8 * (pp_ & 3)); } } while (0)
    v4u areg[8], ureg[2];
    { const int ci0 = SW_CI(w); SW_LOADA(SW_ROW0(ci0)); }
    __syncthreads();
    for (int s = 0; s < SW_STEPS; ++s) {
        const int idx = 8 * s + w; const bool active = idx < SW_NCH;
        const int ci = SW_CI(idx); const bool isctx = ci < SW_NCTX; const int row0 = SW_ROW0(ci);
        float Pc[2][MTN][4], Hc[2][MTN][4], CA[2], CB[2]; v4u hfr[MTN], gr[MTN];
        CA[0] = 1.f; CB[0] = 0.f; CA[1] = 1.f; CB[1] = 0.f;
        if (active) {
            f32x4 acc[MTN][4]; float uu[2][MTN][4];
#pragma unroll
            for (int mt = 0; mt < MTN; ++mt)
#pragma unroll
                for (int nt = 0; nt < 4; ++nt) acc[mt][nt] = (f32x4){0.f, 0.f, 0.f, 0.f};
#pragma unroll
            for (int i = 0; i < 8; ++i) { const int r = 4 * i + (lane >> 4); *(LAS v4u*)(AT + r * 256 + (((lane & 15) ^ (r & 15)) << 4)) = areg[i]; }
#pragma unroll
            for (int i = 0; i < 2; ++i) { const int pp = lane + 64 * i; *(LAS v4u*)(UT + (pp >> 2) * 80 + 16 * (pp & 3)) = ureg[i]; }
            asm volatile("s_waitcnt lgkmcnt(0)" ::: "memory");
#pragma unroll
            for (int ct = 0; ct < 2; ++ct)
#pragma unroll
                for (int mt = 0; mt < MTN; ++mt)
#pragma unroll
                    for (int r = 0; r < 4; ++r) uu[ct][mt][r] = bf2f(*(const LAS unsigned short*)(UT + (16 * mt + 4 * g + r) * 80 + (16 * ct + lc) * 2));
#pragma unroll
            for (int kb = 0; kb < 2; ++kb) {
                pg8::v8i bfr[4], afr[MTN];
#pragma unroll
                for (int nt = 0; nt < 4; ++nt) { const LAS unsigned char* rp = F.lds + (16 * nt + lc) * 256;
                    bfr[nt].lo = *(const LAS pg8::v4i*)(rp + (((2 * g + 8 * kb) ^ lc) << 4)); bfr[nt].hi = *(const LAS pg8::v4i*)(rp + (((2 * g + 1 + 8 * kb) ^ lc) << 4)); }
#pragma unroll
                for (int mt = 0; mt < MTN; ++mt) { const LAS unsigned char* rp = AT + (16 * mt + lc) * 256;
                    afr[mt].lo = *(const LAS pg8::v4i*)(rp + (((2 * g + 8 * kb) ^ lc) << 4)); afr[mt].hi = *(const LAS pg8::v4i*)(rp + (((2 * g + 1 + 8 * kb) ^ lc) << 4)); }
#pragma unroll
                for (int mt = 0; mt < MTN; ++mt)
#pragma unroll
                    for (int nt = 0; nt < 4; ++nt)
                        asm volatile("v_mfma_scale_f32_16x16x128_f8f6f4 %0, %1, %2, %0, %3, %3 op_sel_hi:[0,0,0]" : "+v"(acc[mt][nt]) : "v"(afr[mt]), "v"(bfr[nt]), "v"(f8s));
            }
            asm volatile("s_nop 15\n\ts_nop 15\n\ts_waitcnt lgkmcnt(0)" ::: "memory");
            if (idx + 8 < SW_NCH) { const int nci = SW_CI(idx + 8); SW_LOADA(SW_ROW0(nci)); }
            if (DIR == 1 && !isctx) {
#pragma unroll
                for (int i = 0; i < MTN; ++i) { const int pp = lane + 64 * i; const size_t off = (size_t)(row0 + (pp >> 2)) * D + nb * 256 + 32 * cg + 8 * (pp & 3);
                    hfr[i] = *(const v4u*)(GH + off); gr[i] = *(const v4u*)(Gp + off); }
            }
#pragma unroll
            for (int ct = 0; ct < 2; ++ct) {
                float a[MTN][4], bc[MTN][4];
#pragma unroll
                for (int mt = 0; mt < MTN; ++mt)
#pragma unroll
                    for (int r = 0; r < 4; ++r) {
                        const float rg = __builtin_amdgcn_rcpf(1.f + __builtin_amdgcn_exp2f(__builtin_fmaf(acc[mt][ct * 2 + 0][r], -SW_LOG2E, br[ct]))), ig = __builtin_amdgcn_rcpf(1.f + __builtin_amdgcn_exp2f(__builtin_fmaf(acc[mt][ct * 2 + 1][r], -SW_LOG2E, bi[ct])));
                        const float av = __builtin_amdgcn_exp2f(lam8[ct] * rg); a[mt][r] = av; bc[mt][r] = __builtin_amdgcn_sqrtf(fmaxf(1.f - av * av, 0.f)) * (ig * uu[ct][mt][r]); }
                float ca = 1.f, cbv = 0.f;
#pragma unroll
                for (int q4 = 0; q4 < MTN; ++q4) { const int mt = DIR == 0 ? q4 : MTN - 1 - q4;
                    float A = 1.f, B = 0.f;
#pragma unroll
                    for (int rr = 0; rr < 4; ++rr) { const int r = DIR == 0 ? rr : 3 - rr; A = A * a[mt][r]; B = a[mt][r] * B + bc[mt][r]; }
                    float ta = 1.f, tb = 0.f, ea = 1.f, eb = 0.f, Ar[4], Br[4];
                    rows4(A, Ar); rows4(B, Br);
#pragma unroll
                    for (int q = 0; q < 4; ++q) { const int gg = DIR == 0 ? q : 3 - q;
                        const float Ag = Ar[gg], Bg = Br[gg];
                        if (gg == g) { ea = ta; eb = tb; }
                        tb = Ag * tb + Bg; ta = ta * Ag; }
                    float pa = ea * ca, pb = ea * cbv + eb;
#pragma unroll
                    for (int rr = 0; rr < 4; ++rr) { const int r = DIR == 0 ? rr : 3 - rr; pb = a[mt][r] * pb + bc[mt][r]; pa = pa * a[mt][r]; Pc[ct][mt][r] = pa; Hc[ct][mt][r] = pb; }
                    cbv = ta * cbv + tb; ca = ca * ta; }
                CA[ct] = ca; CB[ct] = cbv;
            }
        }
        if (g == 0) { AGG[(((s & 1) * 8 + w) * 2 + 0) * 16 + lc] = (f32x2){CA[0], CB[0]}; AGG[(((s & 1) * 8 + w) * 2 + 1) * 16 + lc] = (f32x2){CA[1], CB[1]}; }
        __syncthreads();
        float hin[2];
#pragma unroll
        for (int ct = 0; ct < 2; ++ct) { float h = hprev[ct]; hin[ct] = h;
#pragma unroll
            for (int ww = 0; ww < 8; ++ww) { const f32x2 ab = AGG[(((s & 1) * 8 + ww) * 2 + ct) * 16 + lc]; if (ww == w) hin[ct] = h; h = ab.x * h + ab.y; }
            hprev[ct] = h; }
        if (active && !isctx) {
            LAS unsigned char* US = AT;
            if (DIR == 1) {
#pragma unroll
                for (int i = 0; i < MTN; ++i) { const int pp = lane + 64 * i; *(LAS v4u*)(US + (pp >> 2) * 80 + 16 * (pp & 3)) = hfr[i]; *(LAS v4u*)(GS + (pp >> 2) * 80 + 16 * (pp & 3)) = gr[i]; }
                asm volatile("s_waitcnt lgkmcnt(0)" ::: "memory");
            }
#pragma unroll
            for (int ct = 0; ct < 2; ++ct)
#pragma unroll
                for (int mt = 0; mt < MTN; ++mt)
#pragma unroll
                    for (int r = 0; r < 4; ++r) { const float h = Pc[ct][mt][r] * hin[ct] + Hc[ct][mt][r];
                        const int so = (16 * mt + 4 * g + r) * 80 + (16 * ct + lc) * 2;
                        float o = h;
                        if (DIR == 1) o = (bf2f(*(const LAS unsigned short*)(US + so)) + h) * bf2f(*(const LAS unsigned short*)(GS + so));
                        *(LAS unsigned short*)(US + so) = (unsigned short)f2bf(o); }
            asm volatile("s_waitcnt lgkmcnt(0)" ::: "memory");
#pragma unroll
            for (int i = 0; i < MTN; ++i) { const int pp = lane + 64 * i; const size_t off = (size_t)(row0 + (pp >> 2)) * D + nb * 256 + 32 * cg + 8 * (pp & 3);
                *(v4u*)(GH + off) = *(const LAS v4u*)(US + (pp >> 2) * 80 + 16 * (pp & 3)); }
            asm volatile("s_waitcnt lgkmcnt(0)" ::: "memory");
        }
    }
#undef SW_CI
#undef SW_ROW0
#undef SW_LOADA
    __syncthreads();
}

constexpr float LOG2E = 1.4426950408889634f;
__device__ __forceinline__ bf16x8 pack8(const f32x4 a, const f32x4 b) {
    v4u w; w.x = pg8::cvt_pk_bf16(a.x, a.y); w.y = pg8::cvt_pk_bf16(a.z, a.w); w.z = pg8::cvt_pk_bf16(b.x, b.y); w.w = pg8::cvt_pk_bf16(b.z, b.w);
    return __builtin_bit_cast(bf16x8, w);
}
constexpr int AK_C = 0, AV_C = 32768, AK_W = 67584, AV_W = 67584, A_RPB = 143360;
__device__ __forceinline__ int kswz(int k) { return ((k >> 1) & 1) | (((k >> 3) & 3) << 1); }
__device__ __forceinline__ void attn_stage_ctx(Frame& F, const bf16* QK, const bf16* VT, int b, int h) {
    v4u kr[4], vr[4]; int tid_ = F.tid; asm volatile("" : "+v"(tid_));
#pragma unroll
    for (int i = 0; i < 4; ++i) { const int pid = tid_ + 512 * i; { const int key = pid >> 3, c = pid & 7; kr[i] = *(const v4u*)(QK + (size_t)(NL + b * CTXL + key) * 2048 + 1024 + h * 64 + c * 8); }
        { const int dim = pid >> 5, c = pid & 31; vr[i] = *(const v4u*)(VT + (size_t)(h * 64 + dim) * MT + NL + b * CTXL + c * 8); } }
#pragma unroll
    for (int i = 0; i < 4; ++i) { const int pid = tid_ + 512 * i; { const int key = pid >> 3, c = pid & 7; *(LAS v4u*)(F.lds + AK_C + key * 128 + ((c ^ kswz(key & 31)) << 4)) = kr[i]; }
        { const int dim = pid >> 5, c = pid & 31; *(LAS v4u*)(F.lds + AV_C + dim * 544 + c * 16) = vr[i]; } }
    __syncthreads();
}
__device__ __forceinline__ void attn_load_kw(const bf16* QK, int b, int h, int rb, int tid, v4u (&kr)[9]) {
    asm volatile("" : "+v"(tid));
#pragma unroll
    for (int i = 0; i < 9; ++i) { const int pid = tid + 512 * i, key = pid >> 3, c = pid & 7; int row = rb + (key >> 6); row = row > 63 ? 63 : row;
        kr[i] = *(const v4u*)(QK + (size_t)(b * SEQ + row * 64 + (key & 63)) * 2048 + 1024 + h * 64 + c * 8); }
}
__device__ __forceinline__ void attn_store_kw(LAS unsigned char* lds, int tid, const v4u (&kr)[9]) {
    asm volatile("" : "+v"(tid));
#pragma unroll
    for (int i = 0; i < 9; ++i) { const int pid = tid + 512 * i, key = pid >> 3, c = pid & 7; *(LAS v4u*)(lds + AK_W + key * 128 + ((c ^ kswz(key & 31)) << 4)) = kr[i]; }
}
__device__ __forceinline__ void attn_load_vw(const bf16* VT, int b, int h, int rb, int tid, v4u (&vr)[9]) {
    asm volatile("" : "+v"(tid));
#pragma unroll
    for (int i = 0; i < 9; ++i) { const int pid = tid + 512 * i, dim = pid / 72, c = pid % 72; int row = rb + (c >> 3); row = row > 63 ? 63 : row;
        vr[i] = *(const v4u*)(VT + (size_t)(h * 64 + dim) * MT + b * SEQ + row * 64 + (c & 7) * 8); }
}
__device__ __forceinline__ void attn_store_vw(LAS unsigned char* lds, int tid, const v4u (&vr)[9]) {
    asm volatile("" : "+v"(tid));
#pragma unroll
    for (int i = 0; i < 9; ++i) { const int pid = tid + 512 * i, dim = pid / 72, c = pid % 72; *(LAS v4u*)(lds + AV_W + dim * 1184 + c * 16) = vr[i]; }
}
constexpr int AV_T = LDSCTL_OFF + 1024;
__device__ __forceinline__ void attn_dma_vw(LAS unsigned char* lds, const bf16* VT, int b, int h, int rb, int w, int lane) {
    unsigned voff = (unsigned)lane * 16u; asm volatile("" : "+v"(voff));
#pragma unroll
    for (int j = 0; j < 8; ++j) { const int dim = 8 * w + j;
        const char* src = (const char*)(VT + (size_t)(h * 64 + dim) * MT + b * SEQ + rb * 64);
        __builtin_amdgcn_global_load_lds((const unsigned*)(src + voff), (LAS unsigned*)(lds + AV_W + dim * 1184), 16, 0, 0); }
    { const char* src = (const char*)(VT + (size_t)(h * 64 + 8 * w) * MT + b * SEQ + (rb + 8) * 64);
      __builtin_amdgcn_global_load_lds((const unsigned*)(src + (size_t)(voff >> 7) * (MT * 2) + (voff & 127u)), (LAS unsigned*)(lds + AV_T + w * 1024), 16, 0, 0); }
}
__device__ __forceinline__ float xrow_max(float x) {
    auto s = __builtin_amdgcn_permlane16_swap(__float_as_uint(x), __float_as_uint(x), false, false); x = fmaxf(__uint_as_float(s[0]), __uint_as_float(s[1]));
    auto t = __builtin_amdgcn_permlane32_swap(__float_as_uint(x), __float_as_uint(x), false, false); return fmaxf(__uint_as_float(t[0]), __uint_as_float(t[1]));
}
__device__ __forceinline__ float xrow_sum(float x) {
    auto s = __builtin_amdgcn_permlane16_swap(__float_as_uint(x), __float_as_uint(x), false, false); x = __uint_as_float(s[0]) + __uint_as_float(s[1]);
    auto t = __builtin_amdgcn_permlane32_swap(__float_as_uint(x), __float_as_uint(x), false, false); return __uint_as_float(t[0]) + __uint_as_float(t[1]);
}
template <bool LAT>
__device__ __forceinline__ void attn_unit(Frame& F, const bf16* QK, const bf16* VT, bf16* O, int b, int h, int rp_or_half, v4u (&kr)[9], bool has_next, int nrb) {
    int lane_ = F.lane; asm volatile("" : "+v"(lane_));
    const int lane = lane_, g = lane >> 4, lc = lane & 15, w = F.wave;
    const f32x4 zero4 = (f32x4){0.f, 0.f, 0.f, 0.f};
    int r = 0, qt = 0, tokq0, span0 = 0, rs = 0, rb = 0, wro = 0;
    if (LAT) { r = 2 * rp_or_half + (w >> 2); qt = w & 3; tokq0 = b * SEQ + r * 64 + 16 * qt; span0 = qt == 0 ? 0 : (qt == 1 ? 8 : (qt == 2 ? 24 : 32));
        rs = r - 4 < 0 ? 0 : (r - 4 > 56 ? 56 : r - 4); const int r0 = 2 * rp_or_half; rb = r0 - 4 < 0 ? 0 : (r0 - 4 > 56 ? 56 : r0 - 4); wro = rs - rb; }
    else { tokq0 = NL + b * CTXL + rp_or_half * 128 + 16 * w; }
    const bf16* qp = QK + (size_t)(tokq0 + lc) * 2048 + h * 64 + 8 * g;
    const bf16x8 qf0 = *(const bf16x8*)qp, qf1 = *(const bf16x8*)(qp + 32);
    if (LAT) { attn_store_kw(F.lds, F.tid, kr); __builtin_amdgcn_sched_barrier(0); }
    const int kk0 = 8 * (lc >> 2) + (lc & 3);
    f32x4 sc[8][2]; bf16x8 pc[8]; f32x4 o[4];
#pragma unroll
    for (int cp = 0; cp < 8; ++cp)
#pragma unroll
        for (int p = 0; p < 2; ++p) { const int key = 32 * cp + kk0 + 4 * p; const int sz = kswz(key & 31);
            const bf16x8 k0 = *(const LAS bf16x8*)(F.lds + AK_C + key * 128 + ((g ^ sz) << 4)), k1 = *(const LAS bf16x8*)(F.lds + AK_C + key * 128 + (((4 + g) ^ sz) << 4));
            f32x4 a = __builtin_amdgcn_mfma_f32_16x16x32_bf16(k0, qf0, zero4, 0, 0, 0);
            sc[cp][p] = __builtin_amdgcn_mfma_f32_16x16x32_bf16(k1, qf1, a, 0, 0, 0); if (p == 1) asm volatile("" ::: "memory"); }
    float l = 0.f, mc = -1e30f;
#define ATT_CMAX() do { _Pragma("unroll") for (int i_ = 0; i_ < 8; ++i_) _Pragma("unroll") for (int p_ = 0; p_ < 2; ++p_) _Pragma("unroll") for (int j_ = 0; j_ < 4; ++j_) mc = fmaxf(mc, sc[i_][p_][j_]); mc = xrow_max(mc); } while (0)
#define ATT_CEXP(cp_) do { f32x4 e_[2]; _Pragma("unroll") for (int p_ = 0; p_ < 2; ++p_) _Pragma("unroll") for (int j_ = 0; j_ < 4; ++j_) { e_[p_][j_] = __builtin_amdgcn_exp2f(sc[cp_][p_][j_] - mc); l += e_[p_][j_]; } \
        pc[cp_] = pack8(e_[0], e_[1]); asm volatile("" : "+v"(l));   } while (0)
#define ATT_PVC(cp_) do { _Pragma("unroll") for (int dt = 0; dt < 4; ++dt) { const bf16x8 vf = *(const LAS bf16x8*)(F.lds + AV_C + (16 * dt + lc) * 544 + (32 * (cp_) + 8 * g) * 2); \
        o[dt] = __builtin_amdgcn_mfma_f32_16x16x32_bf16(vf, pc[cp_], o[dt], 0, 0, 0); } asm volatile("" ::: "memory"); } while (0)
    if (LAT) {
        f32x4 sw[8][2]; bf16x8 pw[8];
        __syncthreads();
#pragma unroll
        for (int i = 0; i < 8; ++i) {
#pragma unroll
            for (int p = 0; p < 2; ++p) { const int key = (wro + i) * 64 + span0 + kk0 + 4 * p; const int sz = kswz(key & 31);
                const bf16x8 k0 = *(const LAS bf16x8*)(F.lds + AK_W + key * 128 + ((g ^ sz) << 4)), k1 = *(const LAS bf16x8*)(F.lds + AK_W + key * 128 + (((4 + g) ^ sz) << 4));
                f32x4 a = __builtin_amdgcn_mfma_f32_16x16x32_bf16(k0, qf0, zero4, 0, 0, 0);
                sw[i][p] = __builtin_amdgcn_mfma_f32_16x16x32_bf16(k1, qf1, a, 0, 0, 0); }
            asm volatile("" ::: "memory");
            if (i == 0) ATT_CMAX(); else ATT_CEXP(i - 1);
            __builtin_amdgcn_sched_barrier(0);
        }
        ATT_CEXP(7);
        __syncthreads();
        attn_dma_vw(F.lds, VT, b, h, rb, w, lane);
        const LAS float* RPB = (const LAS float*)(F.lds + A_RPB);
        const int c = 16 * qt + lc; const int cs = c - 8 < 0 ? 0 : (c - 8 > 48 ? 48 : c - 8);
        const int cb0 = span0 + 8 * g;
        float mw = -1e30f, m2 = mc, alpha = 1.f;
#pragma unroll
        for (int dt = 0; dt < 4; ++dt) o[dt] = zero4;
#define ATT_WBIAS(i_) do { const LAS float* rowb = RPB + (rs + (i_) - r + 7) * 31 + (cb0 - c + 15); float bv[8]; \
        _Pragma("unroll") for (int x = 0; x < 8; ++x) bv[x] = rowb[x]; \
        asm volatile("" : "+v"(bv[0]), "+v"(bv[1]), "+v"(bv[2]), "+v"(bv[3]), "+v"(bv[4]), "+v"(bv[5]), "+v"(bv[6]), "+v"(bv[7]));   \
        _Pragma("unroll") for (int p_ = 0; p_ < 2; ++p_) _Pragma("unroll") for (int j_ = 0; j_ < 4; ++j_) { const bool ok = (unsigned)(cb0 - cs + 4 * p_ + j_) < 16u; \
            const float v_ = ok ? sw[i_][p_][j_] + bv[4 * p_ + j_] : -1e30f; sw[i_][p_][j_] = v_; mw = fmaxf(mw, v_); } } while (0)
#define ATT_WEXP(i_) do { f32x4 e_[2]; _Pragma("unroll") for (int p_ = 0; p_ < 2; ++p_) _Pragma("unroll") for (int j_ = 0; j_ < 4; ++j_) { e_[p_][j_] = __builtin_amdgcn_exp2f(sw[i_][p_][j_] - m2); l += e_[p_][j_]; } \
        pw[i_] = pack8(e_[0], e_[1]); asm volatile("" : "+v"(l)); } while (0)
#pragma unroll
        for (int cp = 0; cp < 8; ++cp) {
            ATT_PVC(cp);
            if (cp < 4) { ATT_WBIAS(2 * cp); ATT_WBIAS(2 * cp + 1); }
            else if (cp == 4) { mw = xrow_max(mw); m2 = fmaxf(mc, mw); alpha = __builtin_amdgcn_exp2f(mc - m2); l *= alpha; }
            else if (cp == 5) { ATT_WEXP(0); ATT_WEXP(1); ATT_WEXP(2); }
            else if (cp == 6) { ATT_WEXP(3); ATT_WEXP(4); ATT_WEXP(5); }
            else { ATT_WEXP(6); ATT_WEXP(7); }
            __builtin_amdgcn_sched_barrier(0);
        }
#pragma unroll
        for (int dt = 0; dt < 4; ++dt) o[dt] = o[dt] * alpha;
        asm volatile("s_waitcnt vmcnt(0)" ::: "memory");
        __syncthreads();
        if (has_next) attn_load_kw(QK, b, h, nrb, F.tid, kr);
#pragma unroll
        for (int i = 0; i < 8; ++i)
#pragma unroll
            for (int dt = 0; dt < 4; ++dt) { const int dim = 16 * dt + lc;
                const int voffs = (i == 7 && wro == 1) ? AV_T + dim * 128 + (span0 + 8 * g) * 2 : AV_W + dim * 1184 + ((wro + i) * 64 + span0 + 8 * g) * 2;
                const bf16x8 vf = *(const LAS bf16x8*)(F.lds + voffs); o[dt] = __builtin_amdgcn_mfma_f32_16x16x32_bf16(vf, pw[i], o[dt], 0, 0, 0); if (dt == 3) asm volatile("" ::: "memory"); }
#undef ATT_WBIAS
#undef ATT_WEXP
    } else {
        ATT_CMAX();
#pragma unroll
        for (int cp = 0; cp < 8; ++cp) ATT_CEXP(cp);
#pragma unroll
        for (int dt = 0; dt < 4; ++dt) o[dt] = zero4;
#pragma unroll
        for (int cp = 0; cp < 8; ++cp) ATT_PVC(cp);
    }
#undef ATT_CMAX
#undef ATT_CEXP
#undef ATT_PVC
    l = xrow_sum(l);
    const float inv = __builtin_amdgcn_rcpf(l);
    unsigned char* op = (unsigned char*)O + (size_t)(tokq0 + lc) * D + h * 64 + 4 * g;
#pragma unroll
    for (int dt = 0; dt < 4; ++dt) *(unsigned*)(op + 16 * dt) = pk4_fp8(o[dt].x * inv, o[dt].y * inv, o[dt].z * inv, o[dt].w * inv);
    if (LAT) __syncthreads();
}
__device__ __forceinline__ void attn_phase(Frame& F) {
    const bf16* QK = (const bf16*)(F.ws + WS_B);
    const bf16* VT = (const bf16*)(F.ws + WS_C);
    bf16* O = (bf16*)(F.ws + WS_A);
    const int NUB = BATCH * NHEAD * 32, per = (NUB + F.G - 1) / F.G;
    int u0 = F.vcu * per, u1 = u0 + per; if (u1 > NUB) u1 = NUB;
    int cb = -1, ch = -1; v4u kr[9];
    for (int u = u0; u < u1; ++u) {
        const int b = u >> 9, h = (u >> 5) & 15, rp = u & 31;
        if (b != cb || h != ch) { __syncthreads(); attn_stage_ctx(F, QK, VT, b, h); if (F.tid < 465) ((LAS float*)(F.lds + A_RPB))[F.tid] = F.in[I_RPB][h * 465 + F.tid] * LOG2E; cb = b; ch = h;
            { const int r0 = 2 * rp; attn_load_kw(QK, b, h, r0 - 4 < 0 ? 0 : (r0 - 4 > 56 ? 56 : r0 - 4), F.tid, kr); } __syncthreads(); }
        const int un = u + 1; const bool hn = un < u1 && (un >> 5) == (u >> 5); const int nr0 = 2 * (un & 31);
        attn_unit<true>(F, QK, VT, O, b, h, rp, kr, hn, nr0 - 4 < 0 ? 0 : (nr0 - 4 > 56 ? 56 : nr0 - 4));
        if (un < u1 && !hn) { cb = -1; }
    }
    for (int u = F.vcu; u < BATCH * NHEAD * 2; u += F.G) {
        const int b = u >> 5, h = (u >> 1) & 15, half = u & 1;
        if (b != cb || h != ch) { __syncthreads(); attn_stage_ctx(F, QK, VT, b, h); cb = b; ch = h; }
        attn_unit<false>(F, QK, VT, O, b, h, half, kr, false, 0);
    }
    __syncthreads();
}
constexpr int LC_CNT = 256, LC_BASE = 384, LC_TSTART = 512, LC_ECNT = 768, LC_REC = 1024;
struct RouteRec { int e0, e1, p0, p1; float w0, w1; int pad0, pad1; };
__device__ __forceinline__ void reduce8(const float (&a)[8], float (&out)[8], int lane) {
#define R8_DPP(x, ctrl) __builtin_bit_cast(float, __builtin_amdgcn_update_dpp(0, __builtin_bit_cast(int, x), ctrl, 0xF, 0xF, false))
    float t[4], u[2];
#pragma unroll
    for (int i = 0; i < 4; ++i) { auto r = __builtin_amdgcn_permlane32_swap(__float_as_uint(a[i]), __float_as_uint(a[i + 4]), false, false); t[i] = __uint_as_float(r[0]) + __uint_as_float(r[1]); }
#pragma unroll
    for (int i = 0; i < 2; ++i) { auto r = __builtin_amdgcn_permlane16_swap(__float_as_uint(t[i]), __float_as_uint(t[i + 2]), false, false); u[i] = __uint_as_float(r[0]) + __uint_as_float(r[1]); }
    const bool hi8 = (lane & 8) != 0;
    float keep = hi8 ? u[1] : u[0]; const float send = hi8 ? u[0] : u[1];
    keep += R8_DPP(send, 0x128);
    keep += R8_DPP(keep, 0x141); keep += R8_DPP(keep, 0xB1); keep += R8_DPP(keep, 0x4E);
#pragma unroll
    for (int k = 0; k < 8; ++k) out[k] = __builtin_bit_cast(float, __builtin_amdgcn_readlane(__builtin_bit_cast(int, keep), 8 * k));
#undef R8_DPP
}
__device__ __forceinline__ void norm2_router(Frame& F, int layer, int nrows) {
    LAS f32x4* WT = (LAS f32x4*)F.lds;
    LAS int* cnt = (LAS int*)(F.lds + LDSCTL_OFF + LC_CNT); LAS int* base = (LAS int*)(F.lds + LDSCTL_OFF + LC_BASE);
    LAS v4u* rec = (LAS v4u*)(F.lds + LDSCTL_OFF + LC_REC);
    const float* wg = F.in[I_MWG] + (size_t)layer * D * 4; const float* we = F.in[I_MWE] + (size_t)layer * 4 * D * 8;
    { f32x4 wt[18];
#pragma unroll
      for (int q = 0; q < 18; ++q) { const int pid = F.tid + NTHREADS * q; const int plane = pid >> 10, pos = pid & 1023, k = 4 * (pos & 63) + 256 * (pos >> 8) + ((pos >> 6) & 3);
          wt[q] = plane == 0 ? *(const f32x4*)(wg + k * 4) : *(const f32x4*)(we + ((size_t)((plane - 1) >> 1) * 1024 + k) * 8 + ((plane - 1) & 1) * 4); }
#pragma unroll
      for (int q = 0; q < 18; ++q) WT[F.tid + NTHREADS * q] = wt[q]; }
    if (F.tid < 32) cnt[F.tid] = 0;
    __syncthreads();
    const int rpb = nrows / F.G, rbase = blockIdx.x * rpb;
    const float* gam = F.in[I_NORMG] + (layer * 2 + 1) * D;
    unsigned char* HL2 = F.ws + WS_HL2;
    const float* bg = F.in[I_MBG] + layer * 4; const float* be = F.in[I_MBE] + layer * 32;
    typedef float f32x2 __attribute__((ext_vector_type(2)));
    int cur_mr = -1; f32x4 mA[4], mB[4]; v2u raw[2][4];
    const bf16* XLp = (const bf16*)(F.ws + WS_XL);
    if (F.wave < rpb / 2) {
#pragma unroll
        for (int q = 0; q < 2; ++q)
#pragma unroll
            for (int j = 0; j < 4; ++j) raw[q][j] = ((const v2u*)(XLp + (size_t)(rbase + 2 * F.wave + q) * D))[64 * j + F.lane]; }
    for (int pr = F.wave; pr < rpb / 2; pr += NWAVES) {
        f32x4 v[2][4];
#pragma unroll
        for (int q = 0; q < 2; ++q)
#pragma unroll
            for (int j = 0; j < 4; ++j) { const v2u w = raw[q][j]; v[q][j] = (f32x4){bflo(w.x), bfhi(w.x), bflo(w.y), bfhi(w.y)}; }
        if (pr + NWAVES < rpb / 2) {
#pragma unroll
            for (int q = 0; q < 2; ++q)
#pragma unroll
                for (int j = 0; j < 4; ++j) raw[q][j] = ((const v2u*)(XLp + (size_t)(rbase + 2 * (pr + NWAVES) + q) * D))[64 * j + F.lane]; }
#pragma unroll
        for (int q = 0; q < 2; ++q) { const int r = rbase + 2 * pr + q; const int mr = row_mod(r);
            if (mr != cur_mr) { cur_mr = mr; const float* sc = modp(F, layer, mr, 4); const float* sh = modp(F, layer, mr, 3);
#pragma unroll
                for (int j = 0; j < 4; ++j) { mA[j] = ((const f32x4*)gam)[64 * j + F.lane] * (((const f32x4*)sc)[64 * j + F.lane] + 1.0f); mB[j] = ((const f32x4*)sh)[64 * j + F.lane]; } }
            const float rstd = row_rstd(v[q]);
#pragma unroll
            for (int j = 0; j < 4; ++j) v[q][j] = (v[q][j] * rstd) * mA[j] + mB[j];
#pragma unroll
            for (int j = 0; j < 4; ++j) ((unsigned*)(HL2 + (size_t)r * D))[64 * j + F.lane] = pk4_fp8(v[q][j].x, v[q][j].y, v[q][j].z, v[q][j].w); }
        f32x2 ga2[2][2];
#pragma unroll
        for (int q = 0; q < 2; ++q) { ga2[q][0] = (f32x2){0.f, 0.f}; ga2[q][1] = (f32x2){0.f, 0.f}; }
#pragma unroll
        for (int j = 0; j < 4; ++j)
#pragma unroll
            for (int i = 0; i < 4; ++i) { const f32x4 w = WT[(4 * j + i) * 64 + F.lane];
                const f32x2 wlo = (f32x2){w.x, w.y}, whi = (f32x2){w.z, w.w};
#pragma unroll
                for (int q = 0; q < 2; ++q) { const float x = v[q][j][i]; const f32x2 xs = (f32x2){x, x};
                    ga2[q][0] = __builtin_elementwise_fma(xs, wlo, ga2[q][0]); ga2[q][1] = __builtin_elementwise_fma(xs, whi, ga2[q][1]); } }
        float ga[2][4];
#pragma unroll
        for (int q = 0; q < 2; ++q) { ga[q][0] = ga2[q][0].x; ga[q][1] = ga2[q][0].y; ga[q][2] = ga2[q][1].x; ga[q][3] = ga2[q][1].y; }
        float gsum[8];
        { float gin[8];
#pragma unroll
          for (int q = 0; q < 2; ++q)
#pragma unroll
              for (int n = 0; n < 4; ++n) gin[4 * q + n] = ga[q][n];
          reduce8(gin, gsum, F.lane); }
#pragma unroll
        for (int q = 0; q < 2; ++q) {
            float gl[4];
#pragma unroll
            for (int n = 0; n < 4; ++n) gl[n] = gsum[4 * q + n] + bg[n];
            int gs = 0; float gm = gl[0];
#pragma unroll
            for (int n = 1; n < 4; ++n) if (gl[n] > gm) { gm = gl[n]; gs = n; }
            gs = __builtin_amdgcn_readfirstlane(gs);
            float den = 0.f;
#pragma unroll
            for (int n = 0; n < 4; ++n) den += __expf(gl[n] - gm);
            const float gprob = 1.f / den;
            const LAS f32x4* wb = WT + (1 + 2 * gs) * 1024 + F.lane;
            float el[8]; f32x2 el2[4];
#pragma unroll
            for (int x = 0; x < 4; ++x) el2[x] = (f32x2){0.f, 0.f};
#pragma unroll
            for (int j = 0; j < 4; ++j)
#pragma unroll
                for (int i = 0; i < 4; ++i) { const f32x4 w0 = wb[(4 * j + i) * 64], w1 = wb[1024 + (4 * j + i) * 64];
                    const float x_ = v[q][j][i]; const f32x2 xs = (f32x2){x_, x_};
                    el2[0] = __builtin_elementwise_fma(xs, (f32x2){w0.x, w0.y}, el2[0]); el2[1] = __builtin_elementwise_fma(xs, (f32x2){w0.z, w0.w}, el2[1]);
                    el2[2] = __builtin_elementwise_fma(xs, (f32x2){w1.x, w1.y}, el2[2]); el2[3] = __builtin_elementwise_fma(xs, (f32x2){w1.z, w1.w}, el2[3]); }
#pragma unroll
            for (int x = 0; x < 4; ++x) { el[2 * x] = el2[x].x; el[2 * x + 1] = el2[x].y; }
            { float es[8]; reduce8(el, es, F.lane);
#pragma unroll
              for (int x = 0; x < 8; ++x) el[x] = es[x] + be[gs * 8 + x]; }
            int i0 = 0; float v0 = el[0];
#pragma unroll
            for (int x = 1; x < 8; ++x) if (el[x] > v0) { v0 = el[x]; i0 = x; }
            int i1 = -1; float v1 = -3.0e38f;
#pragma unroll
            for (int x = 0; x < 8; ++x) if (x != i0 && el[x] > v1) { v1 = el[x]; i1 = x; }
            const float w0 = 1.f / (1.f + __expf(v1 - v0));
            if (F.lane == 0) { const int e0 = gs * 8 + i0, e1 = gs * 8 + i1;
                const int p0 = __hip_atomic_fetch_add(&cnt[e0], 1, __ATOMIC_RELAXED, __HIP_MEMORY_SCOPE_WORKGROUP), p1 = __hip_atomic_fetch_add(&cnt[e1], 1, __ATOMIC_RELAXED, __HIP_MEMORY_SCOPE_WORKGROUP);
                rec[2 * (2 * pr + q)] = (v4u){(unsigned)e0, (unsigned)e1, (unsigned)p0, (unsigned)p1};
                rec[2 * (2 * pr + q) + 1] = (v4u){__builtin_bit_cast(unsigned, gprob * w0), __builtin_bit_cast(unsigned, gprob * (1.f - w0)), 0u, 0u}; }
        }
    }
    __syncthreads();
    unsigned* gcnt = (unsigned*)(F.ws + WS_CTL) + CW_ECNT + layer * 64;
    if (F.tid < 32) base[F.tid] = (int)__hip_atomic_fetch_add(gcnt + F.tid, (unsigned)cnt[F.tid], RLX_AGENT);
    __syncthreads();
    v4u* ROUTE = (v4u*)(F.ws + WS_ROUTE); int* SRCROW = (int*)(F.ws + WS_SRCROW);
    for (int i = F.tid; i < rpb; i += NTHREADS) { v4u a = rec[2 * i]; const v4u b2 = rec[2 * i + 1]; a.z += (unsigned)base[a.x]; a.w += (unsigned)base[a.y]; ROUTE[2 * (rbase + i)] = a; ROUTE[2 * (rbase + i) + 1] = b2;
        SRCROW[(size_t)a.x * MT + a.z] = rbase + i; SRCROW[(size_t)a.y * MT + a.w] = rbase + i; }
    __syncthreads();
}
__device__ __forceinline__ void moe_tile_starts(Frame& F, int layer) {
    LAS int* ts = (LAS int*)(F.lds + LDSCTL_OFF + LC_TSTART);
    if (F.wave == 0) {
        const unsigned* gcnt = (const unsigned*)(F.ws + WS_CTL) + CW_ECNT + layer * 64; LAS int* ec = (LAS int*)(F.lds + LDSCTL_OFF + LC_ECNT);
        const int lane = F.lane; const int cn = lane < 32 ? (int)__hip_atomic_load(gcnt + lane, RLX_AGENT) : 0; const int tiles = (cn + 255) >> 8;
        int incl = tiles;
#pragma unroll
        for (int d = 1; d < 32; d <<= 1) { const int t = __shfl_up(incl, d); if (lane >= d) incl += t; }
        if (lane < 32) { ec[lane] = cn; ts[lane] = incl - tiles; }
        if (lane == 31) ts[32] = incl; }
    __syncthreads();
}
template <bool GATHER_>
struct MoeSched {
    static constexpr bool GATHER = GATHER_;
    const LAS int* ts; int G, c; const char* A; const char* B; size_t strideA, strideBe, strideBn; const int* srcrow;
    __device__ __forceinline__ bool next(int i, pg8::Unit& u) const {
        if (!pg8::order_next(__builtin_amdgcn_readfirstlane(ts[32]), 4, G, c, i, u.pm, u.pn)) return false;
        const int lane = (int)__builtin_amdgcn_mbcnt_hi(~0u, __builtin_amdgcn_mbcnt_lo(~0u, 0u));
        const int e = __builtin_popcount((unsigned)__builtin_amdgcn_ballot_w64(ts[lane & 31] <= u.pm)) - 1;
        u.a = GATHER ? A : A + (size_t)u.pm * strideA; u.b = B + (size_t)e * strideBe + (size_t)u.pn * strideBn; u.aux = e; return true;
    }
    __device__ __forceinline__ const int* row_ptr(const pg8::Unit& u, int r) const {
        const int e = u.aux; const int p0 = (u.pm - __builtin_amdgcn_readfirstlane(ts[e])) * 256; const int cn = __builtin_amdgcn_readfirstlane(ts[64 + e]);
        const int pos = p0 + r; return srcrow + (size_t)e * MT + (pos < cn ? pos : p0);
    }
    __device__ __forceinline__ int row_of(const pg8::Unit& u, int r) const { return *row_ptr(u, r); }
    __device__ __forceinline__ void a_offsets(const pg8::Unit& u, const pg8::Gemm& g, const int (&R)[2], const int (&C)[2], unsigned (&v)[2][2]) const {
        if (GATHER) {
            int row[2][2];
#pragma unroll
            for (int h = 0; h < 2; ++h)
#pragma unroll
                for (int i = 0; i < 2; ++i) row[h][i] = row_of(u, h * 128 + R[i]);
#pragma unroll
            for (int h = 0; h < 2; ++h)
#pragma unroll
                for (int i = 0; i < 2; ++i) v[h][i] = (unsigned)(row[h][i] * g.lda + C[i]);
        } else {
#pragma unroll
            for (int h = 0; h < 2; ++h)
#pragma unroll
                for (int i = 0; i < 2; ++i) v[h][i] = (unsigned)((h * 128 + R[i]) * g.lda + C[i]);
        }
    }
};
static_assert(LC_ECNT - LC_TSTART == 256, "MoeSched reads the expert counts at ts[64 + e]");
struct EpiSwiglu {
    static constexpr bool PERM = true; static constexpr int COLMAP = 0;
    unsigned char* O;
    __device__ __forceinline__ void operator()(const f32x4 (&acc)[2][2][4][2], const pg8::Unit& u, int wr, int wc, int fr, int fq) const {
        const int row0 = u.pm * 256 + wr * 64 + fr, col0 = u.pn * 128 + wc * 32 + 8 * fq;
#pragma unroll
        for (int ai = 0; ai < 2; ++ai)
#pragma unroll
            for (int m = 0; m < 4; ++m) {
                f32x4 h0, h1;
#pragma unroll
                for (int j = 0; j < 4; ++j) { const float a = acc[ai][0][m][0][j], b = acc[ai][0][m][1][j]; h0[j] = a * __builtin_amdgcn_rcpf(1.f + __expf(-a)) * acc[ai][1][m][0][j]; h1[j] = b * __builtin_amdgcn_rcpf(1.f + __expf(-b)) * acc[ai][1][m][1][j]; }
                v2u w; w.x = pk4_fp8(h0.x, h0.y, h0.z, h0.w); w.y = pk4_fp8(h1.x, h1.y, h1.z, h1.w);
                *(v2u*)(O + (size_t)(row0 + ai * 128 + m * 16) * EFF + col0) = w;
            }
    }
};
__device__ __forceinline__ void moe_gemm1(Frame& F, int layer) {
    moe_tile_starts(F, layer);
    const pg8::Gemm g{8, D, D};
    MoeSched<true> S{(const LAS int*)(F.lds + LDSCTL_OFF + LC_TSTART), F.G, (int)blockIdx.x, (const char*)(F.ws + WS_HL2), (const char*)(F.ws + WS_W13), 0, (size_t)1024 * 1024, (size_t)256 * D, (const int*)(F.ws + WS_SRCROW)};
    EpiSwiglu E{F.ws + WS_HDN};
    pg8::gemm_phase<EpiSwiglu, MoeSched<true>, true>(F.lds, g, S, E, F.wave);
}
__device__ __forceinline__ void moe_gemm2(Frame& F, int layer) {
    moe_tile_starts(F, layer);
    const pg8::Gemm g{4, EFF, EFF};
    MoeSched<false> S{(const LAS int*)(F.lds + LDSCTL_OFF + LC_TSTART), F.G, (int)blockIdx.x, (const char*)(F.ws + WS_HDN), (const char*)(F.ws + WS_W2), (size_t)256 * EFF, (size_t)1024 * 512, (size_t)256 * EFF, nullptr};
    EpiF8 E{F.ws + WS_XS, D};
    pg8::gemm_phase<EpiF8, MoeSched<false>, true>(F.lds, g, S, E, F.wave);
}
template <int MODE>
__device__ __forceinline__ void moe_combine(Frame& F, int layer, int nrows) {
    moe_tile_starts(F, layer);
    const LAS int* ts = (const LAS int*)(F.lds + LDSCTL_OFF + LC_TSTART);
    const int gw = F.vcu * NWAVES + F.wave, NGW = F.G * NWAVES;
    const v4u* ROUTE = (const v4u*)(F.ws + WS_ROUTE); const unsigned char* YS = F.ws + WS_XS;
    const bf16* XLc = (const bf16*)(F.ws + WS_XL); bf16* HL = (bf16*)(F.ws + WS_A);
    const int rpw = nrows / NGW, rbeg = gw * rpw, rend = rbeg + rpw;
    LAS v4u* RT = (LAS v4u*)(F.lds + F.wave * TR_SCR);
    if (F.lane < rpw) { const v4u ra = ROUTE[2 * (rbeg + F.lane)], rb = ROUTE[2 * (rbeg + F.lane) + 1];
        RT[F.lane] = (v4u){ra.z + (unsigned)ts[ra.x] * 256u, ra.w + (unsigned)ts[ra.y] * 256u, rb.x, rb.y}; }
    asm volatile("s_waitcnt lgkmcnt(0)" ::: "memory");
    int cur_mr = -1; f32x4 gtv[4], mA[4], mB[4];
    v2u xl0[4], xl1[4], xl2[4], xl3[4]; unsigned ya0[4], yb0[4], ya1[4], yb1[4], ya2[4], yb2[4], ya3[4], yb3[4]; v4u rt0, rt1, rt2, rt3;
#define CMB_LOAD(r_, rt_, xl_, ya_, yb_) do { rt_ = RT[(r_) - rbeg]; \
        _Pragma("unroll") for (int j = 0; j < 4; ++j) xl_[j] = ((const v2u*)(XLc + (size_t)(r_) * D))[64 * j + F.lane]; \
        _Pragma("unroll") for (int j = 0; j < 4; ++j) { ya_[j] = ((const unsigned*)(YS + (size_t)rt_[0] * D))[64 * j + F.lane]; yb_[j] = ((const unsigned*)(YS + (size_t)rt_[1] * D))[64 * j + F.lane]; } } while (0)
#define CMB_ROW(r_, rt_, xl_, ya_, yb_) do { const int row_ = (r_); const int mr = row_mod(row_); \
        if (mr != cur_mr) { cur_mr = mr; const float* gt = modp(F, layer, mr, 5); \
            _Pragma("unroll") for (int j = 0; j < 4; ++j) gtv[j] = ((const f32x4*)gt)[64 * j + F.lane]; \
            if (MODE == 0) { const float* sc = modp(F, 1, mr, 1); const float* sh = modp(F, 1, mr, 0); const float* gg = F.in[I_NORMG] + 2 * D; \
                _Pragma("unroll") for (int j = 0; j < 4; ++j) { mA[j] = ((const f32x4*)gg)[64 * j + F.lane] * (((const f32x4*)sc)[64 * j + F.lane] + 1.0f); mB[j] = ((const f32x4*)sh)[64 * j + F.lane]; } } \
            else { _Pragma("unroll") for (int j = 0; j < 4; ++j) mA[j] = ((const f32x4*)F.in[I_FINALG])[64 * j + F.lane]; } } \
        const float w0 = __uint_as_float(rt_[2]), w1 = __uint_as_float(rt_[3]); f32x4 v[4];        \
        _Pragma("unroll") for (int j = 0; j < 4; ++j) { const v2u w = xl_[j]; const f32x4 x = (f32x4){bflo(w.x), bfhi(w.x), bflo(w.y), bfhi(w.y)}; \
            const f32x2 a0 = __builtin_amdgcn_cvt_pk_f32_fp8((int)ya_[j], false), a1 = __builtin_amdgcn_cvt_pk_f32_fp8((int)ya_[j], true); \
            const f32x2 b0 = __builtin_amdgcn_cvt_pk_f32_fp8((int)yb_[j], false), b1 = __builtin_amdgcn_cvt_pk_f32_fp8((int)yb_[j], true); \
            const f32x4 fa = (f32x4){a0.x, a0.y, a1.x, a1.y}, fb = (f32x4){b0.x, b0.y, b1.x, b1.y}; \
            v[j] = x + gtv[j] * (fa * w0 + fb * w1); } \
        if (MODE == 0) { store_row_bf16((bf16*)(F.ws + WS_XL) + (size_t)row_ * D, F.lane, v); \
            const float rstd = row_rstd(v); \
            _Pragma("unroll") for (int j = 0; j < 4; ++j) v[j] = (v[j] * rstd) * mA[j] + mB[j]; \
            store_row_bf16(HL + (size_t)row_ * D, F.lane, v); } \
        else { const float rstd = row_rstd(v); \
            _Pragma("unroll") for (int j = 0; j < 4; ++j) { const f32x4 o_ = (v[j] * rstd) * mA[j]; __builtin_nontemporal_store(o_, (f32x4*)(F.out + (size_t)row_ * D) + 64 * j + F.lane); } } } while (0)
    if (rpw <= 0) return;
    CMB_LOAD(rbeg, rt0, xl0, ya0, yb0);
    if (rbeg + 1 < rend) CMB_LOAD(rbeg + 1, rt1, xl1, ya1, yb1);
    if (rbeg + 2 < rend) CMB_LOAD(rbeg + 2, rt2, xl2, ya2, yb2);
#define CMB_STEP(k_, rtc_, xlc_, yac_, ybc_, rtf_, xlf_, yaf_, ybf_) \
        if (r + (k_) >= rend) break; \
        if (r + (k_) + 3 < rend) CMB_LOAD(r + (k_) + 3, rtf_, xlf_, yaf_, ybf_); \
        CMB_ROW(r + (k_), rtc_, xlc_, yac_, ybc_);
    for (int r = rbeg; r < rend; r += 4) {
        CMB_STEP(0, rt0, xl0, ya0, yb0, rt3, xl3, ya3, yb3)
        CMB_STEP(1, rt1, xl1, ya1, yb1, rt0, xl0, ya0, yb0)
        CMB_STEP(2, rt2, xl2, ya2, yb2, rt1, xl1, ya1, yb1)
        CMB_STEP(3, rt3, xl3, ya3, yb3, rt2, xl2, ya2, yb2)
    }
#undef CMB_STEP
#undef CMB_LOAD
#undef CMB_ROW
}

__global__ void __launch_bounds__(NTHREADS, 2) fwd_kernel(Args args) {
    extern __shared__ __attribute__((aligned(16))) unsigned char lds[];
    Frame F;
    F.lds = (LAS unsigned char*)lds;
    F.tid = threadIdx.x; F.lane = F.tid & 63; F.wave = __builtin_amdgcn_readfirstlane(F.tid >> 6);
    F.G = gridDim.x; { const int bx = blockIdx.x; F.vcu = (F.G % 8 == 0) ? (bx % 8) * (F.G / 8) + bx / 8 : bx; }
    F.in = (const float* const __attribute__((address_space(4)))*)__builtin_amdgcn_kernarg_segment_ptr(); F.out = args.out; F.ws = args.ws;
    static_assert(offsetof(Args, in) == 0 && offsetof(Args, out) == N_IN * 8 && offsetof(Args, ws) == N_IN * 8 + 8, "kernarg table: inputs, out, ws");
    unsigned* ctl = (unsigned*)(F.ws + WS_CTL);
    for (int u = F.tid; u < (LDS_BYTES - LDSCTL_OFF) / 4; u += NTHREADS) ((LAS unsigned*)(F.lds + LDSCTL_OFF))[u] = 0u;
    __syncthreads();
    XcdBarrier bar = xcd_barrier_post(ctl + CW_BAR, (volatile LAS unsigned*)(F.lds + LDSCTL_OFF + 64));
    const int lo = args.ph_lo, hi = args.ph_hi;
#define PH_BEGIN(k) { constexpr int k_ = (k); { asm volatile("" : "+s"(F.in));  F.out = (float*)F.in[N_IN]; F.ws = (unsigned char*)F.in[N_IN + 1]; if (lo <= k_ && k_ < hi)
#define PH_END } if (lo <= k_ && k_ + 1 < hi) xcd_barrier(bar); }

    PH_BEGIN(0) { p0_mod(F); __syncthreads(); p0_small_weights(F); conv_moe_weights(F, 0, MOE_CONV_SIDE0 + F.vcu * NWAVES + F.wave, F.G * NWAVES, MOE_CONV_TAIL0); }
    PH_END
    PH_BEGIN(1) { p1_norm0(F); }
    PH_END
    PH_BEGIN(2) {
        const pg8::Gemm g{16, 2 * D, 2 * D};
        if ((int)blockIdx.x < GEMM_G) {
        { DenseSched S{136, 8, GEMM_G, (int)blockIdx.x, (const char*)(F.ws + WS_A), (const char*)(F.ws + WS_WQK), (size_t)256 * D * 2, (size_t)256 * D * 2};
          EpiBf16<0> E{(bf16*)(F.ws + WS_B), 2048, F.in[I_BQKV], 4, 0.125f * LOG2E};
          pg8::gemm_phase(F.lds, g, S, E, F.wave); }
        { DenseSched S{4, 136, GEMM_G, GEMM_G - 1 - (int)blockIdx.x, (const char*)(F.ws + WS_WV), (const char*)(F.ws + WS_A), (size_t)256 * D * 2, (size_t)256 * D * 2};
          EpiBf16RowBias E{(bf16*)(F.ws + WS_C), MT, F.in[I_BQKV] + 2 * D};
          pg8::gemm_phase(F.lds, g, S, E, F.wave); }
        } else conv_moe_weights(F, 0, ((int)blockIdx.x - GEMM_G) * NWAVES + F.wave, (F.G - GEMM_G) * NWAVES, MOE_CONV_SIDE0);
    }
    PH_END
    PH_BEGIN(3) { attn_phase(F); }
    PH_END
    PH_BEGIN(4) {
        const pg8::Gemm g{8, D, D};
        DenseSched S{136, 4, F.G, (int)blockIdx.x, (const char*)(F.ws + WS_A), (const char*)(F.ws + WS_WO), (size_t)256 * D, (size_t)256 * D};
        EpiResid<false> E{F.in[I_X], F.in[I_CTX], (bf16*)(F.ws + WS_XL), F.in[I_NABO], modp(F, 0, 0, 2)};
        pg8::gemm_phase<EpiResid<false>, DenseSched, true>(F.lds, g, S, E, F.wave);
        if ((int)blockIdx.x >= 32)
            conv_moe_weights(F, 0, MOE_CONV_TAIL0 + ((int)blockIdx.x - 32) * NWAVES + F.wave, (F.G - 32) * NWAVES, MOE_CONV_ITEMS);
    }
    PH_END
    PH_BEGIN(5) { norm2_router(F, 0, MT); }
    PH_END
    PH_BEGIN(6) { moe_gemm1(F, 0); }
    PH_END
    PH_BEGIN(7) { moe_gemm2(F, 0); }
    PH_END
    PH_BEGIN(8) { moe_combine<0>(F, 0, MT); conv_moe_weights(F, 1, MOE_CONV_SIDE1 + F.vcu * NWAVES + F.wave, F.G * NWAVES, MOE_CONV_TAIL1); }
    PH_END
    PH_BEGIN(9) {
        const pg8::Gemm g{16, 2 * D, 2 * D};
        if ((int)blockIdx.x < GEMM_G) {
        { DenseSched S{128, 4, GEMM_G, (int)blockIdx.x, (const char*)(F.ws + WS_A), (const char*)(F.ws + WS_WIN), (size_t)256 * D * 2, (size_t)256 * D * 2};
          EpiBf16<1> E{(bf16*)(F.ws + WS_G), D, F.in[I_LBIN], 0, 1.f};
          pg8::gemm_phase(F.lds, g, S, E, F.wave); }
        { DenseSched S{136, 4, GEMM_G, GEMM_G - 1 - (int)blockIdx.x, (const char*)(F.ws + WS_A), (const char*)(F.ws + WS_WIN) + (size_t)D * D * 2, (size_t)256 * D * 2, (size_t)256 * D * 2};
          EpiBf16<0> E{(bf16*)(F.ws + WS_UPRE), D, F.in[I_LBIN] + D, 0, 1.f};
          pg8::gemm_phase(F.lds, g, S, E, F.wave); }
          if ((int)blockIdx.x >= 32 && (int)blockIdx.x < 176)
              conv_moe_weights(F, 1, MOE_CONV_TAIL1 + ((int)blockIdx.x - 32) * NWAVES + F.wave, 144 * NWAVES, MOE_CONV_ITEMS);
        } else conv_moe_weights(F, 1, ((int)blockIdx.x - GEMM_G) * NWAVES + F.wave, (F.G - GEMM_G) * NWAVES, MOE_CONV_SIDE1);
    }
    PH_END
    PH_BEGIN(10) { conv_phase(F); }
    PH_END
    PH_BEGIN(11) { scan_sweep<0>(F); asm volatile("s_waitcnt vmcnt(0)" ::: "memory"); __syncthreads(); scan_sweep<1>(F); }
    PH_END
    PH_BEGIN(12) {
        const pg8::Gemm g{16, 2 * D, 2 * D};
        DenseSched S{128, 4, F.G, (int)blockIdx.x, (const char*)(F.ws + WS_GH), (const char*)(F.ws + WS_WLO), (size_t)256 * D * 2, (size_t)256 * D * 2};
        EpiResid<true> E{nullptr, nullptr, (bf16*)(F.ws + WS_XL), F.in[I_LBO], modp(F, 1, 0, 2)};
        pg8::gemm_phase(F.lds, g, S, E, F.wave);
    }
    PH_END
    PH_BEGIN(13) { norm2_router(F, 1, NL); }
    PH_END
    PH_BEGIN(14) { moe_gemm1(F, 1); }
    PH_END
    PH_BEGIN(15) { moe_gemm2(F, 1); }
    PH_END
    PH_BEGIN(16) { moe_combine<1>(F, 1, NL); }
    PH_END
#undef PH_BEGIN
#undef PH_END
}

__global__ void diag_fill(float* out, float v, int n) { for (int i = blockIdx.x * blockDim.x + threadIdx.x; i < n; i += gridDim.x * blockDim.x) out[i] = v; }
extern "C" void kernel_launch(void* const* d_in, const int* in_sizes, int n_in, void* d_out, int out_size, void* d_ws, size_t ws_size, hipStream_t stream) {
    static int grid = 0; static float diag = 0.f;
    if (grid == 0) {
        if (n_in != N_IN || out_size != NL * D || ws_size < WS_END) { fprintf(stderr, "kernel_launch: unexpected shapes: n_in %d out %d ws %zu (need %zu)\n", n_in, out_size, ws_size, (size_t)WS_END); grid = -1; diag = 2.f; }
        else {
        int dev = 0, cus = 0, per_cu = 0;
        if (hipGetDevice(&dev) != hipSuccess || hipDeviceGetAttribute(&cus, hipDeviceAttributeMultiprocessorCount, dev) != hipSuccess) { grid = -1; diag = 3.f; }
        else if (hipFuncSetAttribute((const void*)fwd_kernel, hipFuncAttributeMaxDynamicSharedMemorySize, LDS_BYTES) != hipSuccess) { fprintf(stderr, "kernel_launch: hipFuncSetAttribute failed\n"); grid = -1; diag = 4.f; }
        else if (hipOccupancyMaxActiveBlocksPerMultiprocessor(&per_cu, (const void*)fwd_kernel, NTHREADS, LDS_BYTES) != hipSuccess || per_cu < 1) { fprintf(stderr, "kernel_launch: occupancy query says %d blocks/CU\n", per_cu); (void)hipGetLastError(); grid = -1; diag = 5.f; }
        else if (cus != 256) { fprintf(stderr, "kernel_launch: built for 256 CUs, device has %d\n", cus); grid = -1; diag = 7.f; }
        else grid = cus;
        }
    }
    if (grid < 0) { diag_fill<<<256, 256, 0, stream>>>((float*)d_out, diag, out_size); return; }
    if (hipMemsetAsync((char*)d_ws + WS_CTL, 0, CTL_ZERO_BYTES, stream) != hipSuccess) { fprintf(stderr, "kernel_launch: memset failed\n"); return; }
    Args a{};
    for (int i = 0; i < N_IN; ++i) a.in[i] = (const float*)d_in[i];
    a.out = (float*)d_out; a.ws = (unsigned char*)d_ws; a.ph_lo = 0; a.ph_hi = 1000;
    void* kargs[] = {&a};
    hipError_t e = hipLaunchCooperativeKernel((const void*)fwd_kernel, dim3(grid), dim3(NTHREADS), kargs, LDS_BYTES, stream);
    if (e != hipSuccess) { fprintf(stderr, "kernel_launch: cooperative launch failed: %s (grid %d)\n", hipGetErrorString(e), grid); (void)hipGetLastError(); diag_fill<<<256, 256, 0, stream>>>((float*)d_out, 6.f, out_size); }
}
```
